# Optimizing an MI355X kernel written in HIP

```python
import jax, jax.numpy as jnp
from jax import lax
import numpy as np

D_MODEL = 2048
BATCH = 4
SEQ = 4096
DEPTH = 4

N_MIXERS = 2
N_MLSTM_LAYERS = (DEPTH + 1) // 2
N_GMLP_LAYERS = DEPTH // 2
MLSTM_HEADS = 8
MLSTM_V_DIM = D_MODEL // MLSTM_HEADS
MLSTM_QK_DIM = MLSTM_V_DIM // 2
MLSTM_CHUNK = 128
MLSTM_QK_W = MLSTM_HEADS * MLSTM_QK_DIM
MLSTM_V_W = MLSTM_HEADS * MLSTM_V_DIM
MLSTM_N_GATES = 4 * MLSTM_HEADS
MLSTM_IN_COLS = 2 * MLSTM_QK_W + 2 * MLSTM_V_W + MLSTM_N_GATES
F_BIAS_LO = 3.0
F_BIAS_HI = 6.0
GMLP_WIDTH = D_MODEL
GMLP_GROUPS = 8
GMLP_GROUP_DIM = GMLP_WIDTH // GMLP_GROUPS
GMLP_CHUNK = 128
N_EXPERTS = 32
TOP_K = 4
EXPERT_FF = D_MODEL // 4
SWIGLU_LIMIT = 7.0
SWIGLU_ALPHA = 1.702
MOE_BLOCK = 128
DEEPNORM_ALPHA = (2 * DEPTH) ** 0.25
DEEPNORM_BETA = (8 * DEPTH) ** -0.25
LN_EPS = 1e-5

kernel_name = 'bidir_mlstm_gmlp_moe_deepnorm'


def layer_norm(x, g, b):
    xf = x.astype(jnp.float32)
    mu = jnp.mean(xf, axis=-1, keepdims=True)
    xc = xf - mu
    var = jnp.mean(xc * xc, axis=-1, keepdims=True)
    y = xc * lax.rsqrt(var + LN_EPS)
    return (y * g.astype(jnp.float32) + b.astype(jnp.float32)).astype(x.dtype)


def mlstm_scan(q, k, v, ig, lf):
    B, H, S, dk = q.shape
    dv = v.shape[-1]
    L = MLSTM_CHUNK
    nc = S // L

    def to_chunks(a):
        return jnp.moveaxis(a.reshape((B, H, nc, L) + a.shape[3:]), 2, 0)

    tri = jnp.tril(jnp.ones((L, L), dtype=bool))

    def step(carry, inp):
        C, n, m = carry
        qc, kc, vc, ic, fc = inp
        b = jnp.cumsum(fc, axis=-1)
        dmat = jnp.where(tri, b[..., :, None] - b[..., None, :] + ic[..., None, :], -jnp.inf)
        inter = b + m[..., None]
        m_t = jnp.maximum(inter, jnp.max(dmat, axis=-1))
        s = jnp.einsum('bhtd,bhsd->bhts', qc, kc) * jnp.exp(dmat - m_t[..., None])
        inter_scale = jnp.exp(inter - m_t)
        num = jnp.einsum('bhts,bhsv->bhtv', s, vc) + inter_scale[..., None] * jnp.einsum('bhtd,bhdv->bhtv', qc, C)
        den = jnp.sum(s, axis=-1) + inter_scale * jnp.einsum('bhtd,bhd->bht', qc, n)
        h = num / jnp.maximum(jnp.abs(den), jnp.exp(-m_t))[..., None]
        b_last = b[..., -1]
        g = b_last[..., None] - b + ic
        m_new = jnp.maximum(b_last + m, jnp.max(g, axis=-1))
        decay = jnp.exp(b_last + m - m_new)
        wk = jnp.exp(g - m_new[..., None])
        C_new = decay[..., None, None] * C + jnp.einsum('bhs,bhsd,bhsv->bhdv', wk, kc, vc)
        n_new = decay[..., None] * n + jnp.einsum('bhs,bhsd->bhd', wk, kc)
        return (C_new, n_new, m_new), h

    init = (jnp.zeros((B, H, dk, dv), jnp.float32),
            jnp.zeros((B, H, dk), jnp.float32),
            jnp.zeros((B, H), jnp.float32))
    _, hs = lax.scan(step, init, (to_chunks(q), to_chunks(k), to_chunks(v), to_chunks(ig), to_chunks(lf)))
    return jnp.moveaxis(hs, 0, 2).reshape(B, H, S, dv)


def mlstm_mixer(x, w_in, b_gates, norm_g, w_out):
    B, S, _ = x.shape
    H = MLSTM_HEADS
    proj = x @ w_in
    q, k, v, o, gates = jnp.split(
        proj, [MLSTM_QK_W, 2 * MLSTM_QK_W, 2 * MLSTM_QK_W + MLSTM_V_W, 2 * MLSTM_QK_W + 2 * MLSTM_V_W], axis=-1)
    gates = gates.astype(jnp.float32) + b_gates.astype(jnp.float32)
    gates = jnp.transpose(gates.reshape(B, S, 4, H), (2, 0, 3, 1))
    i_fw, f_fw, i_bw, f_bw = gates[0], gates[1], gates[2], gates[3]

    def heads(a, d):
        return jnp.transpose(a.reshape(B, S, H, d), (0, 2, 1, 3)).astype(jnp.float32)

    qh = heads(q, MLSTM_QK_DIM) * (MLSTM_QK_DIM ** -0.5)
    kh = heads(k, MLSTM_QK_DIM)
    vh = heads(v, MLSTM_V_DIM)
    h_fw = mlstm_scan(qh, kh, vh, i_fw, jax.nn.log_sigmoid(f_fw))
    flip = lambda a: jnp.flip(a, axis=2)
    h_bw = flip(mlstm_scan(flip(qh), flip(kh), flip(vh), flip(i_bw), flip(jax.nn.log_sigmoid(f_bw))))
    h = h_fw + h_bw
    mu = jnp.mean(h, axis=-1, keepdims=True)
    hc = h - mu
    h = hc * lax.rsqrt(jnp.mean(hc * hc, axis=-1, keepdims=True) + LN_EPS)
    h = jnp.transpose(h, (0, 2, 1, 3)).reshape(B, S, MLSTM_V_W) * norm_g.astype(jnp.float32)
    h = (jax.nn.sigmoid(o.astype(jnp.float32)) * h).astype(x.dtype)
    return h @ w_out


def gmlp_mixer(x, w_in, b_in, vnorm_g, vnorm_b, w_s, b_s, w_out):
    B, S, _ = x.shape
    z = jax.nn.gelu(x @ w_in + b_in, approximate=False)
    u, v = jnp.split(z, 2, axis=-1)
    v = layer_norm(v, vnorm_g, vnorm_b)
    nch = S // GMLP_CHUNK
    vc = v.reshape(B, nch, GMLP_CHUNK, GMLP_GROUPS, GMLP_GROUP_DIM)
    s = jnp.einsum('gts,bcsgd->bctgd', w_s, vc) + jnp.transpose(b_s)[:, :, None]
    y = u * s.reshape(B, S, GMLP_WIDTH)
    return y @ w_out


def moe(x, router_w, router_b, w_gu, b_gu, w_dn, b_dn):
    B, S, D = x.shape
    T = B * S
    A = T * TOP_K
    xf = x.reshape(T, D)
    logits = (xf @ router_w + router_b).astype(jnp.float32)
    top_v, top_e = lax.top_k(logits, TOP_K)
    gate = jax.nn.softmax(top_v, axis=-1).astype(x.dtype)
    e_flat = top_e.reshape(A).astype(jnp.int32)
    order = jnp.argsort(e_flat)
    e_sorted = e_flat[order]
    tok_sorted = (order // TOP_K).astype(jnp.int32)
    w_sorted = gate.reshape(A)[order]
    counts = jnp.bincount(e_flat, length=N_EXPERTS).astype(jnp.int32)
    start = jnp.cumsum(counts) - counts
    rank = jnp.arange(A, dtype=jnp.int32) - start[e_sorted]
    padded = (counts + MOE_BLOCK - 1) // MOE_BLOCK * MOE_BLOCK
    pend = jnp.cumsum(padded)
    pstart = pend - padded
    dest = pstart[e_sorted] + rank
    n_slots = A + N_EXPERTS * MOE_BLOCK
    n_blocks = n_slots // MOE_BLOCK
    slot_tok = jnp.zeros((n_slots,), jnp.int32).at[dest].set(tok_sorted)
    slot_w = jnp.zeros((n_slots,), x.dtype).at[dest].set(w_sorted)
    block_start = jnp.arange(n_blocks, dtype=jnp.int32) * MOE_BLOCK
    block_e = jnp.minimum(jnp.searchsorted(pend, block_start, side='right'), N_EXPERTS - 1).astype(jnp.int32)

    def expert_block(args):
        toks, e = args
        xb = xf[toks]
        hgu = xb @ w_gu[e] + b_gu[e]
        g = jnp.minimum(hgu[:, :EXPERT_FF], SWIGLU_LIMIT)
        u = jnp.clip(hgu[:, EXPERT_FF:], -SWIGLU_LIMIT, SWIGLU_LIMIT)
        hact = (u + 1) * (g * jax.nn.sigmoid(g * SWIGLU_ALPHA))
        return hact @ w_dn[e] + b_dn[e]

    yb = lax.map(expert_block, (slot_tok.reshape(n_blocks, MOE_BLOCK), block_e))
    y = yb.reshape(n_slots, D) * slot_w[:, None]
    out = jnp.zeros((T, D), x.dtype).at[slot_tok].add(y)
    return out.reshape(B, S, D)


def setup_inputs(seed: int = 0) -> dict:
    key = jax.random.key(seed)
    ks = jax.random.split(key, 21)
    f32 = jnp.float32
    nrm = lambda k, shape, scale: jax.random.normal(k, shape, f32) * scale
    H = MLSTM_HEADS
    fb = jnp.linspace(F_BIAS_LO, F_BIAS_HI, H, dtype=f32)
    zb = jnp.zeros((H,), f32)
    gate_base = jnp.concatenate([zb, fb, zb, fb])
    return {
        'x': nrm(ks[0], (BATCH, SEQ, D_MODEL), 1.0),
        'mlstm_w_in': nrm(ks[1], (N_MLSTM_LAYERS, D_MODEL, MLSTM_IN_COLS), D_MODEL ** -0.5),
        'mlstm_b_gates': gate_base + nrm(ks[2], (N_MLSTM_LAYERS, MLSTM_N_GATES), 0.1),
        'mlstm_norm_g': 1.0 + nrm(ks[3], (N_MLSTM_LAYERS, MLSTM_V_W), 0.02),
        'mlstm_w_out': nrm(ks[4], (N_MLSTM_LAYERS, MLSTM_V_W, D_MODEL), MLSTM_V_W ** -0.5 * DEEPNORM_BETA),
        'gmlp_w_in': nrm(ks[5], (N_GMLP_LAYERS, D_MODEL, 2 * GMLP_WIDTH), D_MODEL ** -0.5),
        'gmlp_b_in': nrm(ks[6], (N_GMLP_LAYERS, 2 * GMLP_WIDTH), 0.02),
        'gmlp_vnorm_g': 1.0 + nrm(ks[7], (N_GMLP_LAYERS, GMLP_WIDTH), 0.02),
        'gmlp_vnorm_b': nrm(ks[8], (N_GMLP_LAYERS, GMLP_WIDTH), 0.02),
        'gmlp_w_s': nrm(ks[9], (N_GMLP_LAYERS, GMLP_GROUPS, GMLP_CHUNK, GMLP_CHUNK), GMLP_CHUNK ** -0.5),
        'gmlp_b_s': 1.0 + nrm(ks[10], (N_GMLP_LAYERS, GMLP_GROUPS, GMLP_CHUNK), 0.02),
        'gmlp_w_out': nrm(ks[11], (N_GMLP_LAYERS, GMLP_WIDTH, D_MODEL), GMLP_WIDTH ** -0.5 * DEEPNORM_BETA),
        'router_w': nrm(ks[12], (DEPTH, D_MODEL, N_EXPERTS), D_MODEL ** -0.5),
        'router_b': nrm(ks[13], (DEPTH, N_EXPERTS), 0.01),
        'expert_w_gu': nrm(ks[14], (DEPTH, N_EXPERTS, D_MODEL, 2 * EXPERT_FF), D_MODEL ** -0.5),
        'expert_b_gu': nrm(ks[15], (DEPTH, N_EXPERTS, 2 * EXPERT_FF), 0.02),
        'expert_w_down': nrm(ks[16], (DEPTH, N_EXPERTS, EXPERT_FF, D_MODEL), EXPERT_FF ** -0.5 * DEEPNORM_BETA),
        'expert_b_down': nrm(ks[17], (DEPTH, N_EXPERTS, D_MODEL), 0.02),
        'ln_g': 1.0 + nrm(ks[18], (DEPTH, 2, D_MODEL), 0.02),
        'ln_b': nrm(ks[19], (DEPTH, 2, D_MODEL), 0.02),
    }


def reference(x, mlstm_w_in, mlstm_b_gates, mlstm_norm_g, mlstm_w_out,
              gmlp_w_in, gmlp_b_in, gmlp_vnorm_g, gmlp_vnorm_b, gmlp_w_s, gmlp_b_s, gmlp_w_out,
              router_w, router_b, expert_w_gu, expert_b_gu, expert_w_down, expert_b_down,
              ln_g, ln_b):
    for layer in range(DEPTH):
        j = layer // N_MIXERS
        if layer % N_MIXERS == 0:
            mix = mlstm_mixer(x, mlstm_w_in[j], mlstm_b_gates[j], mlstm_norm_g[j], mlstm_w_out[j])
        else:
            mix = gmlp_mixer(x, gmlp_w_in[j], gmlp_b_in[j], gmlp_vnorm_g[j], gmlp_vnorm_b[j],
                             gmlp_w_s[j], gmlp_b_s[j], gmlp_w_out[j])
        x = layer_norm(DEEPNORM_ALPHA * x + mix, ln_g[layer, 0], ln_b[layer, 0])
        ffn = moe(x, router_w[layer], router_b[layer], expert_w_gu[layer], expert_b_gu[layer],
                  expert_w_down[layer], expert_b_down[layer])
        x = layer_norm(DEEPNORM_ALPHA * x + ffn, ln_g[layer, 1], ln_b[layer, 1])
    return x
```

```cpp
#include <utility>
#include <type_traits>
#include <hip/hip_runtime.h>
#include <cstdio>
#include <cstdint>

#define LAS __attribute__((address_space(3)))
#define GAS __attribute__((address_space(1)))
typedef unsigned short bf16;
typedef short bf16x8 __attribute__((ext_vector_type(8)));
typedef short s16x4 __attribute__((ext_vector_type(4)));
typedef float f32x4 __attribute__((ext_vector_type(4)));
typedef float f32x2 __attribute__((ext_vector_type(2)));
typedef unsigned u32x4 __attribute__((ext_vector_type(4)));
typedef unsigned u32x2 __attribute__((ext_vector_type(2)));
typedef GAS unsigned gu32;
#define RLX_AGENT __ATOMIC_RELAXED, __HIP_MEMORY_SCOPE_AGENT

constexpr int T = 16384, D = 2048, DEPTH = 4, SEQ = 4096, NBATCH = 4;
constexpr int NE = 32, TOPK = 4, FF = 512;
constexpr int HEADS = 8, DV = 256, DK = 128, QKW = 1024, VW = 2048, MIN_COLS = 6176, MIN_MAIN = 6144;
constexpr int CAP = T;
constexpr int MAXSLOT = T * TOPK + NE * 256;
constexpr float ALPHA = 1.6817928305074290f;
constexpr float LN_EPS = 1e-5f;
constexpr float Y_SCALE = 16.0f;
constexpr int NWAVES = 8, NTHREADS = 512;
#ifndef EXP_NO_MOE
#define EXP_NO_MOE 0
#endif

constexpr size_t MiB = 1u << 20;
constexpr size_t WS_CTL = 0, CTL_ZERO_BYTES = 1 * MiB;
constexpr size_t WS_WGU = 1 * MiB;
constexpr size_t WS_WDN = WS_WGU + 512 * MiB;
constexpr size_t WS_WMI = WS_WDN + 256 * MiB;
constexpr size_t WS_WMO = WS_WMI + 48 * MiB;
constexpr size_t WS_WGI = WS_WMO + 16 * MiB;
constexpr size_t WS_WGO = WS_WGI + 32 * MiB;
constexpr size_t WS_WSM = WS_WGO + 16 * MiB;
constexpr size_t WS_WG_T = WS_WSM, WS_WR_T = WS_WSM + 256 * 1024, WS_WS = WS_WSM + 768 * 1024;
constexpr size_t WS_XB = WS_WSM + 2 * MiB;
constexpr size_t WS_X1 = WS_XB + 64 * MiB;
constexpr size_t WS_PRE = WS_X1 + 64 * MiB;
constexpr size_t WS_MIX = WS_PRE + 64 * MiB;
constexpr size_t WS_HACT = WS_MIX + 384 * MiB;
constexpr size_t WS_Y = WS_HACT + 72 * MiB;
constexpr size_t WS_LIST = WS_Y + 288 * MiB;
constexpr size_t WS_TOK = WS_LIST + 2 * MiB;
constexpr size_t WS_GATES = WS_TOK + 1 * MiB;
constexpr size_t WS_X1F8 = WS_GATES + 2 * MiB;
constexpr size_t WS_END = WS_X1F8 + 32 * MiB;

constexpr size_t WS_GU = WS_MIX, WS_GV = WS_MIX + 64 * MiB, WS_GY = WS_MIX + 128 * MiB, WS_VSTAT = WS_MIX + 192 * MiB;
constexpr size_t WS_MQ = WS_MIX, WS_MK = WS_MIX + 32 * MiB, WS_MV = WS_MIX + 64 * MiB, WS_MO = WS_MIX + 128 * MiB, WS_HF = WS_MIX + 192 * MiB, WS_HB = WS_MIX + 256 * MiB, WS_HG = WS_MIX + 320 * MiB;
constexpr int CW_TMO = 0, CW_CODE = 1, CW_BAR = 4096, CW_CNT = 8192;

constexpr int RING_BYTES = 131072;
constexpr int LDS_BYTES = 163840;
constexpr int LDSX_OFF = LDS_BYTES - 4096;
constexpr int XW_BAR = 8, XW_LCNT = 64, XW_LBASE = 96, XW_CNT = 128, XW_TPRE = 160, XW_PSTART = 200, XW_NTILES = 232, XW_TILE_E = 256, XW_INP = 600, XW_WORDS = 1024;
constexpr int XT_PITCH = 4112;
constexpr int RP_PART = 66048, RP_LOG = 82944, LOGP = 36, RP_GB = 90112, RP_LOGA = 106496;

__device__ __forceinline__ unsigned f2bf(float f) { unsigned u = __builtin_bit_cast(unsigned, f); return (u + 0x7fffu + ((u >> 16) & 1u)) >> 16; }
__device__ __forceinline__ unsigned cvt_pk_bf16_nop(float lo, float hi) { unsigned r; asm volatile("v_cvt_pk_bf16_f32 %0, %1, %2\n\ts_nop 1" : "=v"(r) : "v"(lo), "v"(hi)); return r; }
__device__ __forceinline__ unsigned cvt_pk_bf16(float lo, float hi) { unsigned r; asm volatile("v_cvt_pk_bf16_f32 %0, %1, %2" : "=v"(r) : "v"(lo), "v"(hi)); return r; }
__device__ __forceinline__ float bf_lo(unsigned w) { return __builtin_bit_cast(float, w << 16); }
__device__ __forceinline__ float bf_hi(unsigned w) { return __builtin_bit_cast(float, w & 0xffff0000u); }
__device__ __forceinline__ float wave_sum(float v) {
#pragma unroll
    for (int o = 1; o < 64; o <<= 1) v += __shfl_xor(v, o);
    return v;
}
#define LDS_WAIT() asm volatile("s_waitcnt lgkmcnt(0)" ::: "memory")
#define VM_WAIT() asm volatile("s_waitcnt vmcnt(0)" ::: "memory")

namespace pg8 {
constexpr int BM = 256, BK = 64, HALF = 128, HTB = HALF * BK * 2, STAGE_BYTES = 8 * HTB, NXCD = 8, WGM = 8;
__host__ __device__ __forceinline__ int lds_byte(int r, int c) { const int st = (r >> 4) * 2 + (c >> 5), rr = r & 15, cc = c & 31, ob = rr * 64 + cc * 2; return st * 1024 + (ob ^ (((ob >> 9) & 1) << 5)); }
__host__ __device__ __forceinline__ void stage_rc(int b, int& R, int& C) { const int st = b / 1024, sb = b % 1024, swz = sb ^ (((sb >> 9) & 1) << 5); R = (st >> 1) * 16 + swz / 64; C = (st & 1) * 32 + (swz % 64) / 2; }
__host__ __device__ __forceinline__ int perm32(int rho) { const int n = rho >> 4, i = rho & 15; return 8 * (i >> 2) + 4 * n + (i & 3); }

struct Unit { int pm, pn, e, x; };
typedef int v8i_t __attribute__((ext_vector_type(8)));
typedef int v4i_t __attribute__((ext_vector_type(4)));
__device__ __forceinline__ v8i_t cat_v8(bf16x8 lo, bf16x8 hi) { return __builtin_shufflevector(__builtin_bit_cast(v4i_t, lo), __builtin_bit_cast(v4i_t, hi), 0, 1, 2, 3, 4, 5, 6, 7); }

__device__ __forceinline__ void mfma_f8_tied(f32x4& acc, v8i_t a, v8i_t b, int sa, int sb) {
    asm volatile("v_mfma_scale_f32_16x16x128_f8f6f4 %0, %1, %2, %0, %3, %4 op_sel_hi:[0,0,0]" : "+v"(acc) : "v"(a), "v"(b), "v"(sa), "v"(sb));
}
__device__ __forceinline__ int xcd_remap(int wgid, int nwg) { const int q = nwg / NXCD, r = nwg % NXCD, xcd = wgid % NXCD, off = wgid / NXCD; return (xcd < r ? xcd * (q + 1) : r * (q + 1) + (xcd - r) * q) + off; }

template <class Prob, bool ALIGN_EPI = true>
__device__ __forceinline__ void gemm_phase(LAS unsigned char* lds, const Prob& P, int wave_id) {
    int wid = wave_id; asm volatile("" : "+s"(wid)); unsigned z_ = 0u; asm volatile("" : "+v"(z_)); const int lane = (int)__builtin_amdgcn_mbcnt_hi(~0u, __builtin_amdgcn_mbcnt_lo(~0u, z_));
    const int tid = wid * 64 + lane, wr = wid >> 2, wc = wid & 3, fr = lane & 15, fq = lane >> 4;
    constexpr int K = Prob::K, nt = K / BK;
    unsigned voffB[2];
#pragma unroll
    for (int i = 0; i < 2; ++i) { int R, C; stage_rc(tid * 16 + i * 8192, R, C); const int Rb = Prob::PERM ? ((R & ~31) + perm32(R & 31)) : R;
        voffB[i] = (unsigned)(Rb * K + C) * 2u; }
    const size_t kstep = (size_t)(BK * 2);
    const size_t hstep = (size_t)HALF * K * 2;
    const unsigned ldsw = (unsigned)wid * 1024u;
    const int aoff = lds_byte(wr * 64 + fr, fq * 8), boff = lds_byte(wc * 32 + fr, fq * 8);
#define PG8_SA(b, h) (((b) * 2 + (h)) * HTB)
#define PG8_SB(b, h) ((4 + (b) * 2 + (h)) * HTB)
#define PG8_STAGE(bufoff, gbase, v0, v1) do { \
        __builtin_amdgcn_global_load_lds((const unsigned*)((const char*)(gbase) + (v0)), (LAS unsigned*)(lds + (bufoff) + ldsw), 16, 0, 0); \
        __builtin_amdgcn_global_load_lds((const unsigned*)((const char*)(gbase) + (v1)), (LAS unsigned*)(lds + (bufoff) + ldsw + 8192), 16, 0, 0); } while (0)
#define PG8_STB(bufoff, gbase) PG8_STAGE(bufoff, gbase, voffB[0], voffB[1])
#define PG8_LDA(dst, b, h) do { _Pragma("unroll") for (int m = 0; m < 4; ++m) _Pragma("unroll") for (int k = 0; k < 2; ++k) dst[m][k] = *(const LAS bf16x8*)(lds + PG8_SA(b, h) + aoff + m * 2048 + k * 1024); } while (0)
#define PG8_LDB(dst, b, h) do { _Pragma("unroll") for (int n = 0; n < 2; ++n) _Pragma("unroll") for (int k = 0; k < 2; ++k) dst[n][k] = *(const LAS bf16x8*)(lds + PG8_SB(b, h) + boff + n * 2048 + k * 1024); } while (0)
#define PG8_MMA(ai, bj, At, Bt) do { __builtin_amdgcn_s_setprio(1); \
        if constexpr (Prob::FP8) { asm volatile("s_nop 1" ::: "memory"); _Pragma("unroll") for (int m = 0; m < 4; ++m) _Pragma("unroll") for (int n = 0; n < 2; ++n) \
            mfma_f8_tied(acc[ai][bj][m][n], cat_v8(Bt[n][0], Bt[n][1]), cat_v8(At[m][0], At[m][1]), sc_w, sc_x); } \
        else { _Pragma("unroll") for (int m = 0; m < 4; ++m) _Pragma("unroll") for (int n = 0; n < 2; ++n) _Pragma("unroll") for (int k = 0; k < 2; ++k) \
            acc[ai][bj][m][n] = __builtin_amdgcn_mfma_f32_16x16x32_bf16(Bt[n][k], At[m][k], acc[ai][bj][m][n], 0, 0, 0); } \
        __builtin_amdgcn_s_setprio(0); } while (0)
#define PG8_WAIT_V(n) asm volatile("s_waitcnt vmcnt(" #n ")" ::: "memory")
#define PG8_WAIT_L(n) asm volatile("s_waitcnt lgkmcnt(" #n ")" ::: "memory")
#define PG8_BAR __builtin_amdgcn_s_barrier()
#define PG8_SCHED __builtin_amdgcn_sched_barrier(0)
    Unit cur, nxt; int ui = 0;
    if (!P.next(0, cur)) return;
    int sc_w = Prob::SCALE_B, sc_x = 0x7f7f7f7f; if constexpr (Prob::FP8) { asm volatile("" : "+v"(sc_w), "+v"(sc_x)); }
    float zf_ = 0.f; asm volatile("" : "+v"(zf_)); const f32x4 zero4 = (f32x4){zf_, zf_, zf_, zf_};
    f32x4 acc[2][2][4][2];
#pragma unroll
    for (int a = 0; a < 2; ++a)
#pragma unroll
        for (int b = 0; b < 2; ++b)
#pragma unroll
            for (int m = 0; m < 4; ++m)
#pragma unroll
                for (int n = 0; n < 2; ++n) acc[a][b][m][n] = zero4;
    bf16x8 At[4][2], B0[2][2], B1[2][2];
    const char* cA; const char* cB; unsigned va[2][2], vn[2][2];
    P.bases(cur, cA, cB); P.avoff(cur, tid, va);
    PG8_STB(PG8_SB(0, 0), cB); PG8_STB(PG8_SB(0, 1), cB + hstep); PG8_STAGE(PG8_SA(0, 0), cA, va[0][0], va[0][1]); PG8_STAGE(PG8_SA(0, 1), cA, va[1][0], va[1][1]);
    if (wr == 1) PG8_BAR;
    PG8_WAIT_V(2); PG8_BAR;
    PG8_STB(PG8_SB(1, 0), cB + kstep); PG8_STAGE(PG8_SA(1, 0), cA + kstep, va[0][0], va[0][1]); PG8_STB(PG8_SB(1, 1), cB + hstep + kstep);
    PG8_WAIT_V(6); PG8_BAR;
    for (;;) {
        const bool has_next = P.next(ui + 1, nxt);
        const char* nA = cA; const char* nB = cB;
#pragma unroll
        for (int h = 0; h < 2; ++h)
#pragma unroll
            for (int i = 0; i < 2; ++i) vn[h][i] = va[h][i];
        if (has_next) { P.bases(nxt, nA, nB); P.avoff(nxt, tid, vn); }
        for (int t = 0; t < nt; t += 2) {
            const bool last = (t == nt - 2);
            const char* a1 = cA + (size_t)(t + 1) * kstep;
            const char* a2 = last ? nA : cA + (size_t)(t + 2) * kstep; const char* b2 = last ? nB : cB + (size_t)(t + 2) * kstep;
            const char* a3 = a2 + kstep; const char* b3 = b2 + kstep;
            const unsigned s00 = last ? vn[0][0] : va[0][0], s01 = last ? vn[0][1] : va[0][1], s10 = last ? vn[1][0] : va[1][0], s11 = last ? vn[1][1] : va[1][1];
            PG8_LDB(B0, 0, 0); PG8_LDB(B1, 0, 1); PG8_SCHED; PG8_LDA(At, 0, 0); PG8_STAGE(PG8_SA(1, 1), a1, va[1][0], va[1][1]);
            PG8_WAIT_V(8); PG8_WAIT_L(0); PG8_BAR; PG8_MMA(0, 0, At, B0); PG8_MMA(0, 1, At, B1); PG8_BAR; PG8_SCHED;
            PG8_LDA(At, 0, 1); PG8_STB(PG8_SB(0, 0), b2); PG8_STB(PG8_SB(0, 1), b2 + hstep); PG8_STAGE(PG8_SA(0, 0), a2, s00, s01);
            PG8_WAIT_V(8); PG8_WAIT_L(0); PG8_BAR; PG8_MMA(1, 0, At, B0); PG8_MMA(1, 1, At, B1); PG8_BAR; PG8_SCHED;
            PG8_LDB(B0, 1, 0); PG8_LDB(B1, 1, 1); PG8_SCHED; PG8_LDA(At, 1, 0); PG8_STAGE(PG8_SA(0, 1), a2, s10, s11);
            PG8_WAIT_V(8); PG8_WAIT_L(0); PG8_BAR; PG8_MMA(0, 0, At, B0); PG8_MMA(0, 1, At, B1); PG8_BAR; PG8_SCHED;
            PG8_LDA(At, 1, 1); PG8_STB(PG8_SB(1, 0), b3); PG8_STB(PG8_SB(1, 1), b3 + hstep); PG8_STAGE(PG8_SA(1, 0), a3, s00, s01);
            PG8_WAIT_V(8); PG8_WAIT_L(0); PG8_BAR; PG8_MMA(1, 0, At, B0); PG8_MMA(1, 1, At, B1); PG8_BAR; PG8_SCHED;
        }
        if constexpr (ALIGN_EPI) { if (wr == 0) PG8_BAR; }
        if constexpr (Prob::FP8) asm volatile("s_nop 15\n\ts_nop 15" ::: "memory");
        P.epi(acc, cur, wr, wc, fr, fq);
        if (!has_next) break;
#pragma unroll
        for (int a = 0; a < 2; ++a)
#pragma unroll
            for (int b = 0; b < 2; ++b)
#pragma unroll
                for (int m = 0; m < 4; ++m)
#pragma unroll
                    for (int n = 0; n < 2; ++n) acc[a][b][m][n] = zero4;
        cur = nxt; cA = nA; cB = nB; ++ui;
#pragma unroll
        for (int h = 0; h < 2; ++h)
#pragma unroll
            for (int i = 0; i < 2; ++i) va[h][i] = vn[h][i];
        if constexpr (ALIGN_EPI) { if (wr == 1) PG8_BAR; }
    }
    PG8_WAIT_V(0);
    if constexpr (!ALIGN_EPI) { if (wr == 0) PG8_BAR; }
    PG8_BAR;
#undef PG8_SA
#undef PG8_SB
#undef PG8_STAGE
#undef PG8_STB
#undef PG8_LDA
#undef PG8_LDB
#undef PG8_MMA
#undef PG8_WAIT_V
#undef PG8_WAIT_L
#undef PG8_BAR
#undef PG8_SCHED
}
}

#define XB_TMO      128
#define XB_XCNT(j)  (256  + 64 * (j))
#define XB_XSUB(j)  (1280 + 64 * (j))
#define XB_XGEN(j)  (2304 + 64 * (j))
#define XB_TOP      3328
#define XB_TOPGEN   3392
#define XCD_BAR_WORDS 3456
#define XB_SPIN_CAP (1u << 18)
__device__ __forceinline__ unsigned xb_ld(unsigned* p)              { return __hip_atomic_load(p, __ATOMIC_RELAXED, __HIP_MEMORY_SCOPE_AGENT); }
__device__ __forceinline__ unsigned xb_add(unsigned* p, unsigned v) { return __hip_atomic_fetch_add(p, v, __ATOMIC_RELAXED, __HIP_MEMORY_SCOPE_AGENT); }
__device__ __forceinline__ unsigned xb_xcc_id() { return (unsigned)__builtin_amdgcn_s_getreg((3 << 11) | 20) & 0xFu; }
#define XB_SPIN(cond, bar) do { unsigned _sp = 0; while (cond) { __builtin_amdgcn_s_sleep(1); \
    if ((++_sp & 255u) == 0u) { if (xb_ld(&(bar)[XB_TMO])) break; if (_sp > XB_SPIN_CAP) { atomicAdd(&(bar)[XB_TMO], 1u); break; } } } } while (0)
struct XcdBarrier { unsigned* bar; unsigned x; volatile LAS unsigned* st; };
__device__ __forceinline__ XcdBarrier xcd_barrier_post(unsigned* bar, volatile LAS unsigned* st) {
    XcdBarrier b; b.bar = bar; b.x = xb_xcc_id(); b.st = st;
    if (threadIdx.x == 0) (void)xb_add(&bar[XB_XCNT(b.x)], 1u);
    return b;
}
__device__ __forceinline__ void xcd_barrier_complete(unsigned* bar, unsigned x, unsigned& nloc, unsigned& nx) {
    const unsigned G = gridDim.x * gridDim.y * gridDim.z;
    unsigned sum, cnt, mine, sp = 0u;
    for (;;) {
        sum = 0u; cnt = 0u; mine = 0u;
#pragma unroll
        for (unsigned j = 0; j < 16; ++j) { const unsigned c = xb_ld(&bar[XB_XCNT(j)]); sum += c; cnt += (c > 0u) ? 1u : 0u; mine = (j == x) ? c : mine; }
        if (sum == G) break;
        __builtin_amdgcn_s_sleep(1);
        if ((++sp & 255u) == 0u) { if (xb_ld(&bar[XB_TMO])) break; if (sp > XB_SPIN_CAP) { atomicAdd(&bar[XB_TMO], 1u); break; } }
    }
    nloc = mine > 0u ? mine : 1u; nx = cnt > 0u ? cnt : 1u;
}
__device__ __forceinline__ void xcd_barrier(const XcdBarrier& b, bool is_t0) {
    asm volatile("s_waitcnt vmcnt(0)" ::: "memory");
    __syncthreads();
    if (is_t0) {
        unsigned* bar = b.bar;
        __builtin_amdgcn_s_waitcnt(0);
        unsigned nloc = b.st[0], nx = b.st[1];
        if (nloc == 0u) { xcd_barrier_complete(bar, b.x, nloc, nx); b.st[0] = nloc; b.st[1] = nx; }
        const unsigned old = xb_add(&bar[XB_XSUB(b.x)], 1u);
        const unsigned gen = old / nloc;
        if (old + 1u == (gen + 1u) * nloc) {
            __builtin_amdgcn_fence(__ATOMIC_RELEASE, "agent");
            asm volatile("s_waitcnt vmcnt(0)" ::: "memory");
            const unsigned og = xb_add(&bar[XB_TOP], 1u);
            const unsigned tg = og / nx;
            if (og + 1u == (tg + 1u) * nx) xb_add(&bar[XB_TOPGEN], 1u);
            else XB_SPIN(xb_ld(&bar[XB_TOPGEN]) == tg, bar);
            __builtin_amdgcn_fence(__ATOMIC_ACQUIRE, "agent");
            xb_add(&bar[XB_XGEN(b.x)], 1u);
            asm volatile("s_waitcnt vmcnt(0)" ::: "memory");
        } else {
            XB_SPIN(xb_ld(&bar[XB_XGEN(b.x)]) == gen, bar);
            __builtin_amdgcn_fence(__ATOMIC_ACQUIRE, "agent");
            asm volatile("s_waitcnt vmcnt(0)" ::: "memory");
        }
    }
    __syncthreads();
}

struct Frame {
    LAS unsigned char* lds;
    LAS unsigned* X;
    unsigned char* ws_;
    int tid, lane, wave, G;
    __device__ __forceinline__ unsigned char* wsp() const { unsigned char* p = ws_; asm volatile("" : "+s"(p)); return p; }
    __device__ __forceinline__ gu32* ctlp() const { return (gu32*)(wsp() + WS_CTL); }
    __device__ __forceinline__ float* outp() const { return (float*)inp(20); }
    __device__ __forceinline__ const float* inp(int i) const { const unsigned lo = __builtin_amdgcn_readfirstlane(X[XW_INP + 2 * i]), hi = __builtin_amdgcn_readfirstlane(X[XW_INP + 2 * i + 1]);
        return (const float*)(((unsigned long long)hi << 32) | lo); }
    int wave0;
    __device__ __forceinline__ void rethread() { int w = wave0; asm volatile("" : "+s"(w)); unsigned z = 0u; asm volatile("" : "+v"(z)); const int l = (int)__builtin_amdgcn_mbcnt_hi(~0u, __builtin_amdgcn_mbcnt_lo(~0u, z)); wave = w; lane = l; tid = w * 64 + l; }
};
enum { I_X = 0, I_MWIN, I_MBG, I_MNG, I_MWOUT, I_GWIN, I_GBIN, I_GVG, I_GVB, I_GWS, I_GBS, I_GWOUT, I_RW, I_RB, I_EWGU, I_EBGU, I_EWDN, I_EBDN, I_LNG, I_LNB };

constexpr int TR_P = 65, TR_WAVE_BYTES = 64 * TR_P * 4;
__device__ __forceinline__ void tr_item64(const float* W, int N, int k0, int n0, bf16* dst, int Kd, LAS float* scr, int lane) {
    f32x4 v[16];
#pragma unroll
    for (int i = 0; i < 16; ++i) v[i] = *(const GAS f32x4*)(W + (size_t)(k0 + 4 * i + (lane >> 4)) * N + n0 + (lane & 15) * 4);
#pragma unroll
    for (int i = 0; i < 16; ++i) { LAS float* p = scr + (4 * i + (lane >> 4)) * TR_P + (lane & 15) * 4; p[0] = v[i].x; p[1] = v[i].y; p[2] = v[i].z; p[3] = v[i].w; }
    LDS_WAIT(); asm volatile("" ::: "memory");
    const int c = lane & 7;
#pragma unroll
    for (int j = 0; j < 8; ++j) { const int n = (lane >> 3) + 8 * j; const LAS float* s = scr + (8 * c) * TR_P + n;
        u32x4 o; o.x = cvt_pk_bf16(s[0 * TR_P], s[1 * TR_P]); o.y = cvt_pk_bf16(s[2 * TR_P], s[3 * TR_P]); o.z = cvt_pk_bf16(s[4 * TR_P], s[5 * TR_P]); o.w = cvt_pk_bf16(s[6 * TR_P], s[7 * TR_P]);
        *(GAS u32x4*)(dst + (size_t)n * Kd + k0 + 8 * c) = o; }
    LDS_WAIT(); asm volatile("" ::: "memory");
}
__device__ __forceinline__ void tr_item64_f8(const float* W, int N, int k0, int n0, unsigned char* dst, int Kd, LAS float* scr, int lane, float wscale = 64.f) {
    f32x4 v[16];
#pragma unroll
    for (int i = 0; i < 16; ++i) v[i] = *(const GAS f32x4*)(W + (size_t)(k0 + 4 * i + (lane >> 4)) * N + n0 + (lane & 15) * 4);
#pragma unroll
    for (int i = 0; i < 16; ++i) { LAS float* p = scr + (4 * i + (lane >> 4)) * TR_P + (lane & 15) * 4; p[0] = v[i].x; p[1] = v[i].y; p[2] = v[i].z; p[3] = v[i].w; }
    LDS_WAIT(); asm volatile("" ::: "memory");
    const int c = lane & 3;
#pragma unroll
    for (int j = 0; j < 4; ++j) { const int n = (lane >> 2) + 16 * j; const LAS float* s = scr + (16 * c) * TR_P + n; unsigned w[4];
#pragma unroll
        for (int g = 0; g < 4; ++g) { int a_ = 0; a_ = __builtin_amdgcn_cvt_pk_fp8_f32(s[(4 * g) * TR_P] * wscale, s[(4 * g + 1) * TR_P] * wscale, a_, false); a_ = __builtin_amdgcn_cvt_pk_fp8_f32(s[(4 * g + 2) * TR_P] * wscale, s[(4 * g + 3) * TR_P] * wscale, a_, true); w[g] = (unsigned)a_; }
        *(GAS u32x4*)(dst + (size_t)n * Kd + k0 + 16 * c) = (u32x4){w[0], w[1], w[2], w[3]}; }
    LDS_WAIT(); asm volatile("" ::: "memory");
}
__device__ __forceinline__ void tr_item(const float* W, int N, int k0, int n0, bf16* dst, int Kd, LAS float* scr, int lane) {
#pragma unroll 8
    for (int i = 0; i < 32; ++i) { const int kk = 2 * i + (lane >> 5); scr[kk * 33 + (lane & 31)] = W[(size_t)(k0 + kk) * N + n0 + (lane & 31)]; }
    LDS_WAIT(); asm volatile("" ::: "memory");
    const int c = lane & 7;
#pragma unroll
    for (int j = 0; j < 4; ++j) { const int n = (lane >> 3) + 8 * j; const LAS float* s = scr + (8 * c) * 33 + n;
        u32x4 o; o.x = cvt_pk_bf16(s[0 * 33], s[1 * 33]); o.y = cvt_pk_bf16(s[2 * 33], s[3 * 33]); o.z = cvt_pk_bf16(s[4 * 33], s[5 * 33]); o.w = cvt_pk_bf16(s[6 * 33], s[7 * 33]);
        *(GAS u32x4*)(dst + (size_t)n * Kd + k0 + 8 * c) = o; }
    LDS_WAIT(); asm volatile("" ::: "memory");
}

constexpr int CVT_ITEMS = 32 * 32 * 16 + 32 * 8 * 32, CW_CVT = 24576, XW_CVT = 660;
__device__ __forceinline__ void cvt_moe_item(Frame& F, int L, int idx, LAS float* scr) {
    if (idx < 32 * 512) { const int le = L * 32 + idx / 512, q = idx % 512, kb = q % 32, nb = q / 32;
        const int n0 = nb * 64, half = n0 >> 9, nn = n0 & 511, row = (nn >> 7) * 256 + half * 128 + (nn & 127);
        tr_item64_f8(F.inp(I_EWGU) + (size_t)le * D * 1024, 1024, kb * 64, n0, (unsigned char*)(F.wsp() + WS_WGU) + ((size_t)le * 1024 + row) * D, D, scr, F.lane); }
    else { const int r = idx - 32 * 512; const int le = L * 32 + r / 256, q = r % 256, kb = q % 8, nb = q / 8;
        tr_item64_f8(F.inp(I_EWDN) + (size_t)le * FF * D, D, kb * 64, nb * 64, (unsigned char*)(F.wsp() + WS_WDN) + ((size_t)le * D + nb * 64) * FF, FF, scr, F.lane); }
}
__device__ __forceinline__ void cvt_fill(Frame& F, int L, int max_batches) {
    F.rethread();
    LAS float* scr = (LAS float*)(F.lds + F.wave * TR_WAVE_BYTES);
    gu32* ctr = F.ctlp() + CW_CVT + L * 64;
#pragma unroll 1
    for (int bt = 0; max_batches < 0 || bt < max_batches; ++bt) {
        if (F.tid == 0) F.X[XW_CVT] = __hip_atomic_fetch_add(ctr, 8u, RLX_AGENT);
        __syncthreads();
        const int base = (int)F.X[XW_CVT];
        __syncthreads();
        if (base >= CVT_ITEMS) break;
        const int idx = base + F.wave; if (idx < CVT_ITEMS) cvt_moe_item(F, L, idx, scr);
    }
    __syncthreads();
}
constexpr int P0_S0 = 2 * 32 * 96, P0_S1 = 2 * 32 * 32, P0_S2 = 2 * 32 * 64, P0_S3 = 2 * 32 * 32, P0_NI64 = P0_S0 + P0_S1 + P0_S2 + P0_S3 + CVT_ITEMS;
__device__ __forceinline__ void p0a_decode(Frame& F, int it, const float*& src, int& N, unsigned char*& dst, int& Kd, int& f8, float& scale) {
    int r = it;
    if (r < P0_S0) { const int j = r / (32 * 96), q = r % (32 * 96), kb = q % 32, nb = q / 32;
        src = F.inp(I_MWIN) + (size_t)j * D * MIN_COLS + (size_t)(kb * 64) * MIN_COLS + nb * 64; N = MIN_COLS; dst = (unsigned char*)((bf16*)(F.wsp() + WS_WMI) + ((size_t)j * MIN_MAIN + nb * 64) * D + kb * 64); Kd = D; f8 = 0; scale = 1.f; return; } r -= P0_S0;
    if (r < P0_S1) { const int j = r / 1024, q = r % 1024, kb = q % 32, nb = q / 32;
        src = F.inp(I_MWOUT) + (size_t)j * D * D + (size_t)(kb * 64) * D + nb * 64; N = D; dst = (unsigned char*)(F.wsp() + WS_WMO) + ((size_t)j * D + nb * 64) * D + kb * 64; Kd = D; f8 = 1; scale = 128.f; return; } r -= P0_S1;
    if (r < P0_S2) { const int j = r / 2048, q = r % 2048, kb = q % 32, nb = q / 32;
        src = F.inp(I_GWIN) + (size_t)j * D * 4096 + (size_t)(kb * 64) * 4096 + nb * 64; N = 4096; dst = (unsigned char*)((bf16*)(F.wsp() + WS_WGI) + ((size_t)j * 4096 + nb * 64) * D + kb * 64); Kd = D; f8 = 0; scale = 1.f; return; } r -= P0_S2;
    if (r < P0_S3) { const int j = r / 1024, q = r % 1024, kb = q % 32, nb = q / 32;
        src = F.inp(I_GWOUT) + (size_t)j * D * D + (size_t)(kb * 64) * D + nb * 64; N = D; dst = (unsigned char*)(F.wsp() + WS_WGO) + ((size_t)j * D + nb * 64) * D + kb * 64; Kd = D; f8 = 1; scale = 128.f; return; } r -= P0_S3;
    f8 = 1; scale = 64.f;
    if (r < 32 * 512) { const int le = r / 512, q = r % 512, kb = q % 32, nb = q / 32; const int n0 = nb * 64, half = n0 >> 9, nn = n0 & 511, row = (nn >> 7) * 256 + half * 128 + (nn & 127);
        src = F.inp(I_EWGU) + (size_t)le * D * 1024 + (size_t)(kb * 64) * 1024 + n0; N = 1024; dst = (unsigned char*)(F.wsp() + WS_WGU) + ((size_t)le * 1024 + row) * D + kb * 64; Kd = D; }
    else { r -= 32 * 512; const int le = r / 256, q = r % 256, kb = q % 8, nb = q / 8;
        src = F.inp(I_EWDN) + (size_t)le * FF * D + (size_t)(kb * 64) * D + nb * 64; N = D; dst = (unsigned char*)(F.wsp() + WS_WDN) + ((size_t)le * D + nb * 64) * FF + kb * 64; Kd = FF; }
}
__device__ __forceinline__ void tr_load64(const float* src, int N, int lane, f32x4 (&v)[16]) {
#pragma unroll
    for (int i = 0; i < 16; ++i) v[i] = *(const GAS f32x4*)(src + (size_t)(4 * i + (lane >> 4)) * N + (lane & 15) * 4);
}
__device__ __forceinline__ void tr_finish64(const f32x4 (&v)[16], unsigned char* dst, int Kd, int f8, float wscale, LAS float* scr, int lane) {
#pragma unroll
    for (int i = 0; i < 16; ++i) { LAS float* p = scr + (4 * i + (lane >> 4)) * TR_P + (lane & 15) * 4; p[0] = v[i].x; p[1] = v[i].y; p[2] = v[i].z; p[3] = v[i].w; }
    LDS_WAIT(); asm volatile("" ::: "memory");
    if (f8) { const int c = lane & 3;
#pragma unroll
        for (int j = 0; j < 4; ++j) { const int n = (lane >> 2) + 16 * j; const LAS float* s = scr + (16 * c) * TR_P + n; unsigned w[4];
#pragma unroll
            for (int g = 0; g < 4; ++g) { int a_ = 0; a_ = __builtin_amdgcn_cvt_pk_fp8_f32(s[(4 * g) * TR_P] * wscale, s[(4 * g + 1) * TR_P] * wscale, a_, false); a_ = __builtin_amdgcn_cvt_pk_fp8_f32(s[(4 * g + 2) * TR_P] * wscale, s[(4 * g + 3) * TR_P] * wscale, a_, true); w[g] = (unsigned)a_; }
            *(GAS u32x4*)(dst + (size_t)n * Kd + 16 * c) = (u32x4){w[0], w[1], w[2], w[3]}; } }
    else { const int c = lane & 7;
#pragma unroll
        for (int j = 0; j < 8; ++j) { const int n = (lane >> 3) + 8 * j; const LAS float* s = scr + (8 * c) * TR_P + n;
            u32x4 o; o.x = cvt_pk_bf16(s[0 * TR_P], s[1 * TR_P]); o.y = cvt_pk_bf16(s[2 * TR_P], s[3 * TR_P]); o.z = cvt_pk_bf16(s[4 * TR_P], s[5 * TR_P]); o.w = cvt_pk_bf16(s[6 * TR_P], s[7 * TR_P]);
            *(GAS u32x4*)((bf16*)dst + (size_t)n * Kd + 8 * c) = o; } }
    LDS_WAIT(); asm volatile("" ::: "memory");
}
__device__ __forceinline__ void p0a_weights(Frame& F) {
    F.rethread();
    LAS float* scr = (LAS float*)(F.lds + F.wave * TR_WAVE_BYTES);
    const int gw = blockIdx.x * NWAVES + F.wave, NGW = F.G * NWAVES;
    { f32x4 va[16], vb[16]; const float* sA; const float* sB; unsigned char* dA; unsigned char* dB; int nA, nB, kA, kB, fA, fB; float cA, cB;
      int it = gw;
      if (it < P0_NI64) { p0a_decode(F, it, sA, nA, dA, kA, fA, cA); tr_load64(sA, nA, F.lane, va);
#pragma unroll 1
        for (;;) {
            const bool haveB = it + NGW < P0_NI64; p0a_decode(F, haveB ? it + NGW : it, sB, nB, dB, kB, fB, cB); tr_load64(sB, nB, F.lane, vb);
            tr_finish64(va, dA, kA, fA, cA, scr, F.lane);
            if (!haveB) break;
            const bool haveA = it + 2 * NGW < P0_NI64; p0a_decode(F, haveA ? it + 2 * NGW : it + NGW, sA, nA, dA, kA, fA, cA); tr_load64(sA, nA, F.lane, va);
            tr_finish64(vb, dB, kB, fB, cB, scr, F.lane);
            if (!haveA) break;
            it += 2 * NGW; } } }
    { constexpr int SG = 2 * 32, S4 = 4 * 32;
      for (int it = gw; it < SG + S4; it += NGW) { int r = it;
        if (r < SG) { const int j = r / 32, kb = r % 32;
            tr_item(F.inp(I_MWIN) + (size_t)j * D * MIN_COLS, MIN_COLS, kb * 64, MIN_MAIN, (bf16*)(F.wsp() + WS_WG_T) + (size_t)j * 32 * D, D, scr, F.lane); continue; } r -= SG;
        { const int l = r / 32, kb = r % 32;
            tr_item(F.inp(I_RW) + (size_t)l * D * NE, NE, kb * 64, 0, (bf16*)(F.wsp() + WS_WR_T) + (size_t)l * 32 * D, D, scr, F.lane); } } }
    { const float* src = F.inp(I_GWS); bf16* dst = (bf16*)(F.wsp() + WS_WS); const int n4 = 2 * 8 * 128 * 128 / 4;
      for (int i = blockIdx.x * NTHREADS + F.tid; i < n4; i += F.G * NTHREADS) { const f32x4 v = ((const GAS f32x4*)src)[i]; u32x2 o; o.x = cvt_pk_bf16(v.x, v.y); o.y = cvt_pk_bf16(v.z, v.w); ((GAS u32x2*)dst)[i] = o; } }
}

__device__ __forceinline__ void skinny16(Frame& F, const bf16* WT, const float* bias) {
    LAS unsigned char* XT = F.lds; LAS float* PART = (LAS float*)(F.lds + RP_PART); LAS float* LOG = (LAS float*)(F.lds + RP_LOG);
    const int r = F.lane & 15, q = F.lane >> 4;
    float zf_ = 0.f; asm volatile("" : "+v"(zf_)); f32x4 acc0 = (f32x4){zf_, zf_, zf_, zf_}, acc1 = acc0;
#pragma unroll
    for (int ks = 0; ks < 8; ++ks) {
        const int k0 = F.wave * 256 + ks * 32 + 8 * q;
        const bf16x8 a = *(const LAS bf16x8*)(XT + r * XT_PITCH + k0 * 2);
        const bf16x8 b0 = *(const GAS bf16x8*)(WT + (size_t)r * D + k0);
        const bf16x8 b1 = *(const GAS bf16x8*)(WT + (size_t)(16 + r) * D + k0);
        acc0 = __builtin_amdgcn_mfma_f32_16x16x32_bf16(a, b0, acc0, 0, 0, 0);
        acc1 = __builtin_amdgcn_mfma_f32_16x16x32_bf16(a, b1, acc1, 0, 0, 0);
    }
#pragma unroll
    for (int i = 0; i < 4; ++i) { PART[(F.wave * 16 + 4 * q + i) * 33 + r] = acc0[i]; PART[(F.wave * 16 + 4 * q + i) * 33 + 16 + r] = acc1[i]; }
    __syncthreads();
    { const int row = F.tid >> 5, e = F.tid & 31; float s = bias[e];
#pragma unroll
      for (int w = 0; w < 8; ++w) s += PART[(w * 16 + row) * 33 + e];
      LOG[row * LOGP + e] = s; }
    __syncthreads();
}
__device__ __forceinline__ void load_lane_vec32(const float* p, int lane, float (&v)[32]) {
#pragma unroll
    for (int j = 0; j < 4; ++j) { const f32x4 a = *(const GAS f32x4*)(p + 8 * lane + 512 * j), b = *(const GAS f32x4*)(p + 8 * lane + 512 * j + 4);
        v[8 * j + 0] = a.x; v[8 * j + 1] = a.y; v[8 * j + 2] = a.z; v[8 * j + 3] = a.w; v[8 * j + 4] = b.x; v[8 * j + 5] = b.y; v[8 * j + 6] = b.z; v[8 * j + 7] = b.w; }
}
__device__ __forceinline__ void load_row_bf16(const bf16* row, int lane, float (&v)[32]) {
#pragma unroll
    for (int j = 0; j < 4; ++j) { const u32x4 w = *(const GAS u32x4*)(row + 8 * lane + 512 * j);
        v[8 * j + 0] = bf_lo(w.x); v[8 * j + 1] = bf_hi(w.x); v[8 * j + 2] = bf_lo(w.y); v[8 * j + 3] = bf_hi(w.y); v[8 * j + 4] = bf_lo(w.z); v[8 * j + 5] = bf_hi(w.z); v[8 * j + 6] = bf_lo(w.w); v[8 * j + 7] = bf_hi(w.w); }
}
__device__ __forceinline__ void layer_norm32(float (&v)[32], const float (&g)[32], const float (&b)[32]) {
    float s = 0.f;
#pragma unroll
    for (int i = 0; i < 32; ++i) s += v[i];
    const float mean = wave_sum(s) * (1.f / D); float s2 = 0.f;
#pragma unroll
    for (int i = 0; i < 32; ++i) { v[i] -= mean; s2 += v[i] * v[i]; }
    const float rstd = 1.f / sqrtf(wave_sum(s2) * (1.f / D) + LN_EPS);
#pragma unroll
    for (int i = 0; i < 32; ++i) v[i] = v[i] * rstd * g[i] + b[i];
}
__device__ __forceinline__ void layer_norm32_lds(float (&v)[32], const LAS float* GL, const LAS float* BL, int lane) {
    float s = 0.f;
#pragma unroll
    for (int i = 0; i < 32; ++i) s += v[i];
    const float mean = wave_sum(s) * (1.f / D); float s2 = 0.f;
#pragma unroll
    for (int i = 0; i < 32; ++i) { v[i] -= mean; s2 += v[i] * v[i]; }
    const float rstd = 1.f / sqrtf(wave_sum(s2) * (1.f / D) + LN_EPS);
#pragma unroll
    for (int j = 0; j < 4; ++j) { const f32x4 g0 = *(const LAS f32x4*)(GL + 8 * lane + 512 * j), g1 = *(const LAS f32x4*)(GL + 8 * lane + 512 * j + 4), b0 = *(const LAS f32x4*)(BL + 8 * lane + 512 * j), b1 = *(const LAS f32x4*)(BL + 8 * lane + 512 * j + 4);
        v[8 * j + 0] = v[8 * j + 0] * rstd * g0.x + b0.x; v[8 * j + 1] = v[8 * j + 1] * rstd * g0.y + b0.y; v[8 * j + 2] = v[8 * j + 2] * rstd * g0.z + b0.z; v[8 * j + 3] = v[8 * j + 3] * rstd * g0.w + b0.w;
        v[8 * j + 4] = v[8 * j + 4] * rstd * g1.x + b1.x; v[8 * j + 5] = v[8 * j + 5] * rstd * g1.y + b1.y; v[8 * j + 6] = v[8 * j + 6] * rstd * g1.z + b1.z; v[8 * j + 7] = v[8 * j + 7] * rstd * g1.w + b1.w; }
}
__device__ __forceinline__ void store_row_bf16(const float (&v)[32], bf16* grow, LAS unsigned char* xt_row, bool to_lds, int lane) {
#pragma unroll
    for (int j = 0; j < 4; ++j) { u32x4 w; w.x = cvt_pk_bf16(v[8 * j], v[8 * j + 1]); w.y = cvt_pk_bf16(v[8 * j + 2], v[8 * j + 3]); w.z = cvt_pk_bf16(v[8 * j + 4], v[8 * j + 5]); w.w = cvt_pk_bf16(v[8 * j + 6], v[8 * j + 7]);
        *(GAS u32x4*)(grow + 8 * lane + 512 * j) = w;
        if (to_lds) *(LAS u32x4*)(xt_row + (8 * lane + 512 * j) * 2) = w; }
}
__device__ __forceinline__ float log_sigmoid(float x);
__device__ __forceinline__ void p0b_rows(Frame& F) {
    F.rethread();
    const float* x = F.inp(I_X); bf16* XB = (bf16*)(F.wsp() + WS_XB); float* GT = (float*)(F.wsp() + WS_GATES);
    LAS float* LOG = (LAS float*)(F.lds + RP_LOG);
    for (int it = blockIdx.x; it < T / 16; it += F.G) {
#pragma unroll 1
        for (int rr = 0; rr < 2; ++rr) { const int r = F.wave * 2 + rr, t = it * 16 + r; float v[32];
            load_lane_vec32(x + (size_t)t * D, F.lane, v);
            store_row_bf16(v, XB + (size_t)t * D, F.lds + r * XT_PITCH, true, F.lane); }
        __syncthreads();
        skinny16(F, (const bf16*)(F.wsp() + WS_WG_T), F.inp(I_MBG));
        { const int row = F.tid >> 5, e = F.tid & 31; const float gval = LOG[row * LOGP + e]; GT[(size_t)(it * 16 + row) * 32 + e] = (e & 8) ? log_sigmoid(gval) : gval; }
    }
    __syncthreads();
}
__device__ __forceinline__ void r1_phase(Frame& F, int layer) {
    F.rethread();
    const bf16* PRE = (const bf16*)(F.wsp() + WS_PRE); bf16* X1 = (bf16*)(F.wsp() + WS_X1);
    int* LIST = (int*)(F.wsp() + WS_LIST); int* EIDX = (int*)(F.wsp() + WS_TOK); int* POS = (int*)(F.wsp() + WS_TOK + 256 * 1024); float* GATE = (float*)(F.wsp() + WS_TOK + 512 * 1024);
    LAS unsigned char* XT = F.lds; LAS float* PART = (LAS float*)(F.lds + RP_PART); LAS float* LOGA = (LAS float*)(F.lds + RP_LOGA);
    gu32* gcnt = F.ctlp() + CW_CNT + layer * 32 * 64;
    const int r16 = F.lane & 15, q = F.lane >> 4;
    float g[32], b[32];
    load_lane_vec32(F.inp(I_LNG) + (size_t)(layer * 2 + 0) * D, F.lane, g); load_lane_vec32(F.inp(I_LNB) + (size_t)(layer * 2 + 0) * D, F.lane, b);
    bf16x8 bw0[8], bw1[8];
    { const bf16* WT = (const bf16*)(F.wsp() + WS_WR_T) + (size_t)layer * 32 * D;
#pragma unroll
      for (int ks = 0; ks < 8; ++ks) { const int k0 = F.wave * 256 + ks * 32 + 8 * q; bw0[ks] = *(const GAS bf16x8*)(WT + (size_t)r16 * D + k0); bw1[ks] = *(const GAS bf16x8*)(WT + (size_t)(16 + r16) * D + k0); } }
    const float* rbias = F.inp(I_RB) + layer * NE;
    if (F.tid < 32) F.X[XW_LCNT + F.tid] = 0u;
    int nit = 0;
    for (int it = blockIdx.x; it < T / 16; it += F.G, ++nit) {
#pragma unroll 1
        for (int rr = 0; rr < 2; ++rr) { const int r = F.wave * 2 + rr, t = it * 16 + r; float v[32];
            load_row_bf16(PRE + (size_t)t * D, F.lane, v);
            layer_norm32(v, g, b);
            store_row_bf16(v, X1 + (size_t)t * D, XT + r * XT_PITCH, true, F.lane);
            { unsigned char* x8 = (unsigned char*)(F.wsp() + WS_X1F8) + (size_t)t * D;
#pragma unroll
              for (int j = 0; j < 4; ++j) { int a_ = 0, b_ = 0; a_ = __builtin_amdgcn_cvt_pk_fp8_f32(v[8 * j], v[8 * j + 1], a_, false); a_ = __builtin_amdgcn_cvt_pk_fp8_f32(v[8 * j + 2], v[8 * j + 3], a_, true);
                  b_ = __builtin_amdgcn_cvt_pk_fp8_f32(v[8 * j + 4], v[8 * j + 5], b_, false); b_ = __builtin_amdgcn_cvt_pk_fp8_f32(v[8 * j + 6], v[8 * j + 7], b_, true);
                  *(GAS u32x2*)(x8 + 8 * F.lane + 512 * j) = (u32x2){(unsigned)a_, (unsigned)b_}; } } }
        __syncthreads();
        { float zf_ = 0.f; asm volatile("" : "+v"(zf_)); f32x4 acc0 = (f32x4){zf_, zf_, zf_, zf_}, acc1 = acc0;
#pragma unroll
          for (int ks = 0; ks < 8; ++ks) { const bf16x8 a = *(const LAS bf16x8*)(XT + r16 * XT_PITCH + (F.wave * 256 + ks * 32 + 8 * q) * 2);
              acc0 = __builtin_amdgcn_mfma_f32_16x16x32_bf16(a, bw0[ks], acc0, 0, 0, 0); acc1 = __builtin_amdgcn_mfma_f32_16x16x32_bf16(a, bw1[ks], acc1, 0, 0, 0); }
#pragma unroll
          for (int i = 0; i < 4; ++i) { PART[(F.wave * 16 + 4 * q + i) * 33 + r16] = acc0[i]; PART[(F.wave * 16 + 4 * q + i) * 33 + 16 + r16] = acc1[i]; } }
        __syncthreads();
        { const int row = F.tid >> 5, e = F.tid & 31; float s = rbias[e];
#pragma unroll
          for (int w = 0; w < 8; ++w) s += PART[(w * 16 + row) * 33 + e];
          LOGA[(nit * 16 + row) * LOGP + e] = s; }
    }
    __syncthreads();
    const int nrows = nit * 16; const int row = F.wave * 8 + (F.lane & 7); const bool act = (F.lane < 8) && (row < nrows);
    int e4[4] = {0, 0, 0, 0}; float v4[4] = {0.f, 0.f, 0.f, 0.f}; unsigned rk[4] = {0u, 0u, 0u, 0u};
    if (act) { unsigned mask = 0u; float lv[32];
#pragma unroll
        for (int e4i = 0; e4i < 8; ++e4i) { const f32x4 t = *(const LAS f32x4*)(LOGA + row * LOGP + 4 * e4i); lv[4 * e4i] = t.x; lv[4 * e4i + 1] = t.y; lv[4 * e4i + 2] = t.z; lv[4 * e4i + 3] = t.w; }
#pragma unroll
        for (int k = 0; k < 4; ++k) { float best = -__builtin_inff(); int bi = 0;
#pragma unroll
            for (int e = 0; e < 32; ++e) { const bool ok = (((mask >> e) & 1u) == 0u) && (lv[e] > best); best = ok ? lv[e] : best; bi = ok ? e : bi; }
            mask |= 1u << bi; e4[k] = bi; v4[k] = best; }
        const float e1 = __expf(v4[1] - v4[0]), e2 = __expf(v4[2] - v4[0]), e3 = __expf(v4[3] - v4[0]); const float inv = 1.f / (1.f + e1 + e2 + e3);
        v4[0] = inv; v4[1] = e1 * inv; v4[2] = e2 * inv; v4[3] = e3 * inv;
#pragma unroll
        for (int k = 0; k < 4; ++k) rk[k] = __hip_atomic_fetch_add((LAS unsigned*)(F.X + XW_LCNT + e4[k]), 1u, __ATOMIC_RELAXED, __HIP_MEMORY_SCOPE_WORKGROUP); }
    __syncthreads();
    if (F.tid < 32) { const unsigned c = F.X[XW_LCNT + F.tid]; unsigned base = 0u; if (c) base = __hip_atomic_fetch_add(gcnt + F.tid * 64, c, RLX_AGENT); F.X[XW_LBASE + F.tid] = base; }
    __syncthreads();
    if (act) { const int t = ((int)blockIdx.x + (row >> 4) * F.G) * 16 + (row & 15);
#pragma unroll
        for (int k = 0; k < 4; ++k) { const unsigned pos = F.X[XW_LBASE + e4[k]] + rk[k]; __hip_atomic_store((GAS int*)LIST + ((size_t)e4[k] * CAP + pos), t, RLX_AGENT); EIDX[t * 4 + k] = e4[k]; POS[t * 4 + k] = (int)pos; GATE[t * 4 + k] = v4[k]; } }
    __syncthreads();
}
__device__ __forceinline__ void moe_tables(Frame& F, int layer) {
    F.rethread();
    gu32* gcnt = F.ctlp() + CW_CNT + layer * 32 * 64;
    if (F.tid < 32) F.X[XW_CNT + F.tid] = __hip_atomic_load(gcnt + F.tid * 64, RLX_AGENT);
    __syncthreads();
    if (F.tid == 0) { unsigned run = 0u;
        for (int e = 0; e < 32; ++e) { const unsigned c = F.X[XW_CNT + e], n = (c + 255u) >> 8; F.X[XW_TPRE + e] = run; F.X[XW_PSTART + e] = run * 256u;
            for (unsigned i = 0; i < n; ++i) F.X[XW_TILE_E + run + i] = (unsigned)e; run += n; }
        F.X[XW_TPRE + 32] = run; F.X[XW_NTILES] = run; }
    __syncthreads();
}
__device__ __forceinline__ void r2_phase(Frame& F, int layer, bool last, int gates_j, int kmax) {
    F.rethread();
    const bf16* X1 = (const bf16*)(F.wsp() + WS_X1); const unsigned char* Y = (const unsigned char*)(F.wsp() + WS_Y); bf16* XB = (bf16*)(F.wsp() + WS_XB); float* GT = (float*)(F.wsp() + WS_GATES);
    const int* EIDX = (const int*)(F.wsp() + WS_TOK); const int* POS = (const int*)(F.wsp() + WS_TOK + 256 * 1024); const float* GATE = (const float*)(F.wsp() + WS_TOK + 512 * 1024);
    LAS float* LOG = (LAS float*)(F.lds + RP_LOG);
    LAS float* GL = (LAS float*)(F.lds + RP_GB); LAS float* BL = GL + D;
    { const float* gp = F.inp(I_LNG) + (size_t)(layer * 2 + 1) * D; const float* bp = F.inp(I_LNB) + (size_t)(layer * 2 + 1) * D;
      *(LAS f32x4*)(GL + 4 * F.tid) = *(const GAS f32x4*)(gp + 4 * F.tid); *(LAS f32x4*)(BL + 4 * F.tid) = *(const GAS f32x4*)(bp + 4 * F.tid); }
    __syncthreads();
    for (int it = blockIdx.x; it < T / 16; it += F.G) {
#pragma unroll
        for (int rr = 0; rr < 2; ++rr) { const int r = F.wave * 2 + rr, t = it * 16 + r; float v[32];
            load_row_bf16(X1 + (size_t)t * D, F.lane, v);
#pragma unroll
            for (int i = 0; i < 32; ++i) v[i] *= ALPHA;
#pragma unroll
            for (int k = 0; k < 4; ++k) if (k < kmax) { const int e = __builtin_amdgcn_readfirstlane(EIDX[t * 4 + k]), pos = __builtin_amdgcn_readfirstlane(POS[t * 4 + k]); const float gt = GATE[t * 4 + k];
                const unsigned slot = F.X[XW_PSTART + e] + (unsigned)pos; float yv[32];
                { const unsigned char* yr = Y + (size_t)slot * D;
#pragma unroll
                  for (int j = 0; j < 4; ++j) { const u32x2 w = *(const GAS u32x2*)(yr + 8 * F.lane + 512 * j);
                      yv[8 * j + 0] = __builtin_amdgcn_cvt_f32_fp8((int)w.x, 0); yv[8 * j + 1] = __builtin_amdgcn_cvt_f32_fp8((int)w.x, 1); yv[8 * j + 2] = __builtin_amdgcn_cvt_f32_fp8((int)w.x, 2); yv[8 * j + 3] = __builtin_amdgcn_cvt_f32_fp8((int)w.x, 3);
                      yv[8 * j + 4] = __builtin_amdgcn_cvt_f32_fp8((int)w.y, 0); yv[8 * j + 5] = __builtin_amdgcn_cvt_f32_fp8((int)w.y, 1); yv[8 * j + 6] = __builtin_amdgcn_cvt_f32_fp8((int)w.y, 2); yv[8 * j + 7] = __builtin_amdgcn_cvt_f32_fp8((int)w.y, 3); } }
                const float gts = gt * (1.0f / Y_SCALE);
#pragma unroll
                for (int i = 0; i < 32; ++i) v[i] += gts * yv[i]; }
            layer_norm32_lds(v, GL, BL, F.lane);
            if (last) { float* o = F.outp() + (size_t)t * D;
#pragma unroll
                for (int j = 0; j < 4; ++j) { *(GAS f32x4*)(o + 8 * F.lane + 512 * j) = (f32x4){v[8 * j], v[8 * j + 1], v[8 * j + 2], v[8 * j + 3]}; *(GAS f32x4*)(o + 8 * F.lane + 512 * j + 4) = (f32x4){v[8 * j + 4], v[8 * j + 5], v[8 * j + 6], v[8 * j + 7]}; } }
            else store_row_bf16(v, XB + (size_t)t * D, F.lds + r * XT_PITCH, gates_j >= 0, F.lane); }
        if (gates_j >= 0) {
            __syncthreads();
            skinny16(F, (const bf16*)(F.wsp() + WS_WG_T) + (size_t)gates_j * 32 * D, F.inp(I_MBG) + gates_j * 32);
            { const int row = F.tid >> 5, e = F.tid & 31; const float gval = LOG[row * LOGP + e]; GT[(size_t)(it * 16 + row) * 32 + e] = (e & 8) ? log_sigmoid(gval) : gval; }
        }
    }
    __syncthreads();
}
__device__ __forceinline__ void stub_mixer(Frame& F) {
    F.rethread();
    const bf16* XB = (const bf16*)(F.wsp() + WS_XB); bf16* PRE = (bf16*)(F.wsp() + WS_PRE);
    for (size_t i = (size_t)blockIdx.x * NTHREADS + F.tid; i < (size_t)T * D / 8; i += (size_t)F.G * NTHREADS) { const u32x4 w = ((const GAS u32x4*)XB)[i]; u32x4 o;
        o.x = cvt_pk_bf16(bf_lo(w.x) * ALPHA, bf_hi(w.x) * ALPHA); o.y = cvt_pk_bf16(bf_lo(w.y) * ALPHA, bf_hi(w.y) * ALPHA); o.z = cvt_pk_bf16(bf_lo(w.z) * ALPHA, bf_hi(w.z) * ALPHA); o.w = cvt_pk_bf16(bf_lo(w.w) * ALPHA, bf_hi(w.w) * ALPHA);
        ((GAS u32x4*)PRE)[i] = o; }
}


typedef float f32x2_t __attribute__((ext_vector_type(2)));
__device__ __forceinline__ f32x2_t gelu_pk(f32x2_t v) {
    const f32x2_t av = __builtin_elementwise_abs(v), d = av * 0.2316418882f + 1.0f;
    f32x2_t t; t.x = __builtin_amdgcn_rcpf(d.x); t.y = __builtin_amdgcn_rcpf(d.y);
    f32x2_t q = t * 0.5307027145f + (-0.7265760135f); q = q * t + 0.7107068705f; q = q * t + (-0.142248368f); q = q * t + 0.127414796f; q = q * t;
    const f32x2_t s = (v * v) * (-0.72134752044f);
    f32x2_t e; e.x = __builtin_amdgcn_exp2f(s.x); e.y = __builtin_amdgcn_exp2f(s.y);
    const f32x2_t m = v * (q * e), r = v - m;
    f32x2_t o; o.x = v.x < 0.f ? m.x : r.x; o.y = v.y < 0.f ? m.y : r.y; return o;
}
template <int KK, int NN> struct RectBase {
    static constexpr int K = KK; static constexpr bool PERM = true, FP8 = false; static constexpr int SCALE_B = 0x7f7f7f7f;
    const bf16* A; const bf16* Bt; int G, c;
    __device__ __forceinline__ bool next(int i, pg8::Unit& u) const {
        constexpr int nM = T / 256, nN = NN / 256, nwg = nM * nN; const long L = (long)i * G + c; if (L >= nwg) return false;
        const int wgid = pg8::xcd_remap((int)L, nwg); constexpr int nig = pg8::WGM * nN; const int gid = wgid / nig, fm = gid * pg8::WGM, gsz = (nM - fm) < pg8::WGM ? (nM - fm) : pg8::WGM;
        u.pm = fm + ((wgid % nig) % gsz); u.pn = (wgid % nig) / gsz; u.e = 0; u.x = 0; return true;
    }
    __device__ __forceinline__ void bases(const pg8::Unit& u, const char*& cA, const char*& cB) const { cA = (const char*)(A + (size_t)u.pm * 256 * KK); cB = (const char*)(Bt + (size_t)u.pn * 256 * KK); }
    __device__ __forceinline__ void avoff(const pg8::Unit&, int tid, unsigned (&v)[2][2]) const {
#pragma unroll
        for (int i = 0; i < 2; ++i) { int R, C; pg8::stage_rc(tid * 16 + i * 8192, R, C);
#pragma unroll
            for (int h = 0; h < 2; ++h) v[h][i] = (unsigned)((h * 128 + R) * KK + C) * 2u; }
    }
};
struct OutProjProb : RectBase<D / 2, D> {
    static constexpr bool FP8 = true; static constexpr int SCALE_B = 0x78787878;
    const bf16* XB; bf16* PRE;
    __device__ __forceinline__ void epi(const f32x4 (&acc)[2][2][4][2], const pg8::Unit& u, int wr, int wc, int fr, int fq) const {
        const int row0 = u.pm * 256 + wr * 64 + fr, c0 = u.pn * 256 + wc * 32 + 8 * fq;
#pragma unroll
        for (int ai = 0; ai < 2; ++ai)
#pragma unroll
            for (int m = 0; m < 4; ++m) { const size_t off = (size_t)(row0 + ai * 128 + m * 16) * D + c0;
#pragma unroll
                for (int bj = 0; bj < 2; ++bj) { const u32x4 xr = *(const GAS u32x4*)(XB + off + bj * 128); const f32x4 a0 = acc[ai][bj][m][0], a1 = acc[ai][bj][m][1]; u32x4 w;
                    w.x = cvt_pk_bf16(ALPHA * bf_lo(xr.x) + a0[0], ALPHA * bf_hi(xr.x) + a0[1]); w.y = cvt_pk_bf16(ALPHA * bf_lo(xr.y) + a0[2], ALPHA * bf_hi(xr.y) + a0[3]);
                    w.z = cvt_pk_bf16(ALPHA * bf_lo(xr.z) + a1[0], ALPHA * bf_hi(xr.z) + a1[1]); w.w = cvt_pk_bf16(ALPHA * bf_lo(xr.w) + a1[2], ALPHA * bf_hi(xr.w) + a1[3]);
                    *(GAS u32x4*)(PRE + off + bj * 128) = w; }
                asm volatile("" ::: "memory"); }
    }
};
struct GmlpInProb : RectBase<D, 4096> {
    const float* bias; bf16* U; bf16* V; float* VSTAT;
    __device__ __forceinline__ void epi(const f32x4 (&acc)[2][2][4][2], const pg8::Unit& u, int wr, int wc, int fr, int fq) const {
        const int row0 = u.pm * 256 + wr * 64 + fr, ct = u.pn * 256 + wc * 32 + 8 * fq; const bool isv = u.pn >= 8;
        bf16* O = isv ? V : U; const int c0 = isv ? ct - 2048 : ct;
#pragma unroll
        for (int ai = 0; ai < 2; ++ai)
#pragma unroll
            for (int m = 0; m < 4; ++m) { const int row = row0 + ai * 128 + m * 16; float s1 = 0.f, s2 = 0.f;
#pragma unroll
                for (int bj = 0; bj < 2; ++bj) { const f32x4 b0 = *(const GAS f32x4*)(bias + ct + bj * 128), b1 = *(const GAS f32x4*)(bias + ct + bj * 128 + 4);
                    const f32x4 v0 = acc[ai][bj][m][0] + b0, v1 = acc[ai][bj][m][1] + b1;
                    const f32x2_t g0 = gelu_pk((f32x2_t){v0[0], v0[1]}), g1 = gelu_pk((f32x2_t){v0[2], v0[3]}), g2 = gelu_pk((f32x2_t){v1[0], v1[1]}), g3 = gelu_pk((f32x2_t){v1[2], v1[3]});
                    u32x4 w; w.x = cvt_pk_bf16(g0.x, g0.y); w.y = cvt_pk_bf16(g1.x, g1.y); w.z = cvt_pk_bf16(g2.x, g2.y); w.w = cvt_pk_bf16(g3.x, g3.y);
                    *(GAS u32x4*)(O + (isv ? (size_t)((((unsigned)(row >> 7) * 8u + (unsigned)(u.pn - 8)) * 32u + (unsigned)(wc * 4 + fq + bj * 16)) * 128u + (unsigned)(row & 127)) * 8u : (size_t)row * D + c0 + bj * 128)) = w;
                    if (isv) { const float r0 = bf_lo(w.x), r1 = bf_hi(w.x), r2 = bf_lo(w.y), r3 = bf_hi(w.y), r4 = bf_lo(w.z), r5 = bf_hi(w.z), r6 = bf_lo(w.w), r7 = bf_hi(w.w);
                        s1 += ((r0 + r1) + (r2 + r3)) + ((r4 + r5) + (r6 + r7)); s2 += ((r0 * r0 + r1 * r1) + (r2 * r2 + r3 * r3)) + ((r4 * r4 + r5 * r5) + (r6 * r6 + r7 * r7)); } }
                if (isv) { s1 += __shfl_xor(s1, 16); s1 += __shfl_xor(s1, 32); s2 += __shfl_xor(s2, 16); s2 += __shfl_xor(s2, 32);
                    if (fq == 0) *(GAS f32x2_t*)(VSTAT + ((size_t)((u.pn - 8) * 4 + wc) * T + row) * 2) = (f32x2_t){s1, s2}; }
                asm volatile("" ::: "memory"); }
    }
};


constexpr int VT_PITCH = 272, G3_ST = 69632, G3_WS = 70656;
constexpr int G3_GB = 105472;
__device__ __forceinline__ void g3_phase(Frame& F, int j) {
    F.rethread();
    LAS unsigned char* VT = F.lds; LAS float* ST = (LAS float*)(F.lds + G3_ST); LAS float* GB = (LAS float*)(F.lds + G3_GB);
    const bf16* U = (const bf16*)(F.wsp() + WS_GU); const bf16* V = (const bf16*)(F.wsp() + WS_GV); bf16* YG = (bf16*)(F.wsp() + WS_GY); const float* VSTAT = (const float*)(F.wsp() + WS_VSTAT);
    const float* vg = F.inp(I_GVG) + (size_t)j * D; const float* vb = F.inp(I_GVB) + (size_t)j * D; const float* bs = F.inp(I_GBS) + (size_t)j * 8 * 128;
    const bf16* WS = (const bf16*)(F.wsp() + WS_WS) + (size_t)j * 8 * 128 * 128;
    const int r = F.lane & 15, q = F.lane >> 4;
    const unsigned psel = (F.lane & 1) ? 0x03020706u : 0x05040100u; const int podd = F.lane & 1;
    for (int unit = blockIdx.x; unit < 1024; unit += F.G) {
        const int g = unit & 7, row0 = (unit >> 3) * 128;
        if (F.tid < 128) { float s1 = 0.f, s2 = 0.f;
#pragma unroll 8
            for (int cg = 0; cg < 32; ++cg) { const f32x2 p = *(const GAS f32x2*)(VSTAT + ((size_t)cg * T + row0 + F.tid) * 2); s1 += p.x; s2 += p.y; }
            const float mean = s1 * (1.f / D), var = s2 * (1.f / D) - mean * mean; ST[F.tid * 2] = mean; ST[F.tid * 2 + 1] = 1.f / sqrtf(var + LN_EPS);
            const float* gsrc = (F.tid < 64 ? vg : vb) + g * 256 + 4 * (F.tid & 63); *(LAS f32x4*)(GB + (F.tid < 64 ? 0 : 256) + 4 * (F.tid & 63)) = *(const GAS f32x4*)gsrc; }
        { const bf16* wsg0 = WS + (size_t)g * 128 * 128;
#pragma unroll
          for (int i = 0; i < 4; ++i) { const int p = F.tid + 512 * i; *(LAS u32x4*)(F.lds + G3_WS + (p >> 4) * VT_PITCH + (p & 15) * 16) = *(const GAS u32x4*)(wsg0 + (size_t)(p >> 4) * 128 + (p & 15) * 8); } }
        u32x4 vreg[8];
#pragma unroll
        for (int i = 0; i < 8; ++i) { const int qq = F.tid + 512 * i, s = qq & 127, d8 = qq >> 7;
            vreg[i] = *(const GAS u32x4*)(V + (size_t)((((unsigned)(row0 >> 7) * 8u + (unsigned)g) * 32u + (unsigned)d8) * 128u + (unsigned)s) * 8u); }
        u32x2 ureg[8][2]; float bsv[8];
#pragma unroll
        for (int tt = 0; tt < 8; ++tt) { const int t = 16 * tt + r; const size_t off = (size_t)(row0 + t) * D + g * 256 + 32 * F.wave + 4 * q;
            ureg[tt][0] = *(const GAS u32x2*)(U + off); ureg[tt][1] = *(const GAS u32x2*)(U + off + 16); bsv[tt] = *(const GAS float*)(bs + g * 128 + t); }
        __syncthreads();
#pragma unroll
        for (int i = 0; i < 8; ++i) { const int qq = F.tid + 512 * i, s = qq & 127, d0 = (qq >> 7) * 8;
            const u32x4 w = vreg[i]; const float mean = ST[s * 2], rstd = ST[s * 2 + 1];
            const f32x4 g0 = *(const LAS f32x4*)(GB + d0), g1 = *(const LAS f32x4*)(GB + d0 + 4), b0 = *(const LAS f32x4*)(GB + 256 + d0), b1 = *(const LAS f32x4*)(GB + 256 + d0 + 4);
            const float x[8] = {bf_lo(w.x), bf_hi(w.x), bf_lo(w.y), bf_hi(w.y), bf_lo(w.z), bf_hi(w.z), bf_lo(w.w), bf_hi(w.w)};
            const float gg[8] = {g0.x, g0.y, g0.z, g0.w, g1.x, g1.y, g1.z, g1.w}, bb[8] = {b0.x, b0.y, b0.z, b0.w, b1.x, b1.y, b1.z, b1.w};
            LAS unsigned char* vt = VT + (d0 + podd) * VT_PITCH + (s & ~1) * 2;
#pragma unroll
            for (int k = 0; k < 4; ++k) { const unsigned pk = cvt_pk_bf16_nop((x[2 * k] - mean) * rstd * gg[2 * k] + bb[2 * k], (x[2 * k + 1] - mean) * rstd * gg[2 * k + 1] + bb[2 * k + 1]);
                const unsigned y = (unsigned)__builtin_amdgcn_update_dpp(0, (int)pk, 0xB1, 0xf, 0xf, true); *(LAS unsigned*)(vt + (2 * k) * VT_PITCH) = __builtin_amdgcn_perm(y, pk, psel); } }
        __syncthreads();
        bf16x8 af[2][4];
#pragma unroll
        for (int dd = 0; dd < 2; ++dd)
#pragma unroll
            for (int ks = 0; ks < 4; ++ks) af[dd][ks] = *(const LAS bf16x8*)(VT + (16 * (2 * F.wave + dd) + r) * VT_PITCH + (32 * ks + 8 * q) * 2);
#pragma unroll
        for (int tt = 0; tt < 8; ++tt) { bf16x8 bfr[4];
#pragma unroll
            for (int ks = 0; ks < 4; ++ks) bfr[ks] = *(const LAS bf16x8*)(F.lds + G3_WS + (16 * tt + r) * VT_PITCH + (32 * ks + 8 * q) * 2);
            f32x4 a0 = (f32x4){0.f, 0.f, 0.f, 0.f}, a1 = a0;
#pragma unroll
            for (int ks = 0; ks < 4; ++ks) { a0 = __builtin_amdgcn_mfma_f32_16x16x32_bf16(af[0][ks], bfr[ks], a0, 0, 0, 0); a1 = __builtin_amdgcn_mfma_f32_16x16x32_bf16(af[1][ks], bfr[ks], a1, 0, 0, 0); }
            const int t = 16 * tt + r; const float bias = bsv[tt]; const size_t off = (size_t)(row0 + t) * D + g * 256 + 32 * F.wave + 4 * q;
            { const u32x2 uu = ureg[tt][0]; int o_ = 0; o_ = __builtin_amdgcn_cvt_pk_fp8_f32(bf_lo(uu.x) * (a0[0] + bias), bf_hi(uu.x) * (a0[1] + bias), o_, false); o_ = __builtin_amdgcn_cvt_pk_fp8_f32(bf_lo(uu.y) * (a0[2] + bias), bf_hi(uu.y) * (a0[3] + bias), o_, true); *(GAS unsigned*)((unsigned char*)YG + off) = (unsigned)o_; }
            { const u32x2 uu = ureg[tt][1]; int o_ = 0; o_ = __builtin_amdgcn_cvt_pk_fp8_f32(bf_lo(uu.x) * (a1[0] + bias), bf_hi(uu.x) * (a1[1] + bias), o_, false); o_ = __builtin_amdgcn_cvt_pk_fp8_f32(bf_lo(uu.y) * (a1[2] + bias), bf_hi(uu.y) * (a1[3] + bias), o_, true); *(GAS unsigned*)((unsigned char*)YG + off + 16) = (unsigned)o_; }
            __builtin_amdgcn_sched_barrier(0); }
        __syncthreads();
    }
}


struct MlstmInProb : RectBase<D, MIN_MAIN> {
    bf16* Q; bf16* Kb; bf16* V; bf16* O;
    __device__ __forceinline__ void epi(const f32x4 (&acc)[2][2][4][2], const pg8::Unit& u, int wr, int wc, int fr, int fq) const {
        bf16* base; float sc = 1.f; unsigned off0, SA, SM, SB;
        const unsigned row0 = (unsigned)(u.pm * 256 + wr * 64 + fr), bb = row0 >> 12, chunk0 = (row0 >> 7) & 31u, s0 = row0 & 127u;
        if (u.pn < 4) { base = Q; sc = 0.08838834764831845f; off0 = row0 * QKW + u.pn * 256 + wc * 32 + 8 * fq; SA = 128u * QKW; SM = 16u * QKW; SB = 128u; }
        else if (u.pn < 8) { base = Kb; const unsigned hb = (unsigned)(u.pn - 4) * 2u, seg = (unsigned)(wc * 4 + fq);
            off0 = ((((bb * 8u + hb) * 32u + chunk0) * 16u + seg) * 128u + s0) * 8u; SA = 16384u; SM = 128u; SB = 524288u; }
        else if (u.pn < 16) { base = V; const unsigned h = (unsigned)(u.pn - 8), v8 = (unsigned)((wc & 1) * 4 + fq);
            off0 = (((((bb * 8u + h) * 4u + (unsigned)(wc >> 1)) * 32u + chunk0) * 8u + v8) * 128u + s0) * 8u; SA = 8192u; SM = 128u; SB = 524288u; }
        else { base = O; off0 = row0 * VW + (u.pn - 16) * 256 + wc * 32 + 8 * fq; SA = 128u * VW; SM = 16u * VW; SB = 128u; }
#pragma unroll
        for (int ai = 0; ai < 2; ++ai)
#pragma unroll
            for (int m = 0; m < 4; ++m) { bf16* rowp = base + (size_t)(off0 + ai * SA + m * SM);
#pragma unroll
                for (int bj = 0; bj < 2; ++bj) { const f32x4 v0 = acc[ai][bj][m][0] * sc, v1 = acc[ai][bj][m][1] * sc;
                    u32x4 w; w.x = cvt_pk_bf16(v0[0], v0[1]); w.y = cvt_pk_bf16(v0[2], v0[3]); w.z = cvt_pk_bf16(v1[0], v1[1]); w.w = cvt_pk_bf16(v1[2], v1[3]);
                    *(GAS u32x4*)(rowp + (size_t)(bj * SB)) = w; } }
    }
};
template <class Fn, int... I> __device__ __forceinline__ void sfor_impl(Fn&& f, std::integer_sequence<int, I...>) { (f(std::integral_constant<int, I>{}), ...); }
template <int N, class Fn> __device__ __forceinline__ void sfor(Fn&& f) { sfor_impl(static_cast<Fn&&>(f), std::make_integer_sequence<int, N>{}); }
template <int OFF> __device__ __forceinline__ bf16x8 lds_ld128(const LAS unsigned char* a) { return *(const LAS bf16x8*)(a + OFF); }
template <int OFF> __device__ __forceinline__ u32x2 lds_ld64(const LAS unsigned char* a) { return *(const LAS u32x2*)(a + OFF); }
#define LDS_LANDED10(a, b) __builtin_amdgcn_sched_barrier(0)
#define MFMA_DRAIN(vec) do { __builtin_amdgcn_sched_barrier(0); const int d_ = __builtin_amdgcn_readfirstlane(__builtin_bit_cast(int, (vec)[0])); asm volatile("" :: "s"(d_)); __builtin_amdgcn_sched_barrier(0); } while (0)
#define SFOR(n, var) sfor<n>([&](auto var##_) __attribute__((always_inline)) { constexpr int var = decltype(var##_)::value;
#define SFOR_END });
constexpr int SP = 272;
constexpr int SC_KI = 0, SC_KT = 34816, SC_VT = 69632, SC_VW = 91392, SC_CT = 113152, SC_TB = 134912, SC_TBF = 672;
__device__ __forceinline__ size_t ktile(int b, int h, int dir, int c, int j, int g) { const int cc = dir ? 31 - c : c, s = dir ? 127 - j : j; return ((size_t)((((b * 8 + h) * 32 + cc) * 16 + g) * 128 + s)) * 8; }
__device__ __forceinline__ size_t vtile(int b, int h, int dvs, int dir, int c, int j, int g) { const int cc = dir ? 31 - c : c, s = dir ? 127 - j : j; return ((size_t)(((((b * 8 + h) * 4 + dvs) * 32 + cc) * 8 + g) * 128 + s)) * 8; }
__device__ __forceinline__ int scan_row(int b, int dir, int c, int j) { return b * SEQ + (dir ? (31 - c) * 128 + (127 - j) : c * 128 + j); }
__device__ __forceinline__ float log_sigmoid(float x) {
    const float e = __expf(-fabsf(x)), u = 1.f + e;
    const float l = (u == 1.f) ? e : __logf(u) * (e * __builtin_amdgcn_rcpf(u - 1.f));
    return fminf(x, 0.f) - l;
}
template <int CTRL, int ROWM> __device__ __forceinline__ float dpp_take(float ident, float v) {
    return __builtin_bit_cast(float, __builtin_amdgcn_update_dpp(__builtin_bit_cast(int, ident), __builtin_bit_cast(int, v), CTRL, ROWM, 0xf, false)); }
__device__ __forceinline__ float wave_scan_add(float x) {
    x += dpp_take<0x111, 0xf>(0.f, x); x += dpp_take<0x112, 0xf>(0.f, x); x += dpp_take<0x114, 0xf>(0.f, x); x += dpp_take<0x118, 0xf>(0.f, x);
    x += dpp_take<0x142, 0xa>(0.f, x); x += dpp_take<0x143, 0xc>(0.f, x); return x; }
__device__ __forceinline__ float wave_scan_max(float x) {
    const float ni = -__builtin_inff();
    x = fmaxf(x, dpp_take<0x111, 0xf>(ni, x)); x = fmaxf(x, dpp_take<0x112, 0xf>(ni, x)); x = fmaxf(x, dpp_take<0x114, 0xf>(ni, x)); x = fmaxf(x, dpp_take<0x118, 0xf>(ni, x));
    x = fmaxf(x, dpp_take<0x142, 0xa>(ni, x)); x = fmaxf(x, dpp_take<0x143, 0xc>(ni, x)); return x; }
__device__ __forceinline__ void scan_gate_load(const float* GT, int b, int dir, int c, int gi, int lane, float (&gv)[4]) {
    const char* GB = (const char*)GT + ((size_t)(b * SEQ + (dir ? 31 - c : c) * 128) * 32 + gi) * 4;
    const unsigned lo = (unsigned)(dir ? 126 - 2 * lane : 2 * lane) * 128u, o0 = lo + (dir ? 128u : 0u), o1 = lo + (dir ? 0u : 128u);
    gv[0] = *(const GAS float*)(GB + o0); gv[1] = *(const GAS float*)(GB + o1); gv[2] = *(const GAS float*)(GB + (o0 + 32u)); gv[3] = *(const GAS float*)(GB + (o1 + 32u));
}
__device__ __forceinline__ void scan_tables(LAS float* TB, const float (&gv)[4], int lane, float& m) {
    const float i0 = gv[0], i1 = gv[1], f0 = gv[2], f1 = gv[3];
    const float x = wave_scan_add(f0 + f1);
    const float b1 = x, b0 = x - f1, u0 = i0 - b0, u1 = i1 - b1;
    const float z = wave_scan_max(fmaxf(u0, u1));
    float ex = __shfl_up(z, 1); if (lane == 0) ex = -__builtin_inff();
    const float M0 = fmaxf(m, fmaxf(ex, u0)), M1 = fmaxf(m, z);
    const float Ml = __builtin_bit_cast(float, __builtin_amdgcn_readlane(__builtin_bit_cast(int, M1), 63)), bl = __builtin_bit_cast(float, __builtin_amdgcn_readlane(__builtin_bit_cast(int, b1), 63));
    TB[2 * lane] = u0; TB[2 * lane + 1] = u1; TB[128 + 2 * lane] = M0; TB[128 + 2 * lane + 1] = M1;
    TB[256 + 2 * lane] = __expf(-(b0 + M0)); TB[256 + 2 * lane + 1] = __expf(-(b1 + M1));
    TB[384 + 2 * lane] = __expf(u0 - Ml); TB[384 + 2 * lane + 1] = __expf(u1 - Ml);
    TB[512 + 2 * lane] = __expf(m - M0); TB[512 + 2 * lane + 1] = __expf(m - M1);
    if (lane == 0) TB[640] = __expf(m - Ml);
    m = bl + Ml;
}
__device__ __forceinline__ void m2_scan(Frame& F) {
    F.rethread();
    LAS unsigned char* L = F.lds;
    const bf16* Qg = (const bf16*)(F.wsp() + WS_MQ); const bf16* Kg = (const bf16*)(F.wsp() + WS_MK); const bf16* Vg = (const bf16*)(F.wsp() + WS_MV); const float* GT = (const float*)(F.wsp() + WS_GATES);
    const int w = F.wave, lane = F.lane, c16 = lane & 15, q = lane >> 4, tid = F.tid;
    for (int cblk = blockIdx.x; cblk < 256; cblk += F.G) {
        const int chain = (cblk & 7) * 32 + (cblk >> 3);
        const int dvs = chain & 3, dir = (chain >> 2) & 1, h = (chain >> 3) & 7, b = chain >> 6;
        bf16* Hout = (bf16*)(F.wsp() + (dir ? WS_HB : WS_HF));
        const int qcol0 = h * 128, vcol0 = h * 256 + dvs * 64, gi = 2 * dir * 8 + h;
        const LAS unsigned char* lbase = L + c16 * SP;
        const LAS unsigned char* bKI = lbase + SC_KI + 16 * q; const LAS unsigned char* bCT = lbase + SC_CT + 16 * q; const LAS unsigned char* bVT = lbase + SC_VT + 8 * q;
        const LAS unsigned char* bVW = lbase + SC_VW + 16 * q; const LAS unsigned char* bKT = lbase + SC_KT + 16 * w * SP + 16 * q;
        for (int i = tid; i < 80 * SP / 4; i += NTHREADS) ((LAS unsigned*)(L + SC_CT))[i] = 0u;
        for (int i = tid; i < 16 * SP / 4; i += NTHREADS) { ((LAS unsigned*)(L + SC_VT + 64 * SP))[i] = (i < SP / 4) ? 0x3F803F80u : 0u; ((LAS unsigned*)(L + SC_VW + 64 * SP))[i] = 0u; }
        f32x4 cacc[5];
#pragma unroll
        for (int vt = 0; vt < 5; ++vt) cacc[vt] = (f32x4){0.f, 0.f, 0.f, 0.f};
        const int nK = (int)((0x24444464u >> (4 * w)) & 15u), nV = (int)((0x10223332u >> (4 * w)) & 15u);
        const int kbase = (int)(((w < 4 ? 0x0E0A0400u : 0x1E1A1612u) >> (8 * (w & 3))) & 255u), vbase = (int)(((w < 4 ? 0x08050200u : 0x0F0F0D0Bu) >> (8 * (w & 3))) & 255u);
        u32x4 kn[6], vn[3]; bf16x8 qn[4];
#pragma unroll
        for (int i = 0; i < 6; ++i) { kn[i] = (u32x4){0u, 0u, 0u, 0u}; if (i < nK) kn[i] = *(const GAS u32x4*)(Kg + ktile(b, h, dir, 0, 64 * (i & 1) + lane, (kbase + i) >> 1)); }
#pragma unroll
        for (int i = 0; i < 3; ++i) { vn[i] = (u32x4){0u, 0u, 0u, 0u}; if (i < nV) vn[i] = *(const GAS u32x4*)(Vg + vtile(b, h, dvs, dir, 0, 64 * ((vbase + i) & 1) + lane, (vbase + i) >> 1)); }
#pragma unroll
        for (int ks = 0; ks < 4; ++ks) qn[ks] = *(const GAS bf16x8*)(Qg + (size_t)scan_row(b, dir, 0, 16 * w + c16) * QKW + qcol0 + 32 * ks + 8 * q);
        float m_run = 0.f;
        float gv[4] = {0.f, 0.f, 0.f, 0.f};
        if (w == 0) { scan_gate_load(GT, b, dir, 0, gi, lane, gv); scan_tables((LAS float*)(L + SC_TB), gv, lane, m_run); scan_gate_load(GT, b, dir, 1, gi, lane, gv); }
        __syncthreads();
#pragma unroll 1
        for (int c = 0; c < 32; ++c) {
            const LAS float* TB = (const LAS float*)(L + SC_TB) + (c & 1) * SC_TBF;
            bf16x8 qf[4];
#pragma unroll
            for (int ks = 0; ks < 4; ++ks) qf[ks] = qn[ks];
            const unsigned psel = (lane & 1) ? 0x03020706u : 0x05040100u; const int podd = lane & 1;
#pragma unroll
            for (int i = 0; i < 6; ++i) if (i < nK) { const int s = 64 * (i & 1) + lane, d8 = (kbase + i) >> 1; *(LAS u32x4*)(L + SC_KI + s * SP + d8 * 16) = kn[i]; }
#pragma unroll
            for (int i = 0; i < 3; ++i) if (i < nV) { const int s = 64 * ((vbase + i) & 1) + lane, v8 = (vbase + i) >> 1; const u32x4 vv = vn[i];
                LAS unsigned char* vt = L + SC_VT + (8 * v8 + podd) * SP + (s & ~1) * 2; const unsigned ww[4] = {vv.x, vv.y, vv.z, vv.w};
#pragma unroll
                for (int e = 0; e < 4; ++e) { const unsigned y = (unsigned)__builtin_amdgcn_update_dpp(0, (int)ww[e], 0xB1, 0xf, 0xf, true); *(LAS unsigned*)(vt + (2 * e) * SP) = __builtin_amdgcn_perm(y, ww[e], psel); } }
            __syncthreads();
#pragma unroll
            for (int i = 0; i < 6; ++i) if (i < nK) { const int s = 64 * (i & 1) + lane, d8 = (kbase + i) >> 1; const u32x4 kv = kn[i];
                LAS unsigned char* kt = L + SC_KT + (8 * d8 + podd) * SP + (s & ~1) * 2; const unsigned kw[4] = {kv.x, kv.y, kv.z, kv.w};
#pragma unroll
                for (int e = 0; e < 4; ++e) { const unsigned y = (unsigned)__builtin_amdgcn_update_dpp(0, (int)kw[e], 0xB1, 0xf, 0xf, true); *(LAS unsigned*)(kt + (2 * e) * SP) = __builtin_amdgcn_perm(y, kw[e], psel); } }
#pragma unroll
            for (int i = 0; i < 3; ++i) if (i < nV) { const int s = 64 * ((vbase + i) & 1) + lane, v8 = (vbase + i) >> 1; const u32x4 vv = vn[i]; const float wk = TB[384 + s];
                LAS unsigned char* vw = L + SC_VW + (8 * v8 + podd) * SP + (s & ~1) * 2; const unsigned ww[4] = {vv.x, vv.y, vv.z, vv.w};
#pragma unroll
                for (int e = 0; e < 4; ++e) { const unsigned sc = cvt_pk_bf16_nop(bf_lo(ww[e]) * wk, bf_hi(ww[e]) * wk); const unsigned ys = (unsigned)__builtin_amdgcn_update_dpp(0, (int)sc, 0xB1, 0xf, 0xf, true);
                    *(LAS unsigned*)(vw + (2 * e) * SP) = __builtin_amdgcn_perm(ys, sc, psel); } }
            if (tid < 128) *(LAS unsigned short*)(L + SC_VW + 64 * SP + tid * 2) = (unsigned short)f2bf(TB[384 + tid]);
            if (c + 1 < 32) {
                const int cc1 = dir ? 30 - c : c + 1;
                const char* KB = (const char*)Kg + (size_t)(((b * 8 + h) * 32 + cc1)) * 32768;
                const char* VB = (const char*)Vg + (size_t)((((b * 8 + h) * 4 + dvs) * 32 + cc1)) * 16384;
                const char* QB = (const char*)Qg + ((size_t)(b * SEQ + cc1 * 128) * QKW + qcol0) * 2;
                const unsigned lp = 16u * (unsigned)(dir ? 63 - lane : lane);
#pragma unroll
                for (int i = 0; i < 6; ++i) if (i < nK) { const int n = kbase + i, hf = n & 1; kn[i] = *(const GAS u32x4*)(KB + ((unsigned)((n >> 1) * 2048 + (dir ? 1 - hf : hf) * 1024) + lp)); }
#pragma unroll
                for (int i = 0; i < 3; ++i) if (i < nV) { const int n = vbase + i, hf = n & 1; vn[i] = *(const GAS u32x4*)(VB + ((unsigned)((n >> 1) * 2048 + (dir ? 1 - hf : hf) * 1024) + lp)); }
                const unsigned qo = (unsigned)((dir ? 127 - (16 * w + c16) : 16 * w + c16) * (QKW * 2) + 16 * q);
#pragma unroll
                for (int ks = 0; ks < 4; ++ks) qn[ks] = *(const GAS bf16x8*)(QB + (qo + 64u * ks));
            }
            if (w == 0 && c + 1 < 32) { scan_tables((LAS float*)(L + SC_TB) + ((c + 1) & 1) * SC_TBF, gv, lane, m_run); if (c + 2 < 32) scan_gate_load(GT, b, dir, c + 2, gi, lane, gv); }
            const float Mj = TB[128 + 16 * w + c16], iscj = TB[512 + 16 * w + c16], emtj = TB[256 + 16 * w + c16];
            const LAS unsigned char* bTB = (const LAS unsigned char*)TB + 16 * q;
            f32x4 ad[5], ac[5];
#pragma unroll
            for (int vt = 0; vt < 5; ++vt) { ad[vt] = (f32x4){0.f, 0.f, 0.f, 0.f}; ac[vt] = ad[vt]; }
            SFOR(2, kh) bf16x8 r0[5], r1[5];
                SFOR(5, vt) r0[vt] = lds_ld128<16 * vt * SP + 128 * kh>(bCT); r1[vt] = lds_ld128<16 * vt * SP + 128 * kh + 64>(bCT); SFOR_END
                LDS_LANDED10(r0, r1);
#pragma unroll
                for (int vt = 0; vt < 5; ++vt) ad[vt] = __builtin_amdgcn_mfma_f32_16x16x32_bf16(r0[vt], qf[2 * kh], ad[vt], 0, 0, 0);
#pragma unroll
                for (int vt = 0; vt < 5; ++vt) ad[vt] = __builtin_amdgcn_mfma_f32_16x16x32_bf16(r1[vt], qf[2 * kh + 1], ad[vt], 0, 0, 0);
                MFMA_DRAIN(ad[4]);
            SFOR_END
            bf16x8 pf[4];
            SFOR(4, kp) u32x4 t4 = (u32x4){0u, 0u, 0u, 0u};
                if (2 * kp <= w) {
                    bf16x8 a0[5], a1[5];
                    SFOR(4, ks) a0[ks] = lds_ld128<32 * kp * SP + 64 * ks>(bKI); a1[ks] = lds_ld128<(32 * kp + 16) * SP + 64 * ks>(bKI); SFOR_END
                    a0[4] = lds_ld128<32 * kp * 4>(bTB); a1[4] = lds_ld128<(32 * kp + 16) * 4>(bTB);
                    LDS_LANDED10(a0, a1);
                    const f32x4 ua = __builtin_bit_cast(f32x4, a0[4]), ub = __builtin_bit_cast(f32x4, a1[4]);
                    f32x4 s0 = (f32x4){0.f, 0.f, 0.f, 0.f}, s1 = s0;
#pragma unroll
                    for (int ks = 0; ks < 4; ++ks) { s0 = __builtin_amdgcn_mfma_f32_16x16x32_bf16(a0[ks], qf[ks], s0, 0, 0, 0); s1 = __builtin_amdgcn_mfma_f32_16x16x32_bf16(a1[ks], qf[ks], s1, 0, 0, 0); }
                    float p0[4], p1[4]; const int j = 16 * w + c16;
#pragma unroll
                    for (int i = 0; i < 4; ++i) { const int s = 32 * kp + 4 * q + i; p0[i] = (s <= j) ? s0[i] * __expf(ua[i] - Mj) : 0.f; p1[i] = (s + 16 <= j) ? s1[i] * __expf(ub[i] - Mj) : 0.f; }
                    t4.x = cvt_pk_bf16(p0[0], p0[1]); t4.y = cvt_pk_bf16(p0[2], p0[3]); t4.z = cvt_pk_bf16(p1[0], p1[1]); t4.w = cvt_pk_bf16(p1[2], p1[3]); }
                pf[kp] = __builtin_bit_cast(bf16x8, t4);
            SFOR_END
            SFOR(4, kp) if (2 * kp <= w) {
                u32x2 lo[5], hi[5];
                SFOR(5, vt) lo[vt] = lds_ld64<16 * vt * SP + 64 * kp>(bVT); hi[vt] = lds_ld64<16 * vt * SP + 64 * kp + 32>(bVT); SFOR_END
                LDS_LANDED10(lo, hi);
#pragma unroll
                for (int vt = 0; vt < 5; ++vt) { u32x4 t4; t4.x = lo[vt].x; t4.y = lo[vt].y; t4.z = hi[vt].x; t4.w = hi[vt].y; ac[vt] = __builtin_amdgcn_mfma_f32_16x16x32_bf16(__builtin_bit_cast(bf16x8, t4), pf[kp], ac[vt], 0, 0, 0); }
                MFMA_DRAIN(ac[4]); }
            SFOR_END
            f32x4 num[5];
#pragma unroll
            for (int vt = 0; vt < 5; ++vt) num[vt] = ac[vt] + ad[vt] * iscj;
            { const float den = __shfl(num[4][0], c16); const float inv = 1.f / fmaxf(fabsf(den), emtj);
              bf16* hrow = Hout + (size_t)scan_row(b, dir, c, 16 * w + c16) * VW + vcol0 + 4 * q;
#pragma unroll
              for (int vt = 0; vt < 4; ++vt) { u32x2 o; o.x = cvt_pk_bf16(num[vt][0] * inv, num[vt][1] * inv); o.y = cvt_pk_bf16(num[vt][2] * inv, num[vt][3] * inv); *(GAS u32x2*)(hrow + 16 * vt) = o; } }
            __syncthreads();
            { const float decay = TB[640];
#pragma unroll
              for (int vt = 0; vt < 5; ++vt) cacc[vt] = cacc[vt] * decay;
              SFOR(2, kh) bf16x8 b0[5], b1[5], ka0, ka1;
                  ka0 = lds_ld128<128 * kh>(bKT); ka1 = lds_ld128<128 * kh + 64>(bKT);
                  SFOR(5, vt) b0[vt] = lds_ld128<16 * vt * SP + 128 * kh>(bVW); b1[vt] = lds_ld128<16 * vt * SP + 128 * kh + 64>(bVW); SFOR_END
                  LDS_LANDED10(b0, b1);
#pragma unroll
                  for (int vt = 0; vt < 5; ++vt) cacc[vt] = __builtin_amdgcn_mfma_f32_16x16x32_bf16(ka0, b0[vt], cacc[vt], 0, 0, 0);
#pragma unroll
                  for (int vt = 0; vt < 5; ++vt) cacc[vt] = __builtin_amdgcn_mfma_f32_16x16x32_bf16(ka1, b1[vt], cacc[vt], 0, 0, 0);
                  MFMA_DRAIN(cacc[4]);
              SFOR_END
#pragma unroll
              for (int vt = 0; vt < 5; ++vt) { u32x2 o; o.x = cvt_pk_bf16(cacc[vt][0], cacc[vt][1]); o.y = cvt_pk_bf16(cacc[vt][2], cacc[vt][3]); *(LAS u32x2*)(L + SC_CT + (16 * vt + c16) * SP + (16 * w + 4 * q) * 2) = o; } }
            __syncthreads();
        }
    }
}
__device__ __forceinline__ float half_wave_sum(float x) {
    x += __builtin_bit_cast(float, __builtin_amdgcn_update_dpp(0, __builtin_bit_cast(int, x), 0xB1, 0xf, 0xf, true));
    x += __builtin_bit_cast(float, __builtin_amdgcn_update_dpp(0, __builtin_bit_cast(int, x), 0x4E, 0xf, 0xf, true));
    x += __builtin_bit_cast(float, __builtin_amdgcn_update_dpp(0, __builtin_bit_cast(int, x), 0x141, 0xf, 0xf, true));
    x += __builtin_bit_cast(float, __builtin_amdgcn_update_dpp(0, __builtin_bit_cast(int, x), 0x140, 0xf, 0xf, true));
    return x + __shfl_xor(x, 16);
}
__device__ __forceinline__ void m3_combine(Frame& F, int j) {
    F.rethread();
    const bf16* HF = (const bf16*)(F.wsp() + WS_HF); const bf16* HB = (const bf16*)(F.wsp() + WS_HB); const bf16* O = (const bf16*)(F.wsp() + WS_MO); bf16* HG = (bf16*)(F.wsp() + WS_HG);
    float g[32]; load_lane_vec32(F.inp(I_MNG) + (size_t)j * VW, F.lane, g);
    const int t0 = blockIdx.x * NWAVES + F.wave, tstep = F.G * NWAVES;
    u32x4 ra[4], rb[4], ro[4];
#pragma unroll
    for (int jj = 0; jj < 4; ++jj) { ra[jj] = *(const GAS u32x4*)(HF + (size_t)t0 * VW + 8 * F.lane + 512 * jj); rb[jj] = *(const GAS u32x4*)(HB + (size_t)t0 * VW + 8 * F.lane + 512 * jj); ro[jj] = *(const GAS u32x4*)(O + (size_t)t0 * VW + 8 * F.lane + 512 * jj); }
    for (int t = t0; t < T; t += tstep) {
        float a[32], o[32];
#pragma unroll
        for (int jj = 0; jj < 4; ++jj) { const unsigned wa[4] = {ra[jj].x, ra[jj].y, ra[jj].z, ra[jj].w}, wb[4] = {rb[jj].x, rb[jj].y, rb[jj].z, rb[jj].w}, wo[4] = {ro[jj].x, ro[jj].y, ro[jj].z, ro[jj].w};
#pragma unroll
            for (int e = 0; e < 4; ++e) { a[8 * jj + 2 * e] = bf_lo(wa[e]) + bf_lo(wb[e]); a[8 * jj + 2 * e + 1] = bf_hi(wa[e]) + bf_hi(wb[e]); o[8 * jj + 2 * e] = bf_lo(wo[e]); o[8 * jj + 2 * e + 1] = bf_hi(wo[e]); } }
        if (t + tstep < T) { const size_t rn = (size_t)(t + tstep) * VW + 8 * F.lane;
#pragma unroll
            for (int jj = 0; jj < 4; ++jj) { ra[jj] = *(const GAS u32x4*)(HF + rn + 512 * jj); rb[jj] = *(const GAS u32x4*)(HB + rn + 512 * jj); ro[jj] = *(const GAS u32x4*)(O + rn + 512 * jj); } }
#pragma unroll
        for (int jj = 0; jj < 4; ++jj) { float s = 0.f;
#pragma unroll
            for (int e = 0; e < 8; ++e) s += a[8 * jj + e];
            const float mean = half_wave_sum(s) * (1.f / 256.f); float s2 = 0.f;
#pragma unroll
            for (int e = 0; e < 8; ++e) { a[8 * jj + e] -= mean; s2 += a[8 * jj + e] * a[8 * jj + e]; }
            const float rstd = 1.f / sqrtf(half_wave_sum(s2) * (1.f / 256.f) + LN_EPS);
#pragma unroll
            for (int e = 0; e < 8; ++e) a[8 * jj + e] = a[8 * jj + e] * rstd * g[8 * jj + e] * __builtin_amdgcn_rcpf(1.f + __expf(-o[8 * jj + e])); }
        { unsigned char* h8 = (unsigned char*)HG + (size_t)t * VW;
#pragma unroll
          for (int jj = 0; jj < 4; ++jj) { int a_ = 0, b_ = 0; a_ = __builtin_amdgcn_cvt_pk_fp8_f32(a[8 * jj], a[8 * jj + 1], a_, false); a_ = __builtin_amdgcn_cvt_pk_fp8_f32(a[8 * jj + 2], a[8 * jj + 3], a_, true);
              b_ = __builtin_amdgcn_cvt_pk_fp8_f32(a[8 * jj + 4], a[8 * jj + 5], b_, false); b_ = __builtin_amdgcn_cvt_pk_fp8_f32(a[8 * jj + 6], a[8 * jj + 7], b_, true);
              *(GAS u32x2*)(h8 + 8 * F.lane + 512 * jj) = (u32x2){(unsigned)a_, (unsigned)b_}; } }
    }
}

struct MoeOrderBase {
    LAS unsigned* X; int G, c, NT;
    __device__ __forceinline__ bool next_(int i, pg8::Unit& u) const {
        const int ntiles = (int)X[XW_NTILES], nwg = ntiles * NT; const long L = (long)i * G + c; if (L >= nwg) return false;
        const int wgid = pg8::xcd_remap((int)L, nwg); const int ti = wgid / NT; u.pn = wgid % NT;
        u.e = __builtin_amdgcn_readfirstlane((int)X[XW_TILE_E + ti]); u.pm = ti - __builtin_amdgcn_readfirstlane((int)X[XW_TPRE + u.e]); u.x = 0; return true;
    }
};
struct E1Prob : MoeOrderBase {
    static constexpr int K = D / 2; static constexpr bool PERM = true, FP8 = true; static constexpr int SCALE_B = 0x79797979;
    const unsigned char* X1; const unsigned char* Wt; const float* bgu; unsigned char* hact; const int* list;
    __device__ __forceinline__ bool next(int i, pg8::Unit& u) const { return next_(i, u); }
    __device__ __forceinline__ void bases(const pg8::Unit& u, const char*& cA, const char*& cB) const { cA = (const char*)X1; cB = (const char*)(Wt + ((size_t)u.e * 1024 + (size_t)u.pn * 256) * D); }
    __device__ __forceinline__ void avoff(const pg8::Unit& u, int tid, unsigned (&v)[2][2]) const {
        const int cnt = (int)X[XW_CNT + u.e];
#pragma unroll
        for (int i = 0; i < 2; ++i) { int R, C; pg8::stage_rc(tid * 16 + i * 8192, R, C);
#pragma unroll
            for (int h = 0; h < 2; ++h) { int idx = u.pm * 256 + h * 128 + R; idx = idx < cnt ? idx : cnt - 1;
                const int tok = __hip_atomic_load((const GAS int*)list + ((size_t)u.e * CAP + idx), RLX_AGENT); v[h][i] = (unsigned)tok * (unsigned)D + (unsigned)C * 2u; } }
    }
    __device__ __forceinline__ void epi(const f32x4 (&acc)[2][2][4][2], const pg8::Unit& u, int wr, int wc, int fr, int fq) const {
        const unsigned slot0 = X[XW_PSTART + u.e] + (unsigned)u.pm * 256u + (unsigned)(wr * 64 + fr);
        const int hc = u.pn * 128 + wc * 32 + 8 * fq;
        const float* bg = bgu + (size_t)u.e * 1024 + hc;
#pragma unroll
        for (int ai = 0; ai < 2; ++ai)
#pragma unroll
            for (int m = 0; m < 4; ++m) { unsigned char* rowp = hact + (size_t)(slot0 + ai * 128 + m * 16) * FF + hc; float o[8];
#pragma unroll
                for (int n = 0; n < 2; ++n) { const f32x4 bgv = *(const GAS f32x4*)(bg + 4 * n), buv = *(const GAS f32x4*)(bg + 512 + 4 * n);
#pragma unroll
                    for (int jp = 0; jp < 2; ++jp) {
                        f32x2_t gv = (f32x2_t){acc[ai][0][m][n][2 * jp], acc[ai][0][m][n][2 * jp + 1]} + (f32x2_t){bgv[2 * jp], bgv[2 * jp + 1]};
                        f32x2_t uv = (f32x2_t){acc[ai][1][m][n][2 * jp], acc[ai][1][m][n][2 * jp + 1]} + (f32x2_t){buv[2 * jp], buv[2 * jp + 1]};
                        gv.x = fminf(gv.x, 7.0f); gv.y = fminf(gv.y, 7.0f); uv.x = __builtin_amdgcn_fmed3f(uv.x, -7.0f, 7.0f); uv.y = __builtin_amdgcn_fmed3f(uv.y, -7.0f, 7.0f);
                        const f32x2_t t = gv * (-1.702f * 1.4426950408889634f); f32x2_t e; e.x = __builtin_amdgcn_exp2f(t.x); e.y = __builtin_amdgcn_exp2f(t.y);
                        const f32x2_t d = e + 1.0f; f32x2_t r; r.x = __builtin_amdgcn_rcpf(d.x); r.y = __builtin_amdgcn_rcpf(d.y);
                        const f32x2_t res = (uv + 1.0f) * gv * r; o[4 * n + 2 * jp] = res.x; o[4 * n + 2 * jp + 1] = res.y; } }
                asm volatile("" ::: "memory");
                u32x2 w; { int a_ = 0, b_ = 0; a_ = __builtin_amdgcn_cvt_pk_fp8_f32(o[0], o[1], a_, false); a_ = __builtin_amdgcn_cvt_pk_fp8_f32(o[2], o[3], a_, true);
                    b_ = __builtin_amdgcn_cvt_pk_fp8_f32(o[4], o[5], b_, false); b_ = __builtin_amdgcn_cvt_pk_fp8_f32(o[6], o[7], b_, true); w.x = (unsigned)a_; w.y = (unsigned)b_; }
                *(GAS u32x2*)rowp = w; }
    }
};
struct E2Prob : MoeOrderBase {
    static constexpr int K = FF / 2; static constexpr bool PERM = true, FP8 = true; static constexpr int SCALE_B = 0x79797979;
    const unsigned char* hact; const unsigned char* Wt; const float* bdn; unsigned char* Y;
    __device__ __forceinline__ bool next(int i, pg8::Unit& u) const { return next_(i, u); }
    __device__ __forceinline__ void bases(const pg8::Unit& u, const char*& cA, const char*& cB) const {
        cA = (const char*)(hact + (size_t)(X[XW_PSTART + u.e] + (unsigned)u.pm * 256u) * FF); cB = (const char*)(Wt + ((size_t)u.e * D + (size_t)u.pn * 256) * FF); }
    __device__ __forceinline__ void avoff(const pg8::Unit&, int tid, unsigned (&v)[2][2]) const {
#pragma unroll
        for (int i = 0; i < 2; ++i) { int R, C; pg8::stage_rc(tid * 16 + i * 8192, R, C);
#pragma unroll
            for (int h = 0; h < 2; ++h) v[h][i] = (unsigned)((h * 128 + R) * (FF / 2) + C) * 2u; }
    }
    __device__ __forceinline__ void epi(const f32x4 (&acc)[2][2][4][2], const pg8::Unit& u, int wr, int wc, int fr, int fq) const {
        const unsigned slot0 = X[XW_PSTART + u.e] + (unsigned)u.pm * 256u + (unsigned)(wr * 64 + fr);
        const int c0 = u.pn * 256 + wc * 32 + 8 * fq;
        const float* bp = bdn + (size_t)u.e * D + c0;
        f32x4 bv[2][2];
#pragma unroll
        for (int bj = 0; bj < 2; ++bj)
#pragma unroll
            for (int n = 0; n < 2; ++n) bv[bj][n] = *(const GAS f32x4*)(bp + bj * 128 + 4 * n);
#pragma unroll
        for (int ai = 0; ai < 2; ++ai)
#pragma unroll
            for (int m = 0; m < 4; ++m) { unsigned char* rowp = Y + (size_t)(slot0 + ai * 128 + m * 16) * D + c0;
#pragma unroll
                for (int bj = 0; bj < 2; ++bj) { const f32x4 v0 = (acc[ai][bj][m][0] + bv[bj][0]) * Y_SCALE, v1 = (acc[ai][bj][m][1] + bv[bj][1]) * Y_SCALE;
                    int a_ = 0, b_ = 0; a_ = __builtin_amdgcn_cvt_pk_fp8_f32(v0[0], v0[1], a_, false); a_ = __builtin_amdgcn_cvt_pk_fp8_f32(v0[2], v0[3], a_, true);
                    b_ = __builtin_amdgcn_cvt_pk_fp8_f32(v1[0], v1[1], b_, false); b_ = __builtin_amdgcn_cvt_pk_fp8_f32(v1[2], v1[3], b_, true);
                    *(GAS u32x2*)(rowp + bj * 128) = (u32x2){(unsigned)a_, (unsigned)b_}; } }
    }
};


#define GRID_BAR() do { XcdBarrier bar_; bar_.bar = (unsigned*)(F.ctlp() + CW_BAR); bar_.x = xb_xcc_id(); bar_.st = (volatile LAS unsigned*)(F.X + XW_BAR); F.rethread(); xcd_barrier(bar_, F.tid == 0); } while (0)
#ifndef REP_M1
#define REP_M1 1
#endif
#ifndef REP_OUT
#define REP_OUT 1
#endif
#ifndef REP_G1
#define REP_G1 1
#endif
#ifndef REP_M3
#define REP_M3 1
#endif
#ifndef REP_P0A
#define REP_P0A 1
#endif
#ifndef REP_SCAN
#define REP_SCAN 1
#endif
#ifndef REP_E1
#define REP_E1 1
#endif
#ifndef REP_E2
#define REP_E2 1
#endif
#ifndef REP_G3
#define REP_G3 1
#endif
#ifndef REP_R2
#define REP_R2 1
#endif
#ifndef FILL_E1
#define FILL_E1 20
#endif
#ifndef FILL_E2
#define FILL_E2 3
#endif
#ifndef MOE_LAYER_MASK
#define MOE_LAYER_MASK 15
#endif
template <int layer> __device__ __forceinline__ void moe_layer(Frame& F) {
    if constexpr ((layer & 1) == 1) {
        constexpr int j = layer / 2;
        for (int rep_ = 0; rep_ < REP_G1; ++rep_) {
        { GmlpInProb P; P.A = (const bf16*)(F.wsp() + WS_XB); P.Bt = (const bf16*)(F.wsp() + WS_WGI) + (size_t)j * 4096 * D; P.G = F.G; P.c = (int)blockIdx.x;
          P.bias = F.inp(I_GBIN) + (size_t)j * 4096; P.U = (bf16*)(F.wsp() + WS_GU); P.V = (bf16*)(F.wsp() + WS_GV); P.VSTAT = (float*)(F.wsp() + WS_VSTAT);
          pg8::gemm_phase<GmlpInProb, true>(F.lds, P, F.wave0); }
        GRID_BAR(); }
        for (int rep = 0; rep < REP_G3; ++rep) { g3_phase(F, j); GRID_BAR(); }
        for (int rep_ = 0; rep_ < REP_OUT; ++rep_) {
        { OutProjProb P; P.A = (const bf16*)(F.wsp() + WS_GY); P.Bt = (const bf16*)(F.wsp() + WS_WGO + (size_t)j * D * D); P.G = F.G; P.c = (int)blockIdx.x;
          P.XB = (const bf16*)(F.wsp() + WS_XB); P.PRE = (bf16*)(F.wsp() + WS_PRE);
          pg8::gemm_phase<OutProjProb, true>(F.lds, P, F.wave0); }
        GRID_BAR(); }
    } else {
        constexpr int j = layer / 2;
        for (int rep_ = 0; rep_ < REP_M1; ++rep_) {
        { MlstmInProb P; P.A = (const bf16*)(F.wsp() + WS_XB); P.Bt = (const bf16*)(F.wsp() + WS_WMI) + (size_t)j * MIN_MAIN * D; P.G = F.G; P.c = (int)blockIdx.x;
          P.Q = (bf16*)(F.wsp() + WS_MQ); P.Kb = (bf16*)(F.wsp() + WS_MK); P.V = (bf16*)(F.wsp() + WS_MV); P.O = (bf16*)(F.wsp() + WS_MO);
          pg8::gemm_phase<MlstmInProb, true>(F.lds, P, F.wave0); }
        GRID_BAR(); }
        for (int rep = 0; rep < REP_SCAN; ++rep) { m2_scan(F); GRID_BAR(); }
        for (int rep_ = 0; rep_ < REP_M3; ++rep_) { m3_combine(F, j); GRID_BAR(); }
        for (int rep_ = 0; rep_ < REP_OUT; ++rep_) {
        { OutProjProb P; P.A = (const bf16*)(F.wsp() + WS_HG); P.Bt = (const bf16*)(F.wsp() + WS_WMO + (size_t)j * D * D); P.G = F.G; P.c = (int)blockIdx.x;
          P.XB = (const bf16*)(F.wsp() + WS_XB); P.PRE = (bf16*)(F.wsp() + WS_PRE);
          pg8::gemm_phase<OutProjProb, true>(F.lds, P, F.wave0); }
        GRID_BAR(); }
    }
    r1_phase(F, layer); GRID_BAR();
    moe_tables(F, layer);
    if constexpr ((MOE_LAYER_MASK >> layer) & 1) {
    for (int rep = 0; rep < REP_E1; ++rep) {
    { E1Prob P; P.X = F.X; P.G = F.G; P.c = (int)blockIdx.x; P.NT = 4; P.X1 = (const unsigned char*)(F.wsp() + WS_X1F8); P.Wt = (const unsigned char*)(F.wsp() + WS_WGU) + (size_t)layer * 32 * 1024 * D;
      P.bgu = F.inp(I_EBGU) + (size_t)layer * 32 * 1024; P.hact = (unsigned char*)(F.wsp() + WS_HACT); P.list = (const int*)(F.wsp() + WS_LIST);
      pg8::gemm_phase<E1Prob, true>(F.lds, P, F.wave0); }
    if constexpr (layer + 1 < DEPTH) { const int nwg = (int)F.X[XW_NTILES] * 4, c = (int)blockIdx.x; const int mine = nwg > c ? (nwg - c + F.G - 1) / F.G : 0, most = (nwg + F.G - 1) / F.G;
        if (mine < most) cvt_fill(F, layer + 1, FILL_E1); }
    GRID_BAR(); }
    for (int rep = 0; rep < REP_E2; ++rep) {
    { E2Prob P; P.X = F.X; P.G = F.G; P.c = (int)blockIdx.x; P.NT = 8; P.hact = (const unsigned char*)(F.wsp() + WS_HACT); P.Wt = (const unsigned char*)(F.wsp() + WS_WDN) + (size_t)layer * 32 * D * FF;
      P.bdn = F.inp(I_EBDN) + (size_t)layer * 32 * D; P.Y = (unsigned char*)(F.wsp() + WS_Y);
      pg8::gemm_phase<E2Prob, true>(F.lds, P, F.wave0); }
    if constexpr (layer + 1 < DEPTH) { const int nwg = (int)F.X[XW_NTILES] * 8, c = (int)blockIdx.x; const int mine = nwg > c ? (nwg - c + F.G - 1) / F.G : 0, most = (nwg + F.G - 1) / F.G;
        if (mine < most) cvt_fill(F, layer + 1, FILL_E2); }
    GRID_BAR(); }
    }
    if constexpr (layer + 1 < DEPTH) cvt_fill(F, layer + 1, -1);
    for (int rep_ = 0; rep_ < REP_R2; ++rep_) {     r2_phase(F, layer, layer == DEPTH - 1, (layer + 1 < DEPTH && ((layer + 1) & 1) == 0) ? (layer + 1) / 2 : -1, ((MOE_LAYER_MASK >> layer) & 1) ? 4 : 0); GRID_BAR(); }
}

struct Args { const float* in[20]; float* out; unsigned char* ws; };
__global__ void __launch_bounds__(NTHREADS, 2) fwd(Args args) {
    extern __shared__ __attribute__((aligned(16))) unsigned char lds_raw[];
    Frame F;
    F.lds = (LAS unsigned char*)lds_raw; F.X = (LAS unsigned*)(F.lds + LDSX_OFF);
    F.tid = threadIdx.x; F.lane = F.tid & 63; F.wave = __builtin_amdgcn_readfirstlane(F.tid >> 6); F.wave0 = F.wave; F.G = gridDim.x;
    F.ws_ = args.ws;
    for (int u = F.tid; u < XW_WORDS; u += NTHREADS) F.X[u] = 0u;
    __syncthreads();
    if (F.tid == 0) {
#pragma unroll
        for (int i = 0; i < 20; ++i) { const unsigned long long p = (unsigned long long)args.in[i]; F.X[XW_INP + 2 * i] = (unsigned)p; F.X[XW_INP + 2 * i + 1] = (unsigned)(p >> 32); }
        { const unsigned long long p = (unsigned long long)args.out; F.X[XW_INP + 40] = (unsigned)p; F.X[XW_INP + 41] = (unsigned)(p >> 32); } }
    __syncthreads();
    (void)xcd_barrier_post((unsigned*)(F.ctlp() + CW_BAR), (volatile LAS unsigned*)(F.X + XW_BAR));

    for (int rep = 0; rep < REP_P0A; ++rep) { p0a_weights(F); GRID_BAR(); }
    p0b_rows(F); GRID_BAR();
#define GRID_BAR_() GRID_BAR()
    moe_layer<0>(F); moe_layer<1>(F); moe_layer<2>(F); moe_layer<3>(F);
}

extern "C" void kernel_launch(void* const* d_in, const int* in_sizes, int n_in, void* d_out, int out_size, void* d_ws, size_t ws_size, hipStream_t stream) {
    static int grid = 0;
    if (grid == 0) {
        if (n_in != 20 || out_size != T * D || ws_size < WS_END) { fprintf(stderr, "kernel_launch: unexpected shapes (n_in %d out %d ws %zu need %zu)\n", n_in, out_size, ws_size, (size_t)WS_END); grid = -1; return; }
        int dev = 0, cus = 0, per_cu = 0;
        if (hipGetDevice(&dev) != hipSuccess || hipDeviceGetAttribute(&cus, hipDeviceAttributeMultiprocessorCount, dev) != hipSuccess) { grid = -1; return; }
        if (hipFuncSetAttribute((const void*)fwd, hipFuncAttributeMaxDynamicSharedMemorySize, LDS_BYTES) != hipSuccess) { fprintf(stderr, "kernel_launch: hipFuncSetAttribute failed\n"); grid = -1; return; }
        if (hipOccupancyMaxActiveBlocksPerMultiprocessor(&per_cu, (const void*)fwd, NTHREADS, LDS_BYTES) != hipSuccess || per_cu < 1) { fprintf(stderr, "kernel_launch: occupancy query says %d\n", per_cu); }
        (void)hipGetLastError();
        grid = cus;
    }
    if (grid < 0) return;
    if (hipMemsetAsync((char*)d_ws + WS_CTL, 0, CTL_ZERO_BYTES, stream) != hipSuccess) return;
    Args a{};
    for (int i = 0; i < 20; ++i) a.in[i] = (const float*)d_in[i];
    a.out = (float*)d_out; a.ws = (unsigned char*)d_ws;
    hipLaunchKernelGGL(fwd, dim3(grid), dim3(NTHREADS), LDS_BYTES, stream, a);
    const hipError_t le = hipPeekAtLastError();
    if (le != hipSuccess) fprintf(stderr, "kernel_launch: launch failed: %s\n", hipGetErrorName(le));
}
```

```cpp
#include <utility>
#include <type_traits>
#include <hip/hip_runtime.h>
#include <cstdio>
#include <cstdint>

#define LAS __attribute__((address_space(3)))
#define GAS __attribute__((address_space(1)))
typedef unsigned short bf16;
typedef short bf16x8 __attribute__((ext_vector_type(8)));
typedef short s16x4 __attribute__((ext_vector_type(4)));
typedef float f32x4 __attribute__((ext_vector_type(4)));
typedef float f32x2 __attribute__((ext_vector_type(2)));
typedef unsigned u32x4 __attribute__((ext_vector_type(4)));
typedef unsigned u32x2 __attribute__((ext_vector_type(2)));
typedef GAS unsigned gu32;
#define RLX_AGENT __ATOMIC_RELAXED, __HIP_MEMORY_SCOPE_AGENT

constexpr int T = 16384, D = 2048, DEPTH = 4, SEQ = 4096, NBATCH = 4;
constexpr int NE = 32, TOPK = 4, FF = 512;
constexpr int HEADS = 8, DV = 256, DK = 128, QKW = 1024, VW = 2048, MIN_COLS = 6176, MIN_MAIN = 6144;
constexpr int CAP = T;
constexpr int MAXSLOT = T * TOPK + NE * 256;
constexpr float ALPHA = 1.6817928305074290f;
constexpr float LN_EPS = 1e-5f;
constexpr float Y_SCALE = 16.0f;
constexpr int NWAVES = 8, NTHREADS = 512;
#ifndef EXP_NO_MOE
#define EXP_NO_MOE 0
#endif

constexpr size_t MiB = 1u << 20;
constexpr size_t WS_CTL = 0, CTL_ZERO_BYTES = 1 * MiB;
constexpr size_t WS_WGU = 1 * MiB;
constexpr size_t WS_WDN = WS_WGU + 512 * MiB;
constexpr size_t WS_WMI = WS_WDN + 256 * MiB;
constexpr size_t WS_WMO = WS_WMI + 48 * MiB;
constexpr size_t WS_WGI = WS_WMO + 16 * MiB;
constexpr size_t WS_WGO = WS_WGI + 32 * MiB;
constexpr size_t WS_WSM = WS_WGO + 16 * MiB;
constexpr size_t WS_WG_T = WS_WSM, WS_WR_T = WS_WSM + 256 * 1024, WS_WS = WS_WSM + 768 * 1024;
constexpr size_t WS_XB = WS_WSM + 2 * MiB;
constexpr size_t WS_X1 = WS_XB + 64 * MiB;
constexpr size_t WS_PRE = WS_X1 + 64 * MiB;
constexpr size_t WS_MIX = WS_PRE + 64 * MiB;
constexpr size_t WS_HACT = WS_MIX + 384 * MiB;
constexpr size_t WS_Y = WS_HACT + 72 * MiB;
constexpr size_t WS_LIST = WS_Y + 288 * MiB;
constexpr size_t WS_TOK = WS_LIST + 2 * MiB;
constexpr size_t WS_GATES = WS_TOK + 1 * MiB;
constexpr size_t WS_X1F8 = WS_GATES + 2 * MiB;
constexpr size_t WS_END = WS_X1F8 + 32 * MiB;

constexpr size_t WS_GU = WS_MIX, WS_GV = WS_MIX + 64 * MiB, WS_GY = WS_MIX + 128 * MiB, WS_VSTAT = WS_MIX + 192 * MiB;
constexpr size_t WS_MQ = WS_MIX, WS_MK = WS_MIX + 32 * MiB, WS_MV = WS_MIX + 64 * MiB, WS_MO = WS_MIX + 128 * MiB, WS_HF = WS_MIX + 192 * MiB, WS_HB = WS_MIX + 256 * MiB, WS_HG = WS_MIX + 320 * MiB;
constexpr int CW_TMO = 0, CW_CODE = 1, CW_BAR = 4096, CW_CNT = 8192;

constexpr int RING_BYTES = 131072;
constexpr int LDS_BYTES = 163840;
constexpr int LDSX_OFF = LDS_BYTES - 4096;
constexpr int XW_BAR = 8, XW_LCNT = 64, XW_LBASE = 96, XW_CNT = 128, XW_TPRE = 160, XW_PSTART = 200, XW_NTILES = 232, XW_TILE_E = 256, XW_INP = 600, XW_WORDS = 1024;
constexpr int XT_PITCH = 4112;
constexpr int RP_PART = 66048, RP_LOG = 82944, LOGP = 36, RP_GB = 90112, RP_LOGA = 106496;

__device__ __forceinline__ unsigned f2bf(float f) { unsigned u = __builtin_bit_cast(unsigned, f); return (u + 0x7fffu + ((u >> 16) & 1u)) >> 16; }
__device__ __forceinline__ unsigned cvt_pk_bf16_nop(float lo, float hi) { unsigned r; asm volatile("v_cvt_pk_bf16_f32 %0, %1, %2\n\ts_nop 1" : "=v"(r) : "v"(lo), "v"(hi)); return r; }
__device__ __forceinline__ unsigned cvt_pk_bf16(float lo, float hi) { unsigned r; asm volatile("v_cvt_pk_bf16_f32 %0, %1, %2" : "=v"(r) : "v"(lo), "v"(hi)); return r; }
__device__ __forceinline__ float bf_lo(unsigned w) { return __builtin_bit_cast(float, w << 16); }
__device__ __forceinline__ float bf_hi(unsigned w) { return __builtin_bit_cast(float, w & 0xffff0000u); }
__device__ __forceinline__ float wave_sum(float v) {
#pragma unroll
    for (int o = 1; o < 64; o <<= 1) v += __shfl_xor(v, o);
    return v;
}
#define LDS_WAIT() asm volatile("s_waitcnt lgkmcnt(0)" ::: "memory")
#define VM_WAIT() asm volatile("s_waitcnt vmcnt(0)" ::: "memory")

namespace pg8 {
constexpr int BM = 256, BK = 64, HALF = 128, HTB = HALF * BK * 2, STAGE_BYTES = 8 * HTB, NXCD = 8, WGM = 8;
__host__ __device__ __forceinline__ int lds_byte(int r, int c) { const int st = (r >> 4) * 2 + (c >> 5), rr = r & 15, cc = c & 31, ob = rr * 64 + cc * 2; return st * 1024 + (ob ^ (((ob >> 9) & 1) << 5)); }
__host__ __device__ __forceinline__ void stage_rc(int b, int& R, int& C) { const int st = b / 1024, sb = b % 1024, swz = sb ^ (((sb >> 9) & 1) << 5); R = (st >> 1) * 16 + swz / 64; C = (st & 1) * 32 + (swz % 64) / 2; }
__host__ __device__ __forceinline__ int perm32(int rho) { const int n = rho >> 4, i = rho & 15; return 8 * (i >> 2) + 4 * n + (i & 3); }

struct Unit { int pm, pn, e, x; };
typedef int v8i_t __attribute__((ext_vector_type(8)));
typedef int v4i_t __attribute__((ext_vector_type(4)));
__device__ __forceinline__ v8i_t cat_v8(bf16x8 lo, bf16x8 hi) { return __builtin_shufflevector(__builtin_bit_cast(v4i_t, lo), __builtin_bit_cast(v4i_t, hi), 0, 1, 2, 3, 4, 5, 6, 7); }

__device__ __forceinline__ void mfma_f8_tied(f32x4& acc, v8i_t a, v8i_t b, int sa, int sb) {
    asm volatile("v_mfma_scale_f32_16x16x128_f8f6f4 %0, %1, %2, %0, %3, %4 op_sel_hi:[0,0,0]" : "+v"(acc) : "v"(a), "v"(b), "v"(sa), "v"(sb));
}
__device__ __forceinline__ int xcd_remap(int wgid, int nwg) { const int q = nwg / NXCD, r = nwg % NXCD, xcd = wgid % NXCD, off = wgid / NXCD; return (xcd < r ? xcd * (q + 1) : r * (q + 1) + (xcd - r) * q) + off; }

template <class Prob, bool ALIGN_EPI = true>
__device__ __forceinline__ void gemm_phase(LAS unsigned char* lds, const Prob& P, int wave_id) {
    int wid = wave_id; asm volatile("" : "+s"(wid)); unsigned z_ = 0u; asm volatile("" : "+v"(z_)); const int lane = (int)__builtin_amdgcn_mbcnt_hi(~0u, __builtin_amdgcn_mbcnt_lo(~0u, z_));
    const int tid = wid * 64 + lane, wr = wid >> 2, wc = wid & 3, fr = lane & 15, fq = lane >> 4;
    constexpr int K = Prob::K, nt = K / BK;
    unsigned voffB[2];
#pragma unroll
    for (int i = 0; i < 2; ++i) { int R, C; stage_rc(tid * 16 + i * 8192, R, C); const int Rb = Prob::PERM ? ((R & ~31) + perm32(R & 31)) : R;
        voffB[i] = (unsigned)(Rb * K + C) * 2u; }
    const size_t kstep = (size_t)(BK * 2);
    const size_t hstep = (size_t)HALF * K * 2;
    const unsigned ldsw = (unsigned)wid * 1024u;
    const int aoff = lds_byte(wr * 64 + fr, fq * 8), boff = lds_byte(wc * 32 + fr, fq * 8);
#define PG8_SA(b, h) (((b) * 2 + (h)) * HTB)
#define PG8_SB(b, h) ((4 + (b) * 2 + (h)) * HTB)
#define PG8_STAGE(bufoff, gbase, v0, v1) do { \
        __builtin_amdgcn_global_load_lds((const unsigned*)((const char*)(gbase) + (v0)), (LAS unsigned*)(lds + (bufoff) + ldsw), 16, 0, 0); \
        __builtin_amdgcn_global_load_lds((const unsigned*)((const char*)(gbase) + (v1)), (LAS unsigned*)(lds + (bufoff) + ldsw + 8192), 16, 0, 0); } while (0)
#define PG8_STB(bufoff, gbase) PG8_STAGE(bufoff, gbase, voffB[0], voffB[1])
#define PG8_LDA(dst, b, h) do { _Pragma("unroll") for (int m = 0; m < 4; ++m) _Pragma("unroll") for (int k = 0; k < 2; ++k) dst[m][k] = *(const LAS bf16x8*)(lds + PG8_SA(b, h) + aoff + m * 2048 + k * 1024); } while (0)
#define PG8_LDB(dst, b, h) do { _Pragma("unroll") for (int n = 0; n < 2; ++n) _Pragma("unroll") for (int k = 0; k < 2; ++k) dst[n][k] = *(const LAS bf16x8*)(lds + PG8_SB(b, h) + boff + n * 2048 + k * 1024); } while (0)
#define PG8_MMA(ai, bj, At, Bt) do { __builtin_amdgcn_s_setprio(1); \
        if constexpr (Prob::FP8) { asm volatile("s_nop 1" ::: "memory"); _Pragma("unroll") for (int m = 0; m < 4; ++m) _Pragma("unroll") for (int n = 0; n < 2; ++n) \
            mfma_f8_tied(acc[ai][bj][m][n], cat_v8(Bt[n][0], Bt[n][1]), cat_v8(At[m][0], At[m][1]), sc_w, sc_x); } \
        else { _Pragma("unroll") for (int m = 0; m < 4; ++m) _Pragma("unroll") for (int n = 0; n < 2; ++n) _Pragma("unroll") for (int k = 0; k < 2; ++k) \
            acc[ai][bj][m][n] = __builtin_amdgcn_mfma_f32_16x16x32_bf16(Bt[n][k], At[m][k], acc[ai][bj][m][n], 0, 0, 0); } \
        __builtin_amdgcn_s_setprio(0); } while (0)
#define PG8_WAIT_V(n) asm volatile("s_waitcnt vmcnt(" #n ")" ::: "memory")
#define PG8_WAIT_L(n) asm volatile("s_waitcnt lgkmcnt(" #n ")" ::: "memory")
#define PG8_BAR __builtin_amdgcn_s_barrier()
#define PG8_SCHED __builtin_amdgcn_sched_barrier(0)
    Unit cur, nxt; int ui = 0;
    if (!P.next(0, cur)) return;
    int sc_w = Prob::SCALE_B, sc_x = 0x7f7f7f7f; if constexpr (Prob::FP8) { asm volatile("" : "+v"(sc_w), "+v"(sc_x)); }
    float zf_ = 0.f; asm volatile("" : "+v"(zf_)); const f32x4 zero4 = (f32x4){zf_, zf_, zf_, zf_};
    f32x4 acc[2][2][4][2];
#pragma unroll
    for (int a = 0; a < 2; ++a)
#pragma unroll
        for (int b = 0; b < 2; ++b)
#pragma unroll
            for (int m = 0; m < 4; ++m)
#pragma unroll
                for (int n = 0; n < 2; ++n) acc[a][b][m][n] = zero4;
    bf16x8 At[4][2], B0[2][2], B1[2][2];
    const char* cA; const char* cB; unsigned va[2][2], vn[2][2];
    P.bases(cur, cA, cB); P.avoff(cur, tid, va);
    PG8_STB(PG8_SB(0, 0), cB); PG8_STB(PG8_SB(0, 1), cB + hstep); PG8_STAGE(PG8_SA(0, 0), cA, va[0][0], va[0][1]); PG8_STAGE(PG8_SA(0, 1), cA, va[1][0], va[1][1]);
    if (wr == 1) PG8_BAR;
    PG8_WAIT_V(2); PG8_BAR;
    PG8_STB(PG8_SB(1, 0), cB + kstep); PG8_STAGE(PG8_SA(1, 0), cA + kstep, va[0][0], va[0][1]); PG8_STB(PG8_SB(1, 1), cB + hstep + kstep);
    PG8_WAIT_V(6); PG8_BAR;
    for (;;) {
        const bool has_next = P.next(ui + 1, nxt);
        const char* nA = cA; const char* nB = cB;
#pragma unroll
        for (int h = 0; h < 2; ++h)
#pragma unroll
            for (int i = 0; i < 2; ++i) vn[h][i] = va[h][i];
        if (has_next) { P.bases(nxt, nA, nB); P.avoff(nxt, tid, vn); }
        for (int t = 0; t < nt; t += 2) {
            const bool last = (t == nt - 2);
            const char* a1 = cA + (size_t)(t + 1) * kstep;
            const char* a2 = last ? nA : cA + (size_t)(t + 2) * kstep; const char* b2 = last ? nB : cB + (size_t)(t + 2) * kstep;
            const char* a3 = a2 + kstep; const char* b3 = b2 + kstep;
            const unsigned s00 = last ? vn[0][0] : va[0][0], s01 = last ? vn[0][1] : va[0][1], s10 = last ? vn[1][0] : va[1][0], s11 = last ? vn[1][1] : va[1][1];
            PG8_LDB(B0, 0, 0); PG8_LDB(B1, 0, 1); PG8_SCHED; PG8_LDA(At, 0, 0); PG8_STAGE(PG8_SA(1, 1), a1, va[1][0], va[1][1]);
            PG8_WAIT_V(8); PG8_WAIT_L(0); PG8_BAR; PG8_MMA(0, 0, At, B0); PG8_MMA(0, 1, At, B1); PG8_BAR; PG8_SCHED;
            PG8_LDA(At, 0, 1); PG8_STB(PG8_SB(0, 0), b2); PG8_STB(PG8_SB(0, 1), b2 + hstep); PG8_STAGE(PG8_SA(0, 0), a2, s00, s01);
            PG8_WAIT_V(8); PG8_WAIT_L(0); PG8_BAR; PG8_MMA(1, 0, At, B0); PG8_MMA(1, 1, At, B1); PG8_BAR; PG8_SCHED;
            PG8_LDB(B0, 1, 0); PG8_LDB(B1, 1, 1); PG8_SCHED; PG8_LDA(At, 1, 0); PG8_STAGE(PG8_SA(0, 1), a2, s10, s11);
            PG8_WAIT_V(8); PG8_WAIT_L(0); PG8_BAR; PG8_MMA(0, 0, At, B0); PG8_MMA(0, 1, At, B1); PG8_BAR; PG8_SCHED;
            PG8_LDA(At, 1, 1); PG8_STB(PG8_SB(1, 0), b3); PG8_STB(PG8_SB(1, 1), b3 + hstep); PG8_STAGE(PG8_SA(1, 0), a3, s00, s01);
            PG8_WAIT_V(8); PG8_WAIT_L(0); PG8_BAR; PG8_MMA(1, 0, At, B0); PG8_MMA(1, 1, At, B1); PG8_BAR; PG8_SCHED;
        }
        if constexpr (ALIGN_EPI) { if (wr == 0) PG8_BAR; }
        if constexpr (Prob::FP8) asm volatile("s_nop 15\n\ts_nop 15" ::: "memory");
        P.epi(acc, cur, wr, wc, fr, fq);
        if (!has_next) break;
#pragma unroll
        for (int a = 0; a < 2; ++a)
#pragma unroll
            for (int b = 0; b < 2; ++b)
#pragma unroll
                for (int m = 0; m < 4; ++m)
#pragma unroll
                    for (int n = 0; n < 2; ++n) acc[a][b][m][n] = zero4;
        cur = nxt; cA = nA; cB = nB; ++ui;
#pragma unroll
        for (int h = 0; h < 2; ++h)
#pragma unroll
            for (int i = 0; i < 2; ++i) va[h][i] = vn[h][i];
        if constexpr (ALIGN_EPI) { if (wr == 1) PG8_BAR; }
    }
    PG8_WAIT_V(0);
    if constexpr (!ALIGN_EPI) { if (wr == 0) PG8_BAR; }
    PG8_BAR;
#undef PG8_SA
#undef PG8_SB
#undef PG8_STAGE
#undef PG8_STB
#undef PG8_LDA
#undef PG8_LDB
#undef PG8_MMA
#undef PG8_WAIT_V
#undef PG8_WAIT_L
#undef PG8_BAR
#undef PG8_SCHED
}
}

#define XB_TMO      128
#define XB_XCNT(j)  (256  + 64 * (j))
#define XB_XSUB(j)  (1280 + 64 * (j))
#define XB_XGEN(j)  (2304 + 64 * (j))
#define XB_TOP      3328
#define XB_TOPGEN   3392
#define XCD_BAR_WORDS 3456
#define XB_SPIN_CAP (1u << 18)
__device__ __forceinline__ unsigned xb_ld(unsigned* p)              { return __hip_atomic_load(p, __ATOMIC_RELAXED, __HIP_MEMORY_SCOPE_AGENT); }
__device__ __forceinline__ unsigned xb_add(unsigned* p, unsigned v) { return __hip_atomic_fetch_add(p, v, __ATOMIC_RELAXED, __HIP_MEMORY_SCOPE_AGENT); }
__device__ __forceinline__ unsigned xb_xcc_id() { return (unsigned)__builtin_amdgcn_s_getreg((3 << 11) | 20) & 0xFu; }
#define XB_SPIN(cond, bar) do { unsigned _sp = 0; while (cond) { __builtin_amdgcn_s_sleep(1); \
    if ((++_sp & 255u) == 0u) { if (xb_ld(&(bar)[XB_TMO])) break; if (_sp > XB_SPIN_CAP) { atomicAdd(&(bar)[XB_TMO], 1u); break; } } } } while (0)
struct XcdBarrier { unsigned* bar; unsigned x; volatile LAS unsigned* st; };
__device__ __forceinline__ XcdBarrier xcd_barrier_post(unsigned* bar, volatile LAS unsigned* st) {
    XcdBarrier b; b.bar = bar; b.x = xb_xcc_id(); b.st = st;
    if (threadIdx.x == 0) (void)xb_add(&bar[XB_XCNT(b.x)], 1u);
    return b;
}
__device__ __forceinline__ void xcd_barrier_complete(unsigned* bar, unsigned x, unsigned& nloc, unsigned& nx) {
    const unsigned G = gridDim.x * gridDim.y * gridDim.z;
    unsigned sum, cnt, mine, sp = 0u;
    for (;;) {
        sum = 0u; cnt = 0u; mine = 0u;
#pragma unroll
        for (unsigned j = 0; j < 16; ++j) { const unsigned c = xb_ld(&bar[XB_XCNT(j)]); sum += c; cnt += (c > 0u) ? 1u : 0u; mine = (j == x) ? c : mine; }
        if (sum == G) break;
        __builtin_amdgcn_s_sleep(1);
        if ((++sp & 255u) == 0u) { if (xb_ld(&bar[XB_TMO])) break; if (sp > XB_SPIN_CAP) { atomicAdd(&bar[XB_TMO], 1u); break; } }
    }
    nloc = mine > 0u ? mine : 1u; nx = cnt > 0u ? cnt : 1u;
}
__device__ __forceinline__ void xcd_barrier(const XcdBarrier& b, bool is_t0) {
    asm volatile("s_waitcnt vmcnt(0)" ::: "memory");
    __syncthreads();
    if (is_t0) {
        unsigned* bar = b.bar;
        __builtin_amdgcn_s_waitcnt(0);
        unsigned nloc = b.st[0], nx = b.st[1];
        if (nloc == 0u) { xcd_barrier_complete(bar, b.x, nloc, nx); b.st[0] = nloc; b.st[1] = nx; }
        const unsigned old = xb_add(&bar[XB_XSUB(b.x)], 1u);
        const unsigned gen = old / nloc;
        if (old + 1u == (gen + 1u) * nloc) {
            __builtin_amdgcn_fence(__ATOMIC_RELEASE, "agent");
            asm volatile("s_waitcnt vmcnt(0)" ::: "memory");
            const unsigned og = xb_add(&bar[XB_TOP], 1u);
            const unsigned tg = og / nx;
            if (og + 1u == (tg + 1u) * nx) xb_add(&bar[XB_TOPGEN], 1u);
            else XB_SPIN(xb_ld(&bar[XB_TOPGEN]) == tg, bar);
            __builtin_amdgcn_fence(__ATOMIC_ACQUIRE, "agent");
            xb_add(&bar[XB_XGEN(b.x)], 1u);
            asm volatile("s_waitcnt vmcnt(0)" ::: "memory");
        } else {
            XB_SPIN(xb_ld(&bar[XB_XGEN(b.x)]) == gen, bar);
            __builtin_amdgcn_fence(__ATOMIC_ACQUIRE, "agent");
            asm volatile("s_waitcnt vmcnt(0)" ::: "memory");
        }
    }
    __syncthreads();
}

struct Frame {
    LAS unsigned char* lds;
    LAS unsigned* X;
    unsigned char* ws_;
    int tid, lane, wave, G;
    __device__ __forceinline__ unsigned char* wsp() const { unsigned char* p = ws_; asm volatile("" : "+s"(p)); return p; }
    __device__ __forceinline__ gu32* ctlp() const { return (gu32*)(wsp() + WS_CTL); }
    __device__ __forceinline__ float* outp() const { return (float*)inp(20); }
    __device__ __forceinline__ const float* inp(int i) const { const unsigned lo = __builtin_amdgcn_readfirstlane(X[XW_INP + 2 * i]), hi = __builtin_amdgcn_readfirstlane(X[XW_INP + 2 * i + 1]);
        return (const float*)(((unsigned long long)hi << 32) | lo); }
    int wave0;
    __device__ __forceinline__ void rethread() { int w = wave0; asm volatile("" : "+s"(w)); unsigned z = 0u; asm volatile("" : "+v"(z)); const int l = (int)__builtin_amdgcn_mbcnt_hi(~0u, __builtin_amdgcn_mbcnt_lo(~0u, z)); wave = w; lane = l; tid = w * 64 + l; }
};
enum { I_X = 0, I_MWIN, I_MBG, I_MNG, I_MWOUT, I_GWIN, I_GBIN, I_GVG, I_GVB, I_GWS, I_GBS, I_GWOUT, I_RW, I_RB, I_EWGU, I_EBGU, I_EWDN, I_EBDN, I_LNG, I_LNB };

constexpr int TR_P = 65, TR_WAVE_BYTES = 64 * TR_P * 4;
__device__ __forceinline__ void tr_item64(const float* W, int N, int k0, int n0, bf16* dst, int Kd, LAS float* scr, int lane) {
    f32x4 v[16];
#pragma unroll
    for (int i = 0; i < 16; ++i) v[i] = *(const GAS f32x4*)(W + (size_t)(k0 + 4 * i + (lane >> 4)) * N + n0 + (lane & 15) * 4);
#pragma unroll
    for (int i = 0; i < 16; ++i) { LAS float* p = scr + (4 * i + (lane >> 4)) * TR_P + (lane & 15) * 4; p[0] = v[i].x; p[1] = v[i].y; p[2] = v[i].z; p[3] = v[i].w; }
    LDS_WAIT(); asm volatile("" ::: "memory");
    const int c = lane & 7;
#pragma unroll
    for (int j = 0; j < 8; ++j) { const int n = (lane >> 3) + 8 * j; const LAS float* s = scr + (8 * c) * TR_P + n;
        u32x4 o; o.x = cvt_pk_bf16(s[0 * TR_P], s[1 * TR_P]); o.y = cvt_pk_bf16(s[2 * TR_P], s[3 * TR_P]); o.z = cvt_pk_bf16(s[4 * TR_P], s[5 * TR_P]); o.w = cvt_pk_bf16(s[6 * TR_P], s[7 * TR_P]);
        *(GAS u32x4*)(dst + (size_t)n * Kd + k0 + 8 * c) = o; }
    LDS_WAIT(); asm volatile("" ::: "memory");
}
__device__ __forceinline__ void tr_item64_f8(const float* W, int N, int k0, int n0, unsigned char* dst, int Kd, LAS float* scr, int lane, float wscale = 64.f) {
    f32x4 v[16];
#pragma unroll
    for (int i = 0; i < 16; ++i) v[i] = *(const GAS f32x4*)(W + (size_t)(k0 + 4 * i + (lane >> 4)) * N + n0 + (lane & 15) * 4);
#pragma unroll
    for (int i = 0; i < 16; ++i) { LAS float* p = scr + (4 * i + (lane >> 4)) * TR_P + (lane & 15) * 4; p[0] = v[i].x; p[1] = v[i].y; p[2] = v[i].z; p[3] = v[i].w; }
    LDS_WAIT(); asm volatile("" ::: "memory");
    const int c = lane & 3;
#pragma unroll
    for (int j = 0; j < 4; ++j) { const int n = (lane >> 2) + 16 * j; const LAS float* s = scr + (16 * c) * TR_P + n; unsigned w[4];
#pragma unroll
        for (int g = 0; g < 4; ++g) { int a_ = 0; a_ = __builtin_amdgcn_cvt_pk_fp8_f32(s[(4 * g) * TR_P] * wscale, s[(4 * g + 1) * TR_P] * wscale, a_, false); a_ = __builtin_amdgcn_cvt_pk_fp8_f32(s[(4 * g + 2) * TR_P] * wscale, s[(4 * g + 3) * TR_P] * wscale, a_, true); w[g] = (unsigned)a_; }
        *(GAS u32x4*)(dst + (size_t)n * Kd + k0 + 16 * c) = (u32x4){w[0], w[1], w[2], w[3]}; }
    LDS_WAIT(); asm volatile("" ::: "memory");
}
__device__ __forceinline__ void tr_item(const float* W, int N, int k0, int n0, bf16* dst, int Kd, LAS float* scr, int lane) {
#pragma unroll 8
    for (int i = 0; i < 32; ++i) { const int kk = 2 * i + (lane >> 5); scr[kk * 33 + (lane & 31)] = W[(size_t)(k0 + kk) * N + n0 + (lane & 31)]; }
    LDS_WAIT(); asm volatile("" ::: "memory");
    const int c = lane & 7;
#pragma unroll
    for (int j = 0; j < 4; ++j) { const int n = (lane >> 3) + 8 * j; const LAS float* s = scr + (8 * c) * 33 + n;
        u32x4 o; o.x = cvt_pk_bf16(s[0 * 33], s[1 * 33]); o.y = cvt_pk_bf16(s[2 * 33], s[3 * 33]); o.z = cvt_pk_bf16(s[4 * 33], s[5 * 33]); o.w = cvt_pk_bf16(s[6 * 33], s[7 * 33]);
        *(GAS u32x4*)(dst + (size_t)n * Kd + k0 + 8 * c) = o; }
    LDS_WAIT(); asm volatile("" ::: "memory");
}

constexpr int CVT_ITEMS = 32 * 32 * 16 + 32 * 8 * 32, CW_CVT = 24576, XW_CVT = 660;
__device__ __forceinline__ void cvt_moe_item(Frame& F, int L, int idx, LAS float* scr) {
    if (idx < 32 * 512) { const int le = L * 32 + idx / 512, q = idx % 512, kb = q % 32, nb = q / 32;
        const int n0 = nb * 64, half = n0 >> 9, nn = n0 & 511, row = (nn >> 7) * 256 + half * 128 + (nn & 127);
        tr_item64_f8(F.inp(I_EWGU) + (size_t)le * D * 1024, 1024, kb * 64, n0, (unsigned char*)(F.wsp() + WS_WGU) + ((size_t)le * 1024 + row) * D, D, scr, F.lane); }
    else { const int r = idx - 32 * 512; const int le = L * 32 + r / 256, q = r % 256, kb = q % 8, nb = q / 8;
        tr_item64_f8(F.inp(I_EWDN) + (size_t)le * FF * D, D, kb * 64, nb * 64, (unsigned char*)(F.wsp() + WS_WDN) + ((size_t)le * D + nb * 64) * FF, FF, scr, F.lane); }
}
__device__ __forceinline__ void cvt_fill(Frame& F, int L, int max_batches) {
    F.rethread();
    LAS float* scr = (LAS float*)(F.lds + F.wave * TR_WAVE_BYTES);
    gu32* ctr = F.ctlp() + CW_CVT + L * 64;
#pragma unroll 1
    for (int bt = 0; max_batches < 0 || bt < max_batches; ++bt) {
        if (F.tid == 0) F.X[XW_CVT] = __hip_atomic_fetch_add(ctr, 8u, RLX_AGENT);
        __syncthreads();
        const int base = (int)F.X[XW_CVT];
        __syncthreads();
        if (base >= CVT_ITEMS) break;
        const int idx = base + F.wave; if (idx < CVT_ITEMS) cvt_moe_item(F, L, idx, scr);
    }
    __syncthreads();
}
constexpr int P0_S0 = 2 * 32 * 96, P0_S1 = 2 * 32 * 32, P0_S2 = 2 * 32 * 64, P0_S3 = 2 * 32 * 32, P0_NI64 = P0_S0 + P0_S1 + P0_S2 + P0_S3 + CVT_ITEMS;
__device__ __forceinline__ void p0a_decode(Frame& F, int it, const float*& src, int& N, unsigned char*& dst, int& Kd, int& f8, float& scale) {
    int r = it;
    if (r < P0_S0) { const int j = r / (32 * 96), q = r % (32 * 96), kb = q % 32, nb = q / 32;
        src = F.inp(I_MWIN) + (size_t)j * D * MIN_COLS + (size_t)(kb * 64) * MIN_COLS + nb * 64; N = MIN_COLS; dst = (unsigned char*)((bf16*)(F.wsp() + WS_WMI) + ((size_t)j * MIN_MAIN + nb * 64) * D + kb * 64); Kd = D; f8 = 0; scale = 1.f; return; } r -= P0_S0;
    if (r < P0_S1) { const int j = r / 1024, q = r % 1024, kb = q % 32, nb = q / 32;
        src = F.inp(I_MWOUT) + (size_t)j * D * D + (size_t)(kb * 64) * D + nb * 64; N = D; dst = (unsigned char*)(F.wsp() + WS_WMO) + ((size_t)j * D + nb * 64) * D + kb * 64; Kd = D; f8 = 1; scale = 128.f; return; } r -= P0_S1;
    if (r < P0_S2) { const int j = r / 2048, q = r % 2048, kb = q % 32, nb = q / 32;
        src = F.inp(I_GWIN) + (size_t)j * D * 4096 + (size_t)(kb * 64) * 4096 + nb * 64; N = 4096; dst = (unsigned char*)((bf16*)(F.wsp() + WS_WGI) + ((size_t)j * 4096 + nb * 64) * D + kb * 64); Kd = D; f8 = 0; scale = 1.f; return; } r -= P0_S2;
    if (r < P0_S3) { const int j = r / 1024, q = r % 1024, kb = q % 32, nb = q / 32;
        src = F.inp(I_GWOUT) + (size_t)j * D * D + (size_t)(kb * 64) * D + nb * 64; N = D; dst = (unsigned char*)(F.wsp() + WS_WGO) + ((size_t)j * D + nb * 64) * D + kb * 64; Kd = D; f8 = 1; scale = 128.f; return; } r -= P0_S3;
    f8 = 1; scale = 64.f;
    if (r < 32 * 512) { const int le = r / 512, q = r % 512, kb = q % 32, nb = q / 32; const int n0 = nb * 64, half = n0 >> 9, nn = n0 & 511, row = (nn >> 7) * 256 + half * 128 + (nn & 127);
        src = F.inp(I_EWGU) + (size_t)le * D * 1024 + (size_t)(kb * 64) * 1024 + n0; N = 1024; dst = (unsigned char*)(F.wsp() + WS_WGU) + ((size_t)le * 1024 + row) * D + kb * 64; Kd = D; }
    else { r -= 32 * 512; const int le = r / 256, q = r % 256, kb = q % 8, nb = q / 8;
        src = F.inp(I_EWDN) + (size_t)le * FF * D + (size_t)(kb * 64) * D + nb * 64; N = D; dst = (unsigned char*)(F.wsp() + WS_WDN) + ((size_t)le * D + nb * 64) * FF + kb * 64; Kd = FF; }
}
__device__ __forceinline__ void tr_load64(const float* src, int N, int lane, f32x4 (&v)[16]) {
#pragma unroll
    for (int i = 0; i < 16; ++i) v[i] = *(const GAS f32x4*)(src + (size_t)(4 * i + (lane >> 4)) * N + (lane & 15) * 4);
}
__device__ __forceinline__ void tr_finish64(const f32x4 (&v)[16], unsigned char* dst, int Kd, int f8, float wscale, LAS float* scr, int lane) {
#pragma unroll
    for (int i = 0; i < 16; ++i) { LAS float* p = scr + (4 * i + (lane >> 4)) * TR_P + (lane & 15) * 4; p[0] = v[i].x; p[1] = v[i].y; p[2] = v[i].z; p[3] = v[i].w; }
    LDS_WAIT(); asm volatile("" ::: "memory");
    if (f8) { const int c = lane & 3;
#pragma unroll
        for (int j = 0; j < 4; ++j) { const int n = (lane >> 2) + 16 * j; const LAS float* s = scr + (16 * c) * TR_P + n; unsigned w[4];
#pragma unroll
            for (int g = 0; g < 4; ++g) { int a_ = 0; a_ = __builtin_amdgcn_cvt_pk_fp8_f32(s[(4 * g) * TR_P] * wscale, s[(4 * g + 1) * TR_P] * wscale, a_, false); a_ = __builtin_amdgcn_cvt_pk_fp8_f32(s[(4 * g + 2) * TR_P] * wscale, s[(4 * g + 3) * TR_P] * wscale, a_, true); w[g] = (unsigned)a_; }
            *(GAS u32x4*)(dst + (size_t)n * Kd + 16 * c) = (u32x4){w[0], w[1], w[2], w[3]}; } }
    else { const int c = lane & 7;
#pragma unroll
        for (int j = 0; j < 8; ++j) { const int n = (lane >> 3) + 8 * j; const LAS float* s = scr + (8 * c) * TR_P + n;
            u32x4 o; o.x = cvt_pk_bf16(s[0 * TR_P], s[1 * TR_P]); o.y = cvt_pk_bf16(s[2 * TR_P], s[3 * TR_P]); o.z = cvt_pk_bf16(s[4 * TR_P], s[5 * TR_P]); o.w = cvt_pk_bf16(s[6 * TR_P], s[7 * TR_P]);
            *(GAS u32x4*)((bf16*)dst + (size_t)n * Kd + 8 * c) = o; } }
    LDS_WAIT(); asm volatile("" ::: "memory");
}
__device__ __forceinline__ void p0a_weights(Frame& F) {
    F.rethread();
    LAS float* scr = (LAS float*)(F.lds + F.wave * TR_WAVE_BYTES);
    const int gw = blockIdx.x * NWAVES + F.wave, NGW = F.G * NWAVES;
    { f32x4 va[16], vb[16]; const float* sA; const float* sB; unsigned char* dA; unsigned char* dB; int nA, nB, kA, kB, fA, fB; float cA, cB;
      int it = gw;
      if (it < P0_NI64) { p0a_decode(F, it, sA, nA, dA, kA, fA, cA); tr_load64(sA, nA, F.lane, va);
#pragma unroll 1
        for (;;) {
            const bool haveB = it + NGW < P0_NI64; p0a_decode(F, haveB ? it + NGW : it, sB, nB, dB, kB, fB, cB); tr_load64(sB, nB, F.lane, vb);
            tr_finish64(va, dA, kA, fA, cA, scr, F.lane);
            if (!haveB) break;
            const bool haveA = it + 2 * NGW < P0_NI64; p0a_decode(F, haveA ? it + 2 * NGW : it + NGW, sA, nA, dA, kA, fA, cA); tr_load64(sA, nA, F.lane, va);
            tr_finish64(vb, dB, kB, fB, cB, scr, F.lane);
            if (!haveA) break;
            it += 2 * NGW; } } }
    { constexpr int SG = 2 * 32, S4 = 4 * 32;
      for (int it = gw; it < SG + S4; it += NGW) { int r = it;
        if (r < SG) { const int j = r / 32, kb = r % 32;
            tr_item(F.inp(I_MWIN) + (size_t)j * D * MIN_COLS, MIN_COLS, kb * 64, MIN_MAIN, (bf16*)(F.wsp() + WS_WG_T) + (size_t)j * 32 * D, D, scr, F.lane); continue; } r -= SG;
        { const int l = r / 32, kb = r % 32;
            tr_item(F.inp(I_RW) + (size_t)l * D * NE, NE, kb * 64, 0, (bf16*)(F.wsp() + WS_WR_T) + (size_t)l * 32 * D, D, scr, F.lane); } } }
    { const float* src = F.inp(I_GWS); bf16* dst = (bf16*)(F.wsp() + WS_WS); const int n4 = 2 * 8 * 128 * 128 / 4;
      for (int i = blockIdx.x * NTHREADS + F.tid; i < n4; i += F.G * NTHREADS) { const f32x4 v = ((const GAS f32x4*)src)[i]; u32x2 o; o.x = cvt_pk_bf16(v.x, v.y); o.y = cvt_pk_bf16(v.z, v.w); ((GAS u32x2*)dst)[i] = o; } }
}

__device__ __forceinline__ void skinny16(Frame& F, const bf16* WT, const float* bias) {
    LAS unsigned char* XT = F.lds; LAS float* PART = (LAS float*)(F.lds + RP_PART); LAS float* LOG = (LAS float*)(F.lds + RP_LOG);
    const int r = F.lane & 15, q = F.lane >> 4;
    float zf_ = 0.f; asm volatile("" : "+v"(zf_)); f32x4 acc0 = (f32x4){zf_, zf_, zf_, zf_}, acc1 = acc0;
#pragma unroll
    for (int ks = 0; ks < 8; ++ks) {
        const int k0 = F.wave * 256 + ks * 32 + 8 * q;
        const bf16x8 a = *(const LAS bf16x8*)(XT + r * XT_PITCH + k0 * 2);
        const bf16x8 b0 = *(const GAS bf16x8*)(WT + (size_t)r * D + k0);
        const bf16x8 b1 = *(const GAS bf16x8*)(WT + (size_t)(16 + r) * D + k0);
        acc0 = __builtin_amdgcn_mfma_f32_16x16x32_bf16(a, b0, acc0, 0, 0, 0);
        acc1 = __builtin_amdgcn_mfma_f32_16x16x32_bf16(a, b1, acc1, 0, 0, 0);
    }
#pragma unroll
    for (int i = 0; i < 4; ++i) { PART[(F.wave * 16 + 4 * q + i) * 33 + r] = acc0[i]; PART[(F.wave * 16 + 4 * q + i) * 33 + 16 + r] = acc1[i]; }
    __syncthreads();
    { const int row = F.tid >> 5, e = F.tid & 31; float s = bias[e];
#pragma unroll
      for (int w = 0; w < 8; ++w) s += PART[(w * 16 + row) * 33 + e];
      LOG[row * LOGP + e] = s; }
    __syncthreads();
}
__device__ __forceinline__ void load_lane_vec32(const float* p, int lane, float (&v)[32]) {
#pragma unroll
    for (int j = 0; j < 4; ++j) { const f32x4 a = *(const GAS f32x4*)(p + 8 * lane + 512 * j), b = *(const GAS f32x4*)(p + 8 * lane + 512 * j + 4);
        v[8 * j + 0] = a.x; v[8 * j + 1] = a.y; v[8 * j + 2] = a.z; v[8 * j + 3] = a.w; v[8 * j + 4] = b.x; v[8 * j + 5] = b.y; v[8 * j + 6] = b.z; v[8 * j + 7] = b.w; }
}
__device__ __forceinline__ void load_row_bf16(const bf16* row, int lane, float (&v)[32]) {
#pragma unroll
    for (int j = 0; j < 4; ++j) { const u32x4 w = *(const GAS u32x4*)(row + 8 * lane + 512 * j);
        v[8 * j + 0] = bf_lo(w.x); v[8 * j + 1] = bf_hi(w.x); v[8 * j + 2] = bf_lo(w.y); v[8 * j + 3] = bf_hi(w.y); v[8 * j + 4] = bf_lo(w.z); v[8 * j + 5] = bf_hi(w.z); v[8 * j + 6] = bf_lo(w.w); v[8 * j + 7] = bf_hi(w.w); }
}
__device__ __forceinline__ void layer_norm32(float (&v)[32], const float (&g)[32], const float (&b)[32]) {
    float s = 0.f;
#pragma unroll
    for (int i = 0; i < 32; ++i) s += v[i];
    const float mean = wave_sum(s) * (1.f / D); float s2 = 0.f;
#pragma unroll
    for (int i = 0; i < 32; ++i) { v[i] -= mean; s2 += v[i] * v[i]; }
    const float rstd = 1.f / sqrtf(wave_sum(s2) * (1.f / D) + LN_EPS);
#pragma unroll
    for (int i = 0; i < 32; ++i) v[i] = v[i] * rstd * g[i] + b[i];
}
__device__ __forceinline__ void layer_norm32_lds(float (&v)[32], const LAS float* GL, const LAS float* BL, int lane) {
    float s = 0.f;
#pragma unroll
    for (int i = 0; i < 32; ++i) s += v[i];
    const float mean = wave_sum(s) * (1.f / D); float s2 = 0.f;
#pragma unroll
    for (int i = 0; i < 32; ++i) { v[i] -= mean; s2 += v[i] * v[i]; }
    const float rstd = 1.f / sqrtf(wave_sum(s2) * (1.f / D) + LN_EPS);
#pragma unroll
    for (int j = 0; j < 4; ++j) { const f32x4 g0 = *(const LAS f32x4*)(GL + 8 * lane + 512 * j), g1 = *(const LAS f32x4*)(GL + 8 * lane + 512 * j + 4), b0 = *(const LAS f32x4*)(BL + 8 * lane + 512 * j), b1 = *(const LAS f32x4*)(BL + 8 * lane + 512 * j + 4);
        v[8 * j + 0] = v[8 * j + 0] * rstd * g0.x + b0.x; v[8 * j + 1] = v[8 * j + 1] * rstd * g0.y + b0.y; v[8 * j + 2] = v[8 * j + 2] * rstd * g0.z + b0.z; v[8 * j + 3] = v[8 * j + 3] * rstd * g0.w + b0.w;
        v[8 * j + 4] = v[8 * j + 4] * rstd * g1.x + b1.x; v[8 * j + 5] = v[8 * j + 5] * rstd * g1.y + b1.y; v[8 * j + 6] = v[8 * j + 6] * rstd * g1.z + b1.z; v[8 * j + 7] = v[8 * j + 7] * rstd * g1.w + b1.w; }
}
__device__ __forceinline__ void store_row_bf16(const float (&v)[32], bf16* grow, LAS unsigned char* xt_row, bool to_lds, int lane) {
#pragma unroll
    for (int j = 0; j < 4; ++j) { u32x4 w; w.x = cvt_pk_bf16(v[8 * j], v[8 * j + 1]); w.y = cvt_pk_bf16(v[8 * j + 2], v[8 * j + 3]); w.z = cvt_pk_bf16(v[8 * j + 4], v[8 * j + 5]); w.w = cvt_pk_bf16(v[8 * j + 6], v[8 * j + 7]);
        *(GAS u32x4*)(grow + 8 * lane + 512 * j) = w;
        if (to_lds) *(LAS u32x4*)(xt_row + (8 * lane + 512 * j) * 2) = w; }
}
__device__ __forceinline__ void p0b_rows(Frame& F) {
    F.rethread();
    const float* x = F.inp(I_X); bf16* XB = (bf16*)(F.wsp() + WS_XB); float* GT = (float*)(F.wsp() + WS_GATES);
    LAS float* LOG = (LAS float*)(F.lds + RP_LOG);
    for (int it = blockIdx.x; it < T / 16; it += F.G) {
#pragma unroll 1
        for (int rr = 0; rr < 2; ++rr) { const int r = F.wave * 2 + rr, t = it * 16 + r; float v[32];
            load_lane_vec32(x + (size_t)t * D, F.lane, v);
            store_row_bf16(v, XB + (size_t)t * D, F.lds + r * XT_PITCH, true, F.lane); }
        __syncthreads();
        skinny16(F, (const bf16*)(F.wsp() + WS_WG_T), F.inp(I_MBG));
        { const int row = F.tid >> 5, e = F.tid & 31; GT[(size_t)(it * 16 + row) * 32 + e] = LOG[row * LOGP + e]; }
    }
    __syncthreads();
}
__device__ __forceinline__ void r1_phase(Frame& F, int layer) {
    F.rethread();
    const bf16* PRE = (const bf16*)(F.wsp() + WS_PRE); bf16* X1 = (bf16*)(F.wsp() + WS_X1);
    int* LIST = (int*)(F.wsp() + WS_LIST); int* EIDX = (int*)(F.wsp() + WS_TOK); int* POS = (int*)(F.wsp() + WS_TOK + 256 * 1024); float* GATE = (float*)(F.wsp() + WS_TOK + 512 * 1024);
    LAS unsigned char* XT = F.lds; LAS float* PART = (LAS float*)(F.lds + RP_PART); LAS float* LOGA = (LAS float*)(F.lds + RP_LOGA);
    gu32* gcnt = F.ctlp() + CW_CNT + layer * 32 * 64;
    const int r16 = F.lane & 15, q = F.lane >> 4;
    float g[32], b[32];
    load_lane_vec32(F.inp(I_LNG) + (size_t)(layer * 2 + 0) * D, F.lane, g); load_lane_vec32(F.inp(I_LNB) + (size_t)(layer * 2 + 0) * D, F.lane, b);
    bf16x8 bw0[8], bw1[8];
    { const bf16* WT = (const bf16*)(F.wsp() + WS_WR_T) + (size_t)layer * 32 * D;
#pragma unroll
      for (int ks = 0; ks < 8; ++ks) { const int k0 = F.wave * 256 + ks * 32 + 8 * q; bw0[ks] = *(const GAS bf16x8*)(WT + (size_t)r16 * D + k0); bw1[ks] = *(const GAS bf16x8*)(WT + (size_t)(16 + r16) * D + k0); } }
    const float* rbias = F.inp(I_RB) + layer * NE;
    if (F.tid < 32) F.X[XW_LCNT + F.tid] = 0u;
    int nit = 0;
    for (int it = blockIdx.x; it < T / 16; it += F.G, ++nit) {
#pragma unroll 1
        for (int rr = 0; rr < 2; ++rr) { const int r = F.wave * 2 + rr, t = it * 16 + r; float v[32];
            load_row_bf16(PRE + (size_t)t * D, F.lane, v);
            layer_norm32(v, g, b);
            store_row_bf16(v, X1 + (size_t)t * D, XT + r * XT_PITCH, true, F.lane);
            { unsigned char* x8 = (unsigned char*)(F.wsp() + WS_X1F8) + (size_t)t * D;
#pragma unroll
              for (int j = 0; j < 4; ++j) { int a_ = 0, b_ = 0; a_ = __builtin_amdgcn_cvt_pk_fp8_f32(v[8 * j], v[8 * j + 1], a_, false); a_ = __builtin_amdgcn_cvt_pk_fp8_f32(v[8 * j + 2], v[8 * j + 3], a_, true);
                  b_ = __builtin_amdgcn_cvt_pk_fp8_f32(v[8 * j + 4], v[8 * j + 5], b_, false); b_ = __builtin_amdgcn_cvt_pk_fp8_f32(v[8 * j + 6], v[8 * j + 7], b_, true);
                  *(GAS u32x2*)(x8 + 8 * F.lane + 512 * j) = (u32x2){(unsigned)a_, (unsigned)b_}; } } }
        __syncthreads();
        { float zf_ = 0.f; asm volatile("" : "+v"(zf_)); f32x4 acc0 = (f32x4){zf_, zf_, zf_, zf_}, acc1 = acc0;
#pragma unroll
          for (int ks = 0; ks < 8; ++ks) { const bf16x8 a = *(const LAS bf16x8*)(XT + r16 * XT_PITCH + (F.wave * 256 + ks * 32 + 8 * q) * 2);
              acc0 = __builtin_amdgcn_mfma_f32_16x16x32_bf16(a, bw0[ks], acc0, 0, 0, 0); acc1 = __builtin_amdgcn_mfma_f32_16x16x32_bf16(a, bw1[ks], acc1, 0, 0, 0); }
#pragma unroll
          for (int i = 0; i < 4; ++i) { PART[(F.wave * 16 + 4 * q + i) * 33 + r16] = acc0[i]; PART[(F.wave * 16 + 4 * q + i) * 33 + 16 + r16] = acc1[i]; } }
        __syncthreads();
        { const int row = F.tid >> 5, e = F.tid & 31; float s = rbias[e];
#pragma unroll
          for (int w = 0; w < 8; ++w) s += PART[(w * 16 + row) * 33 + e];
          LOGA[(nit * 16 + row) * LOGP + e] = s; }
    }
    __syncthreads();
    const int nrows = nit * 16; const int row = F.wave * 8 + (F.lane & 7); const bool act = (F.lane < 8) && (row < nrows);
    int e4[4] = {0, 0, 0, 0}; float v4[4] = {0.f, 0.f, 0.f, 0.f}; unsigned rk[4] = {0u, 0u, 0u, 0u};
    if (act) { unsigned mask = 0u; float lv[32];
#pragma unroll
        for (int e4i = 0; e4i < 8; ++e4i) { const f32x4 t = *(const LAS f32x4*)(LOGA + row * LOGP + 4 * e4i); lv[4 * e4i] = t.x; lv[4 * e4i + 1] = t.y; lv[4 * e4i + 2] = t.z; lv[4 * e4i + 3] = t.w; }
#pragma unroll
        for (int k = 0; k < 4; ++k) { float best = -__builtin_inff(); int bi = 0;
#pragma unroll
            for (int e = 0; e < 32; ++e) { const bool ok = (((mask >> e) & 1u) == 0u) && (lv[e] > best); best = ok ? lv[e] : best; bi = ok ? e : bi; }
            mask |= 1u << bi; e4[k] = bi; v4[k] = best; }
        const float e1 = __expf(v4[1] - v4[0]), e2 = __expf(v4[2] - v4[0]), e3 = __expf(v4[3] - v4[0]); const float inv = 1.f / (1.f + e1 + e2 + e3);
        v4[0] = inv; v4[1] = e1 * inv; v4[2] = e2 * inv; v4[3] = e3 * inv;
#pragma unroll
        for (int k = 0; k < 4; ++k) rk[k] = __hip_atomic_fetch_add((LAS unsigned*)(F.X + XW_LCNT + e4[k]), 1u, __ATOMIC_RELAXED, __HIP_MEMORY_SCOPE_WORKGROUP); }
    __syncthreads();
    if (F.tid < 32) { const unsigned c = F.X[XW_LCNT + F.tid]; unsigned base = 0u; if (c) base = __hip_atomic_fetch_add(gcnt + F.tid * 64, c, RLX_AGENT); F.X[XW_LBASE + F.tid] = base; }
    __syncthreads();
    if (act) { const int t = ((int)blockIdx.x + (row >> 4) * F.G) * 16 + (row & 15);
#pragma unroll
        for (int k = 0; k < 4; ++k) { const unsigned pos = F.X[XW_LBASE + e4[k]] + rk[k]; __hip_atomic_store((GAS int*)LIST + ((size_t)e4[k] * CAP + pos), t, RLX_AGENT); EIDX[t * 4 + k] = e4[k]; POS[t * 4 + k] = (int)pos; GATE[t * 4 + k] = v4[k]; } }
    __syncthreads();
}
__device__ __forceinline__ void moe_tables(Frame& F, int layer) {
    F.rethread();
    gu32* gcnt = F.ctlp() + CW_CNT + layer * 32 * 64;
    if (F.tid < 32) F.X[XW_CNT + F.tid] = __hip_atomic_load(gcnt + F.tid * 64, RLX_AGENT);
    __syncthreads();
    if (F.tid == 0) { unsigned run = 0u;
        for (int e = 0; e < 32; ++e) { const unsigned c = F.X[XW_CNT + e], n = (c + 255u) >> 8; F.X[XW_TPRE + e] = run; F.X[XW_PSTART + e] = run * 256u;
            for (unsigned i = 0; i < n; ++i) F.X[XW_TILE_E + run + i] = (unsigned)e; run += n; }
        F.X[XW_TPRE + 32] = run; F.X[XW_NTILES] = run; }
    __syncthreads();
}
__device__ __forceinline__ void r2_phase(Frame& F, int layer, bool last, int gates_j, int kmax) {
    F.rethread();
    const bf16* X1 = (const bf16*)(F.wsp() + WS_X1); const unsigned char* Y = (const unsigned char*)(F.wsp() + WS_Y); bf16* XB = (bf16*)(F.wsp() + WS_XB); float* GT = (float*)(F.wsp() + WS_GATES);
    const int* EIDX = (const int*)(F.wsp() + WS_TOK); const int* POS = (const int*)(F.wsp() + WS_TOK + 256 * 1024); const float* GATE = (const float*)(F.wsp() + WS_TOK + 512 * 1024);
    LAS float* LOG = (LAS float*)(F.lds + RP_LOG);
    LAS float* GL = (LAS float*)(F.lds + RP_GB); LAS float* BL = GL + D;
    { const float* gp = F.inp(I_LNG) + (size_t)(layer * 2 + 1) * D; const float* bp = F.inp(I_LNB) + (size_t)(layer * 2 + 1) * D;
      *(LAS f32x4*)(GL + 4 * F.tid) = *(const GAS f32x4*)(gp + 4 * F.tid); *(LAS f32x4*)(BL + 4 * F.tid) = *(const GAS f32x4*)(bp + 4 * F.tid); }
    __syncthreads();
    for (int it = blockIdx.x; it < T / 16; it += F.G) {
#pragma unroll
        for (int rr = 0; rr < 2; ++rr) { const int r = F.wave * 2 + rr, t = it * 16 + r; float v[32];
            load_row_bf16(X1 + (size_t)t * D, F.lane, v);
#pragma unroll
            for (int i = 0; i < 32; ++i) v[i] *= ALPHA;
#pragma unroll
            for (int k = 0; k < 4; ++k) if (k < kmax) { const int e = __builtin_amdgcn_readfirstlane(EIDX[t * 4 + k]), pos = __builtin_amdgcn_readfirstlane(POS[t * 4 + k]); const float gt = GATE[t * 4 + k];
                const unsigned slot = F.X[XW_PSTART + e] + (unsigned)pos; float yv[32];
                { const unsigned char* yr = Y + (size_t)slot * D;
#pragma unroll
                  for (int j = 0; j < 4; ++j) { const u32x2 w = *(const GAS u32x2*)(yr + 8 * F.lane + 512 * j);
                      yv[8 * j + 0] = __builtin_amdgcn_cvt_f32_fp8((int)w.x, 0); yv[8 * j + 1] = __builtin_amdgcn_cvt_f32_fp8((int)w.x, 1); yv[8 * j + 2] = __builtin_amdgcn_cvt_f32_fp8((int)w.x, 2); yv[8 * j + 3] = __builtin_amdgcn_cvt_f32_fp8((int)w.x, 3);
                      yv[8 * j + 4] = __builtin_amdgcn_cvt_f32_fp8((int)w.y, 0); yv[8 * j + 5] = __builtin_amdgcn_cvt_f32_fp8((int)w.y, 1); yv[8 * j + 6] = __builtin_amdgcn_cvt_f32_fp8((int)w.y, 2); yv[8 * j + 7] = __builtin_amdgcn_cvt_f32_fp8((int)w.y, 3); } }
                const float gts = gt * (1.0f / Y_SCALE);
#pragma unroll
                for (int i = 0; i < 32; ++i) v[i] += gts * yv[i]; }
            layer_norm32_lds(v, GL, BL, F.lane);
            if (last) { float* o = F.outp() + (size_t)t * D;
#pragma unroll
                for (int j = 0; j < 4; ++j) { *(GAS f32x4*)(o + 8 * F.lane + 512 * j) = (f32x4){v[8 * j], v[8 * j + 1], v[8 * j + 2], v[8 * j + 3]}; *(GAS f32x4*)(o + 8 * F.lane + 512 * j + 4) = (f32x4){v[8 * j + 4], v[8 * j + 5], v[8 * j + 6], v[8 * j + 7]}; } }
            else store_row_bf16(v, XB + (size_t)t * D, F.lds + r * XT_PITCH, gates_j >= 0, F.lane); }
        if (gates_j >= 0) {
            __syncthreads();
            skinny16(F, (const bf16*)(F.wsp() + WS_WG_T) + (size_t)gates_j * 32 * D, F.inp(I_MBG) + gates_j * 32);
            { const int row = F.tid >> 5, e = F.tid & 31; GT[(size_t)(it * 16 + row) * 32 + e] = LOG[row * LOGP + e]; }
        }
    }
    __syncthreads();
}
__device__ __forceinline__ void stub_mixer(Frame& F) {
    F.rethread();
    const bf16* XB = (const bf16*)(F.wsp() + WS_XB); bf16* PRE = (bf16*)(F.wsp() + WS_PRE);
    for (size_t i = (size_t)blockIdx.x * NTHREADS + F.tid; i < (size_t)T * D / 8; i += (size_t)F.G * NTHREADS) { const u32x4 w = ((const GAS u32x4*)XB)[i]; u32x4 o;
        o.x = cvt_pk_bf16(bf_lo(w.x) * ALPHA, bf_hi(w.x) * ALPHA); o.y = cvt_pk_bf16(bf_lo(w.y) * ALPHA, bf_hi(w.y) * ALPHA); o.z = cvt_pk_bf16(bf_lo(w.z) * ALPHA, bf_hi(w.z) * ALPHA); o.w = cvt_pk_bf16(bf_lo(w.w) * ALPHA, bf_hi(w.w) * ALPHA);
        ((GAS u32x4*)PRE)[i] = o; }
}


typedef float f32x2_t __attribute__((ext_vector_type(2)));
__device__ __forceinline__ f32x2_t gelu_pk(f32x2_t v) {
    const f32x2_t av = __builtin_elementwise_abs(v), d = av * 0.2316418882f + 1.0f;
    f32x2_t t; t.x = __builtin_amdgcn_rcpf(d.x); t.y = __builtin_amdgcn_rcpf(d.y);
    f32x2_t q = t * 0.5307027145f + (-0.7265760135f); q = q * t + 0.7107068705f; q = q * t + (-0.142248368f); q = q * t + 0.127414796f; q = q * t;
    const f32x2_t s = (v * v) * (-0.72134752044f);
    f32x2_t e; e.x = __builtin_amdgcn_exp2f(s.x); e.y = __builtin_amdgcn_exp2f(s.y);
    const f32x2_t m = v * (q * e), r = v - m;
    f32x2_t o; o.x = v.x < 0.f ? m.x : r.x; o.y = v.y < 0.f ? m.y : r.y; return o;
}
template <int KK, int NN> struct RectBase {
    static constexpr int K = KK; static constexpr bool PERM = true, FP8 = false; static constexpr int SCALE_B = 0x7f7f7f7f;
    const bf16* A; const bf16* Bt; int G, c;
    __device__ __forceinline__ bool next(int i, pg8::Unit& u) const {
        constexpr int nM = T / 256, nN = NN / 256, nwg = nM * nN; const long L = (long)i * G + c; if (L >= nwg) return false;
        const int wgid = pg8::xcd_remap((int)L, nwg); constexpr int nig = pg8::WGM * nN; const int gid = wgid / nig, fm = gid * pg8::WGM, gsz = (nM - fm) < pg8::WGM ? (nM - fm) : pg8::WGM;
        u.pm = fm + ((wgid % nig) % gsz); u.pn = (wgid % nig) / gsz; u.e = 0; u.x = 0; return true;
    }
    __device__ __forceinline__ void bases(const pg8::Unit& u, const char*& cA, const char*& cB) const { cA = (const char*)(A + (size_t)u.pm * 256 * KK); cB = (const char*)(Bt + (size_t)u.pn * 256 * KK); }
    __device__ __forceinline__ void avoff(const pg8::Unit&, int tid, unsigned (&v)[2][2]) const {
#pragma unroll
        for (int i = 0; i < 2; ++i) { int R, C; pg8::stage_rc(tid * 16 + i * 8192, R, C);
#pragma unroll
            for (int h = 0; h < 2; ++h) v[h][i] = (unsigned)((h * 128 + R) * KK + C) * 2u; }
    }
};
struct OutProjProb : RectBase<D / 2, D> {
    static constexpr bool FP8 = true; static constexpr int SCALE_B = 0x78787878;
    const bf16* XB; bf16* PRE;
    __device__ __forceinline__ void epi(const f32x4 (&acc)[2][2][4][2], const pg8::Unit& u, int wr, int wc, int fr, int fq) const {
        const int row0 = u.pm * 256 + wr * 64 + fr, c0 = u.pn * 256 + wc * 32 + 8 * fq;
#pragma unroll
        for (int ai = 0; ai < 2; ++ai)
#pragma unroll
            for (int m = 0; m < 4; ++m) { const size_t off = (size_t)(row0 + ai * 128 + m * 16) * D + c0;
#pragma unroll
                for (int bj = 0; bj < 2; ++bj) { const u32x4 xr = *(const GAS u32x4*)(XB + off + bj * 128); const f32x4 a0 = acc[ai][bj][m][0], a1 = acc[ai][bj][m][1]; u32x4 w;
                    w.x = cvt_pk_bf16(ALPHA * bf_lo(xr.x) + a0[0], ALPHA * bf_hi(xr.x) + a0[1]); w.y = cvt_pk_bf16(ALPHA * bf_lo(xr.y) + a0[2], ALPHA * bf_hi(xr.y) + a0[3]);
                    w.z = cvt_pk_bf16(ALPHA * bf_lo(xr.z) + a1[0], ALPHA * bf_hi(xr.z) + a1[1]); w.w = cvt_pk_bf16(ALPHA * bf_lo(xr.w) + a1[2], ALPHA * bf_hi(xr.w) + a1[3]);
                    *(GAS u32x4*)(PRE + off + bj * 128) = w; }
                asm volatile("" ::: "memory"); }
    }
};
struct GmlpInProb : RectBase<D, 4096> {
    const float* bias; bf16* U; bf16* V; float* VSTAT;
    __device__ __forceinline__ void epi(const f32x4 (&acc)[2][2][4][2], const pg8::Unit& u, int wr, int wc, int fr, int fq) const {
        const int row0 = u.pm * 256 + wr * 64 + fr, ct = u.pn * 256 + wc * 32 + 8 * fq; const bool isv = u.pn >= 8;
        bf16* O = isv ? V : U; const int c0 = isv ? ct - 2048 : ct;
#pragma unroll
        for (int ai = 0; ai < 2; ++ai)
#pragma unroll
            for (int m = 0; m < 4; ++m) { const int row = row0 + ai * 128 + m * 16; float s1 = 0.f, s2 = 0.f;
#pragma unroll
                for (int bj = 0; bj < 2; ++bj) { const f32x4 b0 = *(const GAS f32x4*)(bias + ct + bj * 128), b1 = *(const GAS f32x4*)(bias + ct + bj * 128 + 4);
                    const f32x4 v0 = acc[ai][bj][m][0] + b0, v1 = acc[ai][bj][m][1] + b1;
                    const f32x2_t g0 = gelu_pk((f32x2_t){v0[0], v0[1]}), g1 = gelu_pk((f32x2_t){v0[2], v0[3]}), g2 = gelu_pk((f32x2_t){v1[0], v1[1]}), g3 = gelu_pk((f32x2_t){v1[2], v1[3]});
                    u32x4 w; w.x = cvt_pk_bf16(g0.x, g0.y); w.y = cvt_pk_bf16(g1.x, g1.y); w.z = cvt_pk_bf16(g2.x, g2.y); w.w = cvt_pk_bf16(g3.x, g3.y);
                    *(GAS u32x4*)(O + (isv ? (size_t)((((unsigned)(row >> 7) * 8u + (unsigned)(u.pn - 8)) * 32u + (unsigned)(wc * 4 + fq + bj * 16)) * 128u + (unsigned)(row & 127)) * 8u : (size_t)row * D + c0 + bj * 128)) = w;
                    if (isv) { const float r0 = bf_lo(w.x), r1 = bf_hi(w.x), r2 = bf_lo(w.y), r3 = bf_hi(w.y), r4 = bf_lo(w.z), r5 = bf_hi(w.z), r6 = bf_lo(w.w), r7 = bf_hi(w.w);
                        s1 += ((r0 + r1) + (r2 + r3)) + ((r4 + r5) + (r6 + r7)); s2 += ((r0 * r0 + r1 * r1) + (r2 * r2 + r3 * r3)) + ((r4 * r4 + r5 * r5) + (r6 * r6 + r7 * r7)); } }
                if (isv) { s1 += __shfl_xor(s1, 16); s1 += __shfl_xor(s1, 32); s2 += __shfl_xor(s2, 16); s2 += __shfl_xor(s2, 32);
                    if (fq == 0) *(GAS f32x2_t*)(VSTAT + ((size_t)((u.pn - 8) * 4 + wc) * T + row) * 2) = (f32x2_t){s1, s2}; }
                asm volatile("" ::: "memory"); }
    }
};


constexpr int VT_PITCH = 272, G3_ST = 69632, G3_WS = 70656;
constexpr int G3_GB = 105472, G3_ST2 = 107520;
__device__ __forceinline__ void g3_stats(const float* VSTAT, int row0, int tid, LAS float* STb) {
    f32x2 p[32];
#pragma unroll
    for (int cg = 0; cg < 32; ++cg) p[cg] = *(const GAS f32x2*)(VSTAT + ((size_t)cg * T + row0 + tid) * 2);
    float s1 = 0.f, s2 = 0.f;
#pragma unroll
    for (int cg = 0; cg < 32; ++cg) { s1 += p[cg].x; s2 += p[cg].y; }
    const float mean = s1 * (1.f / D), var = s2 * (1.f / D) - mean * mean; STb[tid * 2] = mean; STb[tid * 2 + 1] = 1.f / sqrtf(var + LN_EPS);
}
__device__ __forceinline__ void g3_phase(Frame& F, int j) {
    F.rethread();
    LAS unsigned char* VT = F.lds; LAS float* GB = (LAS float*)(F.lds + G3_GB);
    const bf16* U = (const bf16*)(F.wsp() + WS_GU); const bf16* V = (const bf16*)(F.wsp() + WS_GV); bf16* YG = (bf16*)(F.wsp() + WS_GY); const float* VSTAT = (const float*)(F.wsp() + WS_VSTAT);
    const float* vg = F.inp(I_GVG) + (size_t)j * D; const float* vb = F.inp(I_GVB) + (size_t)j * D; const float* bs = F.inp(I_GBS) + (size_t)j * 8 * 128;
    const bf16* WS = (const bf16*)(F.wsp() + WS_WS) + (size_t)j * 8 * 128 * 128;
    const int r = F.lane & 15, q = F.lane >> 4;
    const unsigned psel = (F.lane & 1) ? 0x03020706u : 0x05040100u; const int podd = F.lane & 1;
    const int unit0 = blockIdx.x, g = unit0 & 7;
    if (unit0 < 1024) {
        if (F.tid < 128) { g3_stats(VSTAT, (unit0 >> 3) * 128, F.tid, (LAS float*)(F.lds + G3_ST));
            const float* gsrc = (F.tid < 64 ? vg : vb) + g * 256 + 4 * (F.tid & 63); *(LAS f32x4*)(GB + (F.tid < 64 ? 0 : 256) + 4 * (F.tid & 63)) = *(const GAS f32x4*)gsrc; }
        { const bf16* wsg0 = WS + (size_t)g * 128 * 128;
#pragma unroll
          for (int i = 0; i < 4; ++i) { const int p = F.tid + 512 * i; *(LAS u32x4*)(F.lds + G3_WS + (p >> 4) * VT_PITCH + (p & 15) * 16) = *(const GAS u32x4*)(wsg0 + (size_t)(p >> 4) * 128 + (p & 15) * 8); } }
    }
    u32x4 vreg[8];
    if (unit0 < 1024) {
#pragma unroll
        for (int i = 0; i < 8; ++i) { const int qq = F.tid + 512 * i, s = qq & 127, d8 = qq >> 7;
            vreg[i] = *(const GAS u32x4*)(V + (size_t)((((unsigned)(unit0 >> 3) * 8u + (unsigned)g) * 32u + (unsigned)d8) * 128u + (unsigned)s) * 8u); } }
    __syncthreads();
    int par = 0;
    for (int unit = unit0; unit < 1024; unit += F.G, par ^= 1) {
        const int row0 = (unit >> 3) * 128; const LAS float* ST = (const LAS float*)(F.lds + (par ? G3_ST2 : G3_ST));
        u32x2 ureg[8][2]; float bsv[8];
#pragma unroll
        for (int tt = 0; tt < 8; ++tt) { const int t = 16 * tt + r; const size_t off = (size_t)(row0 + t) * D + g * 256 + 32 * F.wave + 4 * q;
            ureg[tt][0] = *(const GAS u32x2*)(U + off); ureg[tt][1] = *(const GAS u32x2*)(U + off + 16); bsv[tt] = *(const GAS float*)(bs + g * 128 + t); }
#pragma unroll
        for (int i = 0; i < 8; ++i) { const int qq = F.tid + 512 * i, s = qq & 127, d0 = (qq >> 7) * 8;
            const u32x4 w = vreg[i]; const float mean = ST[s * 2], rstd = ST[s * 2 + 1];
            const f32x4 g0 = *(const LAS f32x4*)(GB + d0), g1 = *(const LAS f32x4*)(GB + d0 + 4), b0 = *(const LAS f32x4*)(GB + 256 + d0), b1 = *(const LAS f32x4*)(GB + 256 + d0 + 4);
            const float x[8] = {bf_lo(w.x), bf_hi(w.x), bf_lo(w.y), bf_hi(w.y), bf_lo(w.z), bf_hi(w.z), bf_lo(w.w), bf_hi(w.w)};
            const float gg[8] = {g0.x, g0.y, g0.z, g0.w, g1.x, g1.y, g1.z, g1.w}, bb[8] = {b0.x, b0.y, b0.z, b0.w, b1.x, b1.y, b1.z, b1.w};
            LAS unsigned char* vt = VT + (d0 + podd) * VT_PITCH + (s & ~1) * 2;
#pragma unroll
            for (int k = 0; k < 4; ++k) { const unsigned pk = cvt_pk_bf16_nop((x[2 * k] - mean) * rstd * gg[2 * k] + bb[2 * k], (x[2 * k + 1] - mean) * rstd * gg[2 * k + 1] + bb[2 * k + 1]);
                const unsigned y = (unsigned)__builtin_amdgcn_update_dpp(0, (int)pk, 0xB1, 0xf, 0xf, true); *(LAS unsigned*)(vt + (2 * k) * VT_PITCH) = __builtin_amdgcn_perm(y, pk, psel); } }
        __syncthreads();
        bf16x8 af[2][4];
#pragma unroll
        for (int dd = 0; dd < 2; ++dd)
#pragma unroll
            for (int ks = 0; ks < 4; ++ks) af[dd][ks] = *(const LAS bf16x8*)(VT + (16 * (2 * F.wave + dd) + r) * VT_PITCH + (32 * ks + 8 * q) * 2);
        if (unit + F.G < 1024) { const int un = unit + F.G;
#pragma unroll
            for (int i = 0; i < 8; ++i) { const int qq = F.tid + 512 * i, s = qq & 127, d8 = qq >> 7;
                vreg[i] = *(const GAS u32x4*)(V + (size_t)((((unsigned)(un >> 3) * 8u + (unsigned)g) * 32u + (unsigned)d8) * 128u + (unsigned)s) * 8u); }
            if (F.tid < 128) g3_stats(VSTAT, (un >> 3) * 128, F.tid, (LAS float*)(F.lds + (par ? G3_ST : G3_ST2))); }
#pragma unroll
        for (int tt = 0; tt < 8; ++tt) { bf16x8 bfr[4];
#pragma unroll
            for (int ks = 0; ks < 4; ++ks) bfr[ks] = *(const LAS bf16x8*)(F.lds + G3_WS + (16 * tt + r) * VT_PITCH + (32 * ks + 8 * q) * 2);
            f32x4 a0 = (f32x4){0.f, 0.f, 0.f, 0.f}, a1 = a0;
#pragma unroll
            for (int ks = 0; ks < 4; ++ks) { a0 = __builtin_amdgcn_mfma_f32_16x16x32_bf16(af[0][ks], bfr[ks], a0, 0, 0, 0); a1 = __builtin_amdgcn_mfma_f32_16x16x32_bf16(af[1][ks], bfr[ks], a1, 0, 0, 0); }
            const int t = 16 * tt + r; const float bias = bsv[tt]; const size_t off = (size_t)(row0 + t) * D + g * 256 + 32 * F.wave + 4 * q;
            { const u32x2 uu = ureg[tt][0]; int o_ = 0; o_ = __builtin_amdgcn_cvt_pk_fp8_f32(bf_lo(uu.x) * (a0[0] + bias), bf_hi(uu.x) * (a0[1] + bias), o_, false); o_ = __builtin_amdgcn_cvt_pk_fp8_f32(bf_lo(uu.y) * (a0[2] + bias), bf_hi(uu.y) * (a0[3] + bias), o_, true); *(GAS unsigned*)((unsigned char*)YG + off) = (unsigned)o_; }
            { const u32x2 uu = ureg[tt][1]; int o_ = 0; o_ = __builtin_amdgcn_cvt_pk_fp8_f32(bf_lo(uu.x) * (a1[0] + bias), bf_hi(uu.x) * (a1[1] + bias), o_, false); o_ = __builtin_amdgcn_cvt_pk_fp8_f32(bf_lo(uu.y) * (a1[2] + bias), bf_hi(uu.y) * (a1[3] + bias), o_, true); *(GAS unsigned*)((unsigned char*)YG + off + 16) = (unsigned)o_; }
            __builtin_amdgcn_sched_barrier(0); }
        __syncthreads();
    }
}


struct MlstmInProb : RectBase<D, MIN_MAIN> {
    bf16* Q; bf16* Kb; bf16* V; bf16* O;
    __device__ __forceinline__ void epi(const f32x4 (&acc)[2][2][4][2], const pg8::Unit& u, int wr, int wc, int fr, int fq) const {
        bf16* base; float sc = 1.f; unsigned off0, SA, SM, SB;
        const unsigned row0 = (unsigned)(u.pm * 256 + wr * 64 + fr), bb = row0 >> 12, chunk0 = (row0 >> 7) & 31u, s0 = row0 & 127u;
        if (u.pn < 4) { base = Q; sc = 0.08838834764831845f; off0 = row0 * QKW + u.pn * 256 + wc * 32 + 8 * fq; SA = 128u * QKW; SM = 16u * QKW; SB = 128u; }
        else if (u.pn < 8) { base = Kb; const unsigned hb = (unsigned)(u.pn - 4) * 2u, seg = (unsigned)(wc * 4 + fq);
            off0 = ((((bb * 8u + hb) * 32u + chunk0) * 16u + seg) * 128u + s0) * 8u; SA = 16384u; SM = 128u; SB = 524288u; }
        else if (u.pn < 16) { base = V; const unsigned h = (unsigned)(u.pn - 8), v8 = (unsigned)((wc & 1) * 4 + fq);
            off0 = (((((bb * 8u + h) * 4u + (unsigned)(wc >> 1)) * 32u + chunk0) * 8u + v8) * 128u + s0) * 8u; SA = 8192u; SM = 128u; SB = 524288u; }
        else { base = O; off0 = row0 * VW + (u.pn - 16) * 256 + wc * 32 + 8 * fq; SA = 128u * VW; SM = 16u * VW; SB = 128u; }
#pragma unroll
        for (int ai = 0; ai < 2; ++ai)
#pragma unroll
            for (int m = 0; m < 4; ++m) { bf16* rowp = base + (size_t)(off0 + ai * SA + m * SM);
#pragma unroll
                for (int bj = 0; bj < 2; ++bj) { const f32x4 v0 = acc[ai][bj][m][0] * sc, v1 = acc[ai][bj][m][1] * sc;
                    u32x4 w; w.x = cvt_pk_bf16(v0[0], v0[1]); w.y = cvt_pk_bf16(v0[2], v0[3]); w.z = cvt_pk_bf16(v1[0], v1[1]); w.w = cvt_pk_bf16(v1[2], v1[3]);
                    *(GAS u32x4*)(rowp + (size_t)(bj * SB)) = w; } }
    }
};
template <class Fn, int... I> __device__ __forceinline__ void sfor_impl(Fn&& f, std::integer_sequence<int, I...>) { (f(std::integral_constant<int, I>{}), ...); }
template <int N, class Fn> __device__ __forceinline__ void sfor(Fn&& f) { sfor_impl(static_cast<Fn&&>(f), std::make_integer_sequence<int, N>{}); }
template <int OFF> __device__ __forceinline__ bf16x8 lds_ld128(const LAS unsigned char* a) { return *(const LAS bf16x8*)(a + OFF); }
template <int OFF> __device__ __forceinline__ u32x2 lds_ld64(const LAS unsigned char* a) { return *(const LAS u32x2*)(a + OFF); }
#define LDS_LANDED10(a, b) __builtin_amdgcn_sched_barrier(0)
#define MFMA_DRAIN(vec) do { __builtin_amdgcn_sched_barrier(0); const int d_ = __builtin_amdgcn_readfirstlane(__builtin_bit_cast(int, (vec)[0])); asm volatile("" :: "s"(d_)); __builtin_amdgcn_sched_barrier(0); } while (0)
#define SFOR(n, var) sfor<n>([&](auto var##_) __attribute__((always_inline)) { constexpr int var = decltype(var##_)::value;
#define SFOR_END });
constexpr int SP = 272;
constexpr int SC_KI = 0, SC_KT = 34816, SC_VT = 69632, SC_VW = 91392, SC_CT = 113152, SC_TB = 134912, SC_TBF = 672;
__device__ __forceinline__ size_t ktile(int b, int h, int dir, int c, int j, int g) { const int cc = dir ? 31 - c : c, s = dir ? 127 - j : j; return ((size_t)((((b * 8 + h) * 32 + cc) * 16 + g) * 128 + s)) * 8; }
__device__ __forceinline__ size_t vtile(int b, int h, int dvs, int dir, int c, int j, int g) { const int cc = dir ? 31 - c : c, s = dir ? 127 - j : j; return ((size_t)(((((b * 8 + h) * 4 + dvs) * 32 + cc) * 8 + g) * 128 + s)) * 8; }
__device__ __forceinline__ int scan_row(int b, int dir, int c, int j) { return b * SEQ + (dir ? (31 - c) * 128 + (127 - j) : c * 128 + j); }
__device__ __forceinline__ float log_sigmoid(float x) {
    const float e = __expf(-fabsf(x)), u = 1.f + e;
    const float l = (u == 1.f) ? e : __logf(u) * (e * __builtin_amdgcn_rcpf(u - 1.f));
    return fminf(x, 0.f) - l;
}
template <int CTRL, int ROWM> __device__ __forceinline__ float dpp_take(float ident, float v) {
    return __builtin_bit_cast(float, __builtin_amdgcn_update_dpp(__builtin_bit_cast(int, ident), __builtin_bit_cast(int, v), CTRL, ROWM, 0xf, false)); }
__device__ __forceinline__ float wave_scan_add(float x) {
    x += dpp_take<0x111, 0xf>(0.f, x); x += dpp_take<0x112, 0xf>(0.f, x); x += dpp_take<0x114, 0xf>(0.f, x); x += dpp_take<0x118, 0xf>(0.f, x);
    x += dpp_take<0x142, 0xa>(0.f, x); x += dpp_take<0x143, 0xc>(0.f, x); return x; }
__device__ __forceinline__ float wave_scan_max(float x) {
    const float ni = -__builtin_inff();
    x = fmaxf(x, dpp_take<0x111, 0xf>(ni, x)); x = fmaxf(x, dpp_take<0x112, 0xf>(ni, x)); x = fmaxf(x, dpp_take<0x114, 0xf>(ni, x)); x = fmaxf(x, dpp_take<0x118, 0xf>(ni, x));
    x = fmaxf(x, dpp_take<0x142, 0xa>(ni, x)); x = fmaxf(x, dpp_take<0x143, 0xc>(ni, x)); return x; }
__device__ __forceinline__ void scan_gate_load(const float* GT, int b, int dir, int c, int gi, int lane, float (&gv)[4]) {
    const int t0 = scan_row(b, dir, c, 2 * lane), t1 = scan_row(b, dir, c, 2 * lane + 1);
    const GAS float* G = (const GAS float*)GT; gv[0] = G[(size_t)t0 * 32 + gi]; gv[1] = G[(size_t)t1 * 32 + gi]; gv[2] = G[(size_t)t0 * 32 + gi + 8]; gv[3] = G[(size_t)t1 * 32 + gi + 8];
}
__device__ __forceinline__ void scan_tables(LAS float* TB, const float (&gv)[4], int lane, float& m) {
    const float i0 = gv[0], i1 = gv[1], f0 = log_sigmoid(gv[2]), f1 = log_sigmoid(gv[3]);
    const float x = wave_scan_add(f0 + f1);
    const float b1 = x, b0 = x - f1, u0 = i0 - b0, u1 = i1 - b1;
    const float z = wave_scan_max(fmaxf(u0, u1));
    float ex = __shfl_up(z, 1); if (lane == 0) ex = -__builtin_inff();
    const float M0 = fmaxf(m, fmaxf(ex, u0)), M1 = fmaxf(m, z);
    const float Ml = __builtin_bit_cast(float, __builtin_amdgcn_readlane(__builtin_bit_cast(int, M1), 63)), bl = __builtin_bit_cast(float, __builtin_amdgcn_readlane(__builtin_bit_cast(int, b1), 63));
    TB[2 * lane] = u0; TB[2 * lane + 1] = u1; TB[128 + 2 * lane] = M0; TB[128 + 2 * lane + 1] = M1;
    TB[256 + 2 * lane] = __expf(-(b0 + M0)); TB[256 + 2 * lane + 1] = __expf(-(b1 + M1));
    TB[384 + 2 * lane] = __expf(u0 - Ml); TB[384 + 2 * lane + 1] = __expf(u1 - Ml);
    TB[512 + 2 * lane] = __expf(m - M0); TB[512 + 2 * lane + 1] = __expf(m - M1);
    if (lane == 0) TB[640] = __expf(m - Ml);
    m = bl + Ml;
}
__device__ __forceinline__ void m2_scan(Frame& F) {
    F.rethread();
    LAS unsigned char* L = F.lds;
    const bf16* Qg = (const bf16*)(F.wsp() + WS_MQ); const bf16* Kg = (const bf16*)(F.wsp() + WS_MK); const bf16* Vg = (const bf16*)(F.wsp() + WS_MV); const float* GT = (const float*)(F.wsp() + WS_GATES);
    const int w = F.wave, lane = F.lane, c16 = lane & 15, q = lane >> 4, tid = F.tid;
    for (int cblk = blockIdx.x; cblk < 256; cblk += F.G) {
        const int chain = (cblk & 7) * 32 + (cblk >> 3);
        const int dvs = chain & 3, dir = (chain >> 2) & 1, h = (chain >> 3) & 7, b = chain >> 6;
        bf16* Hout = (bf16*)(F.wsp() + (dir ? WS_HB : WS_HF));
        const int qcol0 = h * 128, vcol0 = h * 256 + dvs * 64, gi = 2 * dir * 8 + h;
        const LAS unsigned char* lbase = L + c16 * SP;
        const LAS unsigned char* bKI = lbase + SC_KI + 16 * q; const LAS unsigned char* bCT = lbase + SC_CT + 16 * q; const LAS unsigned char* bVT = lbase + SC_VT + 8 * q;
        const LAS unsigned char* bVW = lbase + SC_VW + 16 * q; const LAS unsigned char* bKT = lbase + SC_KT + 16 * w * SP + 16 * q;
        for (int i = tid; i < 80 * SP / 4; i += NTHREADS) ((LAS unsigned*)(L + SC_CT))[i] = 0u;
        for (int i = tid; i < 16 * SP / 4; i += NTHREADS) { ((LAS unsigned*)(L + SC_VT + 64 * SP))[i] = (i < SP / 4) ? 0x3F803F80u : 0u; ((LAS unsigned*)(L + SC_VW + 64 * SP))[i] = 0u; }
        f32x4 cacc[5];
#pragma unroll
        for (int vt = 0; vt < 5; ++vt) cacc[vt] = (f32x4){0.f, 0.f, 0.f, 0.f};
        const int nK = w < 4 ? 6 : (w < 6 ? 4 : 0), nV = nK >> 1, kbase = w < 4 ? 6 * w : (w == 4 ? 24 : 28), vbase = w < 4 ? 3 * w : (w == 4 ? 12 : 14);
        u32x4 kn[6], vn[3]; bf16x8 qn[4];
#pragma unroll
        for (int i = 0; i < 6; ++i) { kn[i] = (u32x4){0u, 0u, 0u, 0u}; if (i < nK) kn[i] = *(const GAS u32x4*)(Kg + ktile(b, h, dir, 0, 64 * (i & 1) + lane, (kbase + i) >> 1)); }
#pragma unroll
        for (int i = 0; i < 3; ++i) { vn[i] = (u32x4){0u, 0u, 0u, 0u}; if (i < nV) vn[i] = *(const GAS u32x4*)(Vg + vtile(b, h, dvs, dir, 0, 64 * ((vbase + i) & 1) + lane, (vbase + i) >> 1)); }
#pragma unroll
        for (int ks = 0; ks < 4; ++ks) qn[ks] = *(const GAS bf16x8*)(Qg + (size_t)scan_row(b, dir, 0, 16 * w + c16) * QKW + qcol0 + 32 * ks + 8 * q);
        float m_run = 0.f;
        float gv[4] = {0.f, 0.f, 0.f, 0.f};
        if (w == 0) { scan_gate_load(GT, b, dir, 0, gi, lane, gv); scan_tables((LAS float*)(L + SC_TB), gv, lane, m_run); scan_gate_load(GT, b, dir, 1, gi, lane, gv); }
        __syncthreads();
#pragma unroll 1
        for (int c = 0; c < 32; ++c) {
            const LAS float* TB = (const LAS float*)(L + SC_TB) + (c & 1) * SC_TBF;
            bf16x8 qf[4];
#pragma unroll
            for (int ks = 0; ks < 4; ++ks) qf[ks] = qn[ks];
            const unsigned psel = (lane & 1) ? 0x03020706u : 0x05040100u; const int podd = lane & 1;
#pragma unroll
            for (int i = 0; i < 6; ++i) if (i < nK) { const int s = 64 * (i & 1) + lane, d8 = (kbase + i) >> 1; *(LAS u32x4*)(L + SC_KI + s * SP + d8 * 16) = kn[i]; }
#pragma unroll
            for (int i = 0; i < 3; ++i) if (i < nV) { const int s = 64 * ((vbase + i) & 1) + lane, v8 = (vbase + i) >> 1; const u32x4 vv = vn[i];
                LAS unsigned char* vt = L + SC_VT + (8 * v8 + podd) * SP + (s & ~1) * 2; const unsigned ww[4] = {vv.x, vv.y, vv.z, vv.w};
#pragma unroll
                for (int e = 0; e < 4; ++e) { const unsigned y = (unsigned)__builtin_amdgcn_update_dpp(0, (int)ww[e], 0xB1, 0xf, 0xf, true); *(LAS unsigned*)(vt + (2 * e) * SP) = __builtin_amdgcn_perm(y, ww[e], psel); } }
            __syncthreads();
#pragma unroll
            for (int i = 0; i < 6; ++i) if (i < nK) { const int s = 64 * (i & 1) + lane, d8 = (kbase + i) >> 1; const u32x4 kv = kn[i];
                LAS unsigned char* kt = L + SC_KT + (8 * d8 + podd) * SP + (s & ~1) * 2; const unsigned kw[4] = {kv.x, kv.y, kv.z, kv.w};
#pragma unroll
                for (int e = 0; e < 4; ++e) { const unsigned y = (unsigned)__builtin_amdgcn_update_dpp(0, (int)kw[e], 0xB1, 0xf, 0xf, true); *(LAS unsigned*)(kt + (2 * e) * SP) = __builtin_amdgcn_perm(y, kw[e], psel); } }
#pragma unroll
            for (int i = 0; i < 3; ++i) if (i < nV) { const int s = 64 * ((vbase + i) & 1) + lane, v8 = (vbase + i) >> 1; const u32x4 vv = vn[i]; const float wk = TB[384 + s];
                LAS unsigned char* vw = L + SC_VW + (8 * v8 + podd) * SP + (s & ~1) * 2; const unsigned ww[4] = {vv.x, vv.y, vv.z, vv.w};
#pragma unroll
                for (int e = 0; e < 4; ++e) { const unsigned sc = cvt_pk_bf16_nop(bf_lo(ww[e]) * wk, bf_hi(ww[e]) * wk); const unsigned ys = (unsigned)__builtin_amdgcn_update_dpp(0, (int)sc, 0xB1, 0xf, 0xf, true);
                    *(LAS unsigned*)(vw + (2 * e) * SP) = __builtin_amdgcn_perm(ys, sc, psel); } }
            if (tid < 128) *(LAS unsigned short*)(L + SC_VW + 64 * SP + tid * 2) = (unsigned short)f2bf(TB[384 + tid]);
            if (c + 1 < 32) {
                const int cc1 = dir ? 30 - c : c + 1;
                const char* KB = (const char*)Kg + (size_t)(((b * 8 + h) * 32 + cc1)) * 32768;
                const char* VB = (const char*)Vg + (size_t)((((b * 8 + h) * 4 + dvs) * 32 + cc1)) * 16384;
                const char* QB = (const char*)Qg + ((size_t)(b * SEQ + cc1 * 128) * QKW + qcol0) * 2;
                const unsigned lp = 16u * (unsigned)(dir ? 63 - lane : lane);
#pragma unroll
                for (int i = 0; i < 6; ++i) if (i < nK) { const int n = kbase + i, hf = n & 1; kn[i] = *(const GAS u32x4*)(KB + ((unsigned)((n >> 1) * 2048 + (dir ? 1 - hf : hf) * 1024) + lp)); }
#pragma unroll
                for (int i = 0; i < 3; ++i) if (i < nV) { const int n = vbase + i, hf = n & 1; vn[i] = *(const GAS u32x4*)(VB + ((unsigned)((n >> 1) * 2048 + (dir ? 1 - hf : hf) * 1024) + lp)); }
                const unsigned qo = (unsigned)((dir ? 127 - (16 * w + c16) : 16 * w + c16) * (QKW * 2) + 16 * q);
#pragma unroll
                for (int ks = 0; ks < 4; ++ks) qn[ks] = *(const GAS bf16x8*)(QB + (qo + 64u * ks));
            }
            if (w == 0 && c + 1 < 32) { scan_tables((LAS float*)(L + SC_TB) + ((c + 1) & 1) * SC_TBF, gv, lane, m_run); if (c + 2 < 32) scan_gate_load(GT, b, dir, c + 2, gi, lane, gv); }
            const float Mj = TB[128 + 16 * w + c16], iscj = TB[512 + 16 * w + c16], emtj = TB[256 + 16 * w + c16];
            const LAS unsigned char* bTB = (const LAS unsigned char*)TB + 16 * q;
            f32x4 ad[5], ac[5];
#pragma unroll
            for (int vt = 0; vt < 5; ++vt) { ad[vt] = (f32x4){0.f, 0.f, 0.f, 0.f}; ac[vt] = ad[vt]; }
            SFOR(2, kh) bf16x8 r0[5], r1[5];
                SFOR(5, vt) r0[vt] = lds_ld128<16 * vt * SP + 128 * kh>(bCT); r1[vt] = lds_ld128<16 * vt * SP + 128 * kh + 64>(bCT); SFOR_END
                LDS_LANDED10(r0, r1);
#pragma unroll
                for (int vt = 0; vt < 5; ++vt) ad[vt] = __builtin_amdgcn_mfma_f32_16x16x32_bf16(r0[vt], qf[2 * kh], ad[vt], 0, 0, 0);
#pragma unroll
                for (int vt = 0; vt < 5; ++vt) ad[vt] = __builtin_amdgcn_mfma_f32_16x16x32_bf16(r1[vt], qf[2 * kh + 1], ad[vt], 0, 0, 0);
                MFMA_DRAIN(ad[4]);
            SFOR_END
            bf16x8 pf[4];
            SFOR(4, kp) u32x4 t4 = (u32x4){0u, 0u, 0u, 0u};
                if (2 * kp <= w) {
                    bf16x8 a0[5], a1[5];
                    SFOR(4, ks) a0[ks] = lds_ld128<32 * kp * SP + 64 * ks>(bKI); a1[ks] = lds_ld128<(32 * kp + 16) * SP + 64 * ks>(bKI); SFOR_END
                    a0[4] = lds_ld128<32 * kp * 4>(bTB); a1[4] = lds_ld128<(32 * kp + 16) * 4>(bTB);
                    LDS_LANDED10(a0, a1);
                    const f32x4 ua = __builtin_bit_cast(f32x4, a0[4]), ub = __builtin_bit_cast(f32x4, a1[4]);
                    f32x4 s0 = (f32x4){0.f, 0.f, 0.f, 0.f}, s1 = s0;
#pragma unroll
                    for (int ks = 0; ks < 4; ++ks) { s0 = __builtin_amdgcn_mfma_f32_16x16x32_bf16(a0[ks], qf[ks], s0, 0, 0, 0); s1 = __builtin_amdgcn_mfma_f32_16x16x32_bf16(a1[ks], qf[ks], s1, 0, 0, 0); }
                    float p0[4], p1[4]; const int j = 16 * w + c16;
#pragma unroll
                    for (int i = 0; i < 4; ++i) { const int s = 32 * kp + 4 * q + i; p0[i] = (s <= j) ? s0[i] * __expf(ua[i] - Mj) : 0.f; p1[i] = (s + 16 <= j) ? s1[i] * __expf(ub[i] - Mj) : 0.f; }
                    t4.x = cvt_pk_bf16(p0[0], p0[1]); t4.y = cvt_pk_bf16(p0[2], p0[3]); t4.z = cvt_pk_bf16(p1[0], p1[1]); t4.w = cvt_pk_bf16(p1[2], p1[3]); }
                pf[kp] = __builtin_bit_cast(bf16x8, t4);
            SFOR_END
            SFOR(4, kp) if (2 * kp <= w) {
                u32x2 lo[5], hi[5];
                SFOR(5, vt) lo[vt] = lds_ld64<16 * vt * SP + 64 * kp>(bVT); hi[vt] = lds_ld64<16 * vt * SP + 64 * kp + 32>(bVT); SFOR_END
                LDS_LANDED10(lo, hi);
#pragma unroll
                for (int vt = 0; vt < 5; ++vt) { u32x4 t4; t4.x = lo[vt].x; t4.y = lo[vt].y; t4.z = hi[vt].x; t4.w = hi[vt].y; ac[vt] = __builtin_amdgcn_mfma_f32_16x16x32_bf16(__builtin_bit_cast(bf16x8, t4), pf[kp], ac[vt], 0, 0, 0); }
                MFMA_DRAIN(ac[4]); }
            SFOR_END
            f32x4 num[5];
#pragma unroll
            for (int vt = 0; vt < 5; ++vt) num[vt] = ac[vt] + ad[vt] * iscj;
            { const float den = __shfl(num[4][0], c16); const float inv = 1.f / fmaxf(fabsf(den), emtj);
              bf16* hrow = Hout + (size_t)scan_row(b, dir, c, 16 * w + c16) * VW + vcol0 + 4 * q;
#pragma unroll
              for (int vt = 0; vt < 4; ++vt) { u32x2 o; o.x = cvt_pk_bf16(num[vt][0] * inv, num[vt][1] * inv); o.y = cvt_pk_bf16(num[vt][2] * inv, num[vt][3] * inv); *(GAS u32x2*)(hrow + 16 * vt) = o; } }
            __syncthreads();
            { const float decay = TB[640];
#pragma unroll
              for (int vt = 0; vt < 5; ++vt) cacc[vt] = cacc[vt] * decay;
              SFOR(2, kh) bf16x8 b0[5], b1[5], ka0, ka1;
                  ka0 = lds_ld128<128 * kh>(bKT); ka1 = lds_ld128<128 * kh + 64>(bKT);
                  SFOR(5, vt) b0[vt] = lds_ld128<16 * vt * SP + 128 * kh>(bVW); b1[vt] = lds_ld128<16 * vt * SP + 128 * kh + 64>(bVW); SFOR_END
                  LDS_LANDED10(b0, b1);
#pragma unroll
                  for (int vt = 0; vt < 5; ++vt) cacc[vt] = __builtin_amdgcn_mfma_f32_16x16x32_bf16(ka0, b0[vt], cacc[vt], 0, 0, 0);
#pragma unroll
                  for (int vt = 0; vt < 5; ++vt) cacc[vt] = __builtin_amdgcn_mfma_f32_16x16x32_bf16(ka1, b1[vt], cacc[vt], 0, 0, 0);
                  MFMA_DRAIN(cacc[4]);
              SFOR_END
#pragma unroll
              for (int vt = 0; vt < 5; ++vt) { u32x2 o; o.x = cvt_pk_bf16(cacc[vt][0], cacc[vt][1]); o.y = cvt_pk_bf16(cacc[vt][2], cacc[vt][3]); *(LAS u32x2*)(L + SC_CT + (16 * vt + c16) * SP + (16 * w + 4 * q) * 2) = o; } }
            __syncthreads();
        }
    }
}
__device__ __forceinline__ float half_wave_sum(float x) {
    x += __builtin_bit_cast(float, __builtin_amdgcn_update_dpp(0, __builtin_bit_cast(int, x), 0xB1, 0xf, 0xf, true));
    x += __builtin_bit_cast(float, __builtin_amdgcn_update_dpp(0, __builtin_bit_cast(int, x), 0x4E, 0xf, 0xf, true));
    x += __builtin_bit_cast(float, __builtin_amdgcn_update_dpp(0, __builtin_bit_cast(int, x), 0x141, 0xf, 0xf, true));
    x += __builtin_bit_cast(float, __builtin_amdgcn_update_dpp(0, __builtin_bit_cast(int, x), 0x140, 0xf, 0xf, true));
    return x + __shfl_xor(x, 16);
}
__device__ __forceinline__ void m3_combine(Frame& F, int j) {
    F.rethread();
    const bf16* HF = (const bf16*)(F.wsp() + WS_HF); const bf16* HB = (const bf16*)(F.wsp() + WS_HB); const bf16* O = (const bf16*)(F.wsp() + WS_MO); bf16* HG = (bf16*)(F.wsp() + WS_HG);
    float g[32]; load_lane_vec32(F.inp(I_MNG) + (size_t)j * VW, F.lane, g);
    const int t0 = blockIdx.x * NWAVES + F.wave, tstep = F.G * NWAVES;
    u32x4 ra[4], rb[4], ro[4];
#pragma unroll
    for (int jj = 0; jj < 4; ++jj) { ra[jj] = *(const GAS u32x4*)(HF + (size_t)t0 * VW + 8 * F.lane + 512 * jj); rb[jj] = *(const GAS u32x4*)(HB + (size_t)t0 * VW + 8 * F.lane + 512 * jj); ro[jj] = *(const GAS u32x4*)(O + (size_t)t0 * VW + 8 * F.lane + 512 * jj); }
    for (int t = t0; t < T; t += tstep) {
        float a[32], o[32];
#pragma unroll
        for (int jj = 0; jj < 4; ++jj) { const unsigned wa[4] = {ra[jj].x, ra[jj].y, ra[jj].z, ra[jj].w}, wb[4] = {rb[jj].x, rb[jj].y, rb[jj].z, rb[jj].w}, wo[4] = {ro[jj].x, ro[jj].y, ro[jj].z, ro[jj].w};
#pragma unroll
            for (int e = 0; e < 4; ++e) { a[8 * jj + 2 * e] = bf_lo(wa[e]) + bf_lo(wb[e]); a[8 * jj + 2 * e + 1] = bf_hi(wa[e]) + bf_hi(wb[e]); o[8 * jj + 2 * e] = bf_lo(wo[e]); o[8 * jj + 2 * e + 1] = bf_hi(wo[e]); } }
        if (t + tstep < T) { const size_t rn = (size_t)(t + tstep) * VW + 8 * F.lane;
#pragma unroll
            for (int jj = 0; jj < 4; ++jj) { ra[jj] = *(const GAS u32x4*)(HF + rn + 512 * jj); rb[jj] = *(const GAS u32x4*)(HB + rn + 512 * jj); ro[jj] = *(const GAS u32x4*)(O + rn + 512 * jj); } }
#pragma unroll
        for (int jj = 0; jj < 4; ++jj) { float s = 0.f;
#pragma unroll
            for (int e = 0; e < 8; ++e) s += a[8 * jj + e];
            const float mean = half_wave_sum(s) * (1.f / 256.f); float s2 = 0.f;
#pragma unroll
            for (int e = 0; e < 8; ++e) { a[8 * jj + e] -= mean; s2 += a[8 * jj + e] * a[8 * jj + e]; }
            const float rstd = 1.f / sqrtf(half_wave_sum(s2) * (1.f / 256.f) + LN_EPS);
#pragma unroll
            for (int e = 0; e < 8; ++e) a[8 * jj + e] = a[8 * jj + e] * rstd * g[8 * jj + e] * __builtin_amdgcn_rcpf(1.f + __expf(-o[8 * jj + e])); }
        { unsigned char* h8 = (unsigned char*)HG + (size_t)t * VW;
#pragma unroll
          for (int jj = 0; jj < 4; ++jj) { int a_ = 0, b_ = 0; a_ = __builtin_amdgcn_cvt_pk_fp8_f32(a[8 * jj], a[8 * jj + 1], a_, false); a_ = __builtin_amdgcn_cvt_pk_fp8_f32(a[8 * jj + 2], a[8 * jj + 3], a_, true);
              b_ = __builtin_amdgcn_cvt_pk_fp8_f32(a[8 * jj + 4], a[8 * jj + 5], b_, false); b_ = __builtin_amdgcn_cvt_pk_fp8_f32(a[8 * jj + 6], a[8 * jj + 7], b_, true);
              *(GAS u32x2*)(h8 + 8 * F.lane + 512 * jj) = (u32x2){(unsigned)a_, (unsigned)b_}; } }
    }
}

struct MoeOrderBase {
    LAS unsigned* X; int G, c, NT;
    __device__ __forceinline__ bool next_(int i, pg8::Unit& u) const {
        const int ntiles = (int)X[XW_NTILES], nwg = ntiles * NT; const long L = (long)i * G + c; if (L >= nwg) return false;
        const int wgid = pg8::xcd_remap((int)L, nwg); const int ti = wgid / NT; u.pn = wgid % NT;
        u.e = __builtin_amdgcn_readfirstlane((int)X[XW_TILE_E + ti]); u.pm = ti - __builtin_amdgcn_readfirstlane((int)X[XW_TPRE + u.e]); u.x = 0; return true;
    }
};
struct E1Prob : MoeOrderBase {
    static constexpr int K = D / 2; static constexpr bool PERM = true, FP8 = true; static constexpr int SCALE_B = 0x79797979;
    const unsigned char* X1; const unsigned char* Wt; const float* bgu; unsigned char* hact; const int* list;
    __device__ __forceinline__ bool next(int i, pg8::Unit& u) const { return next_(i, u); }
    __device__ __forceinline__ void bases(const pg8::Unit& u, const char*& cA, const char*& cB) const { cA = (const char*)X1; cB = (const char*)(Wt + ((size_t)u.e * 1024 + (size_t)u.pn * 256) * D); }
    __device__ __forceinline__ void avoff(const pg8::Unit& u, int tid, unsigned (&v)[2][2]) const {
        const int cnt = (int)X[XW_CNT + u.e];
#pragma unroll
        for (int i = 0; i < 2; ++i) { int R, C; pg8::stage_rc(tid * 16 + i * 8192, R, C);
#pragma unroll
            for (int h = 0; h < 2; ++h) { int idx = u.pm * 256 + h * 128 + R; idx = idx < cnt ? idx : cnt - 1;
                const int tok = __hip_atomic_load((const GAS int*)list + ((size_t)u.e * CAP + idx), RLX_AGENT); v[h][i] = (unsigned)tok * (unsigned)D + (unsigned)C * 2u; } }
    }
    __device__ __forceinline__ void epi(const f32x4 (&acc)[2][2][4][2], const pg8::Unit& u, int wr, int wc, int fr, int fq) const {
        const unsigned slot0 = X[XW_PSTART + u.e] + (unsigned)u.pm * 256u + (unsigned)(wr * 64 + fr);
        const int hc = u.pn * 128 + wc * 32 + 8 * fq;
        const float* bg = bgu + (size_t)u.e * 1024 + hc;
#pragma unroll
        for (int ai = 0; ai < 2; ++ai)
#pragma unroll
            for (int m = 0; m < 4; ++m) { unsigned char* rowp = hact + (size_t)(slot0 + ai * 128 + m * 16) * FF + hc; float o[8];
#pragma unroll
                for (int n = 0; n < 2; ++n) { const f32x4 bgv = *(const GAS f32x4*)(bg + 4 * n), buv = *(const GAS f32x4*)(bg + 512 + 4 * n);
#pragma unroll
                    for (int j = 0; j < 4; ++j) { float gv = acc[ai][0][m][n][j] + bgv[j], uv = acc[ai][1][m][n][j] + buv[j];
                        gv = fminf(gv, 7.0f); uv = fminf(fmaxf(uv, -7.0f), 7.0f);
                        o[4 * n + j] = (uv + 1.0f) * gv * __builtin_amdgcn_rcpf(1.0f + __expf(-1.702f * gv)); } }
                asm volatile("" ::: "memory");
                u32x2 w; { int a_ = 0, b_ = 0; a_ = __builtin_amdgcn_cvt_pk_fp8_f32(o[0], o[1], a_, false); a_ = __builtin_amdgcn_cvt_pk_fp8_f32(o[2], o[3], a_, true);
                    b_ = __builtin_amdgcn_cvt_pk_fp8_f32(o[4], o[5], b_, false); b_ = __builtin_amdgcn_cvt_pk_fp8_f32(o[6], o[7], b_, true); w.x = (unsigned)a_; w.y = (unsigned)b_; }
                *(GAS u32x2*)rowp = w; }
    }
};
struct E2Prob : MoeOrderBase {
    static constexpr int K = FF / 2; static constexpr bool PERM = true, FP8 = true; static constexpr int SCALE_B = 0x79797979;
    const unsigned char* hact; const unsigned char* Wt; const float* bdn; unsigned char* Y;
    __device__ __forceinline__ bool next(int i, pg8::Unit& u) const { return next_(i, u); }
    __device__ __forceinline__ void bases(const pg8::Unit& u, const char*& cA, const char*& cB) const {
        cA = (const char*)(hact + (size_t)(X[XW_PSTART + u.e] + (unsigned)u.pm * 256u) * FF); cB = (const char*)(Wt + ((size_t)u.e * D + (size_t)u.pn * 256) * FF); }
    __device__ __forceinline__ void avoff(const pg8::Unit&, int tid, unsigned (&v)[2][2]) const {
#pragma unroll
        for (int i = 0; i < 2; ++i) { int R, C; pg8::stage_rc(tid * 16 + i * 8192, R, C);
#pragma unroll
            for (int h = 0; h < 2; ++h) v[h][i] = (unsigned)((h * 128 + R) * (FF / 2) + C) * 2u; }
    }
    __device__ __forceinline__ void epi(const f32x4 (&acc)[2][2][4][2], const pg8::Unit& u, int wr, int wc, int fr, int fq) const {
        const unsigned slot0 = X[XW_PSTART + u.e] + (unsigned)u.pm * 256u + (unsigned)(wr * 64 + fr);
        const int c0 = u.pn * 256 + wc * 32 + 8 * fq;
        const float* bp = bdn + (size_t)u.e * D + c0;
        f32x4 bv[2][2];
#pragma unroll
        for (int bj = 0; bj < 2; ++bj)
#pragma unroll
            for (int n = 0; n < 2; ++n) bv[bj][n] = *(const GAS f32x4*)(bp + bj * 128 + 4 * n);
#pragma unroll
        for (int ai = 0; ai < 2; ++ai)
#pragma unroll
            for (int m = 0; m < 4; ++m) { unsigned char* rowp = Y + (size_t)(slot0 + ai * 128 + m * 16) * D + c0;
#pragma unroll
                for (int bj = 0; bj < 2; ++bj) { const f32x4 v0 = (acc[ai][bj][m][0] + bv[bj][0]) * Y_SCALE, v1 = (acc[ai][bj][m][1] + bv[bj][1]) * Y_SCALE;
                    int a_ = 0, b_ = 0; a_ = __builtin_amdgcn_cvt_pk_fp8_f32(v0[0], v0[1], a_, false); a_ = __builtin_amdgcn_cvt_pk_fp8_f32(v0[2], v0[3], a_, true);
                    b_ = __builtin_amdgcn_cvt_pk_fp8_f32(v1[0], v1[1], b_, false); b_ = __builtin_amdgcn_cvt_pk_fp8_f32(v1[2], v1[3], b_, true);
                    *(GAS u32x2*)(rowp + bj * 128) = (u32x2){(unsigned)a_, (unsigned)b_}; } }
    }
};


#define GRID_BAR() do { XcdBarrier bar_; bar_.bar = (unsigned*)(F.ctlp() + CW_BAR); bar_.x = xb_xcc_id(); bar_.st = (volatile LAS unsigned*)(F.X + XW_BAR); F.rethread(); xcd_barrier(bar_, F.tid == 0); } while (0)
#ifndef REP_M1
#define REP_M1 1
#endif
#ifndef REP_OUT
#define REP_OUT 1
#endif
#ifndef REP_G1
#define REP_G1 1
#endif
#ifndef REP_M3
#define REP_M3 1
#endif
#ifndef REP_P0A
#define REP_P0A 1
#endif
#ifndef REP_SCAN
#define REP_SCAN 1
#endif
#ifndef REP_E1
#define REP_E1 1
#endif
#ifndef REP_E2
#define REP_E2 1
#endif
#ifndef REP_G3
#define REP_G3 1
#endif
#ifndef REP_R2
#define REP_R2 1
#endif
#ifndef FILL_E1
#define FILL_E1 20
#endif
#ifndef FILL_E2
#define FILL_E2 3
#endif
#ifndef MOE_LAYER_MASK
#define MOE_LAYER_MASK 15
#endif
template <int layer> __device__ __forceinline__ void moe_layer(Frame& F) {
    if constexpr ((layer & 1) == 1) {
        constexpr int j = layer / 2;
        for (int rep_ = 0; rep_ < REP_G1; ++rep_) {
        { GmlpInProb P; P.A = (const bf16*)(F.wsp() + WS_XB); P.Bt = (const bf16*)(F.wsp() + WS_WGI) + (size_t)j * 4096 * D; P.G = F.G; P.c = (int)blockIdx.x;
          P.bias = F.inp(I_GBIN) + (size_t)j * 4096; P.U = (bf16*)(F.wsp() + WS_GU); P.V = (bf16*)(F.wsp() + WS_GV); P.VSTAT = (float*)(F.wsp() + WS_VSTAT);
          pg8::gemm_phase<GmlpInProb, true>(F.lds, P, F.wave0); }
        GRID_BAR(); }
        for (int rep = 0; rep < REP_G3; ++rep) { g3_phase(F, j); GRID_BAR(); }
        for (int rep_ = 0; rep_ < REP_OUT; ++rep_) {
        { OutProjProb P; P.A = (const bf16*)(F.wsp() + WS_GY); P.Bt = (const bf16*)(F.wsp() + WS_WGO + (size_t)j * D * D); P.G = F.G; P.c = (int)blockIdx.x;
          P.XB = (const bf16*)(F.wsp() + WS_XB); P.PRE = (bf16*)(F.wsp() + WS_PRE);
          pg8::gemm_phase<OutProjProb, true>(F.lds, P, F.wave0); }
        GRID_BAR(); }
    } else {
        constexpr int j = layer / 2;
        for (int rep_ = 0; rep_ < REP_M1; ++rep_) {
        { MlstmInProb P; P.A = (const bf16*)(F.wsp() + WS_XB); P.Bt = (const bf16*)(F.wsp() + WS_WMI) + (size_t)j * MIN_MAIN * D; P.G = F.G; P.c = (int)blockIdx.x;
          P.Q = (bf16*)(F.wsp() + WS_MQ); P.Kb = (bf16*)(F.wsp() + WS_MK); P.V = (bf16*)(F.wsp() + WS_MV); P.O = (bf16*)(F.wsp() + WS_MO);
          pg8::gemm_phase<MlstmInProb, true>(F.lds, P, F.wave0); }
        GRID_BAR(); }
        for (int rep = 0; rep < REP_SCAN; ++rep) { m2_scan(F); GRID_BAR(); }
        for (int rep_ = 0; rep_ < REP_M3; ++rep_) { m3_combine(F, j); GRID_BAR(); }
        for (int rep_ = 0; rep_ < REP_OUT; ++rep_) {
        { OutProjProb P; P.A = (const bf16*)(F.wsp() + WS_HG); P.Bt = (const bf16*)(F.wsp() + WS_WMO + (size_t)j * D * D); P.G = F.G; P.c = (int)blockIdx.x;
          P.XB = (const bf16*)(F.wsp() + WS_XB); P.PRE = (bf16*)(F.wsp() + WS_PRE);
          pg8::gemm_phase<OutProjProb, true>(F.lds, P, F.wave0); }
        GRID_BAR(); }
    }
    r1_phase(F, layer); GRID_BAR();
    moe_tables(F, layer);
    if constexpr ((MOE_LAYER_MASK >> layer) & 1) {
    for (int rep = 0; rep < REP_E1; ++rep) {
    { E1Prob P; P.X = F.X; P.G = F.G; P.c = (int)blockIdx.x; P.NT = 4; P.X1 = (const unsigned char*)(F.wsp() + WS_X1F8); P.Wt = (const unsigned char*)(F.wsp() + WS_WGU) + (size_t)layer * 32 * 1024 * D;
      P.bgu = F.inp(I_EBGU) + (size_t)layer * 32 * 1024; P.hact = (unsigned char*)(F.wsp() + WS_HACT); P.list = (const int*)(F.wsp() + WS_LIST);
      pg8::gemm_phase<E1Prob, true>(F.lds, P, F.wave0); }
    if constexpr (layer + 1 < DEPTH) { const int nwg = (int)F.X[XW_NTILES] * 4, c = (int)blockIdx.x; const int mine = nwg > c ? (nwg - c + F.G - 1) / F.G : 0, most = (nwg + F.G - 1) / F.G;
        if (mine < most) cvt_fill(F, layer + 1, FILL_E1); }
    GRID_BAR(); }
    for (int rep = 0; rep < REP_E2; ++rep) {
    { E2Prob P; P.X = F.X; P.G = F.G; P.c = (int)blockIdx.x; P.NT = 8; P.hact = (const unsigned char*)(F.wsp() + WS_HACT); P.Wt = (const unsigned char*)(F.wsp() + WS_WDN) + (size_t)layer * 32 * D * FF;
      P.bdn = F.inp(I_EBDN) + (size_t)layer * 32 * D; P.Y = (unsigned char*)(F.wsp() + WS_Y);
      pg8::gemm_phase<E2Prob, true>(F.lds, P, F.wave0); }
    if constexpr (layer + 1 < DEPTH) { const int nwg = (int)F.X[XW_NTILES] * 8, c = (int)blockIdx.x; const int mine = nwg > c ? (nwg - c + F.G - 1) / F.G : 0, most = (nwg + F.G - 1) / F.G;
        if (mine < most) cvt_fill(F, layer + 1, FILL_E2); }
    GRID_BAR(); }
    }
    if constexpr (layer + 1 < DEPTH) cvt_fill(F, layer + 1, -1);
    for (int rep_ = 0; rep_ < REP_R2; ++rep_) {     r2_phase(F, layer, layer == DEPTH - 1, (layer + 1 < DEPTH && ((layer + 1) & 1) == 0) ? (layer + 1) / 2 : -1, ((MOE_LAYER_MASK >> layer) & 1) ? 4 : 0); GRID_BAR(); }
}

struct Args { const float* in[20]; float* out; unsigned char* ws; };
__global__ void __launch_bounds__(NTHREADS, 2) fwd(Args args) {
    extern __shared__ __attribute__((aligned(16))) unsigned char lds_raw[];
    Frame F;
    F.lds = (LAS unsigned char*)lds_raw; F.X = (LAS unsigned*)(F.lds + LDSX_OFF);
    F.tid = threadIdx.x; F.lane = F.tid & 63; F.wave = __builtin_amdgcn_readfirstlane(F.tid >> 6); F.wave0 = F.wave; F.G = gridDim.x;
    F.ws_ = args.ws;
    for (int u = F.tid; u < XW_WORDS; u += NTHREADS) F.X[u] = 0u;
    __syncthreads();
    if (F.tid == 0) {
#pragma unroll
        for (int i = 0; i < 20; ++i) { const unsigned long long p = (unsigned long long)args.in[i]; F.X[XW_INP + 2 * i] = (unsigned)p; F.X[XW_INP + 2 * i + 1] = (unsigned)(p >> 32); }
        { const unsigned long long p = (unsigned long long)args.out; F.X[XW_INP + 40] = (unsigned)p; F.X[XW_INP + 41] = (unsigned)(p >> 32); } }
    __syncthreads();
    (void)xcd_barrier_post((unsigned*)(F.ctlp() + CW_BAR), (volatile LAS unsigned*)(F.X + XW_BAR));

    for (int rep = 0; rep < REP_P0A; ++rep) { p0a_weights(F); GRID_BAR(); }
    p0b_rows(F); GRID_BAR();
#define GRID_BAR_() GRID_BAR()
    moe_layer<0>(F); moe_layer<1>(F); moe_layer<2>(F); moe_layer<3>(F);
}

extern "C" void kernel_launch(void* const* d_in, const int* in_sizes, int n_in, void* d_out, int out_size, void* d_ws, size_t ws_size, hipStream_t stream) {
    static int grid = 0;
    if (grid == 0) {
        if (n_in != 20 || out_size != T * D || ws_size < WS_END) { fprintf(stderr, "kernel_launch: unexpected shapes (n_in %d out %d ws %zu need %zu)\n", n_in, out_size, ws_size, (size_t)WS_END); grid = -1; return; }
        int dev = 0, cus = 0, per_cu = 0;
        if (hipGetDevice(&dev) != hipSuccess || hipDeviceGetAttribute(&cus, hipDeviceAttributeMultiprocessorCount, dev) != hipSuccess) { grid = -1; return; }
        if (hipFuncSetAttribute((const void*)fwd, hipFuncAttributeMaxDynamicSharedMemorySize, LDS_BYTES) != hipSuccess) { fprintf(stderr, "kernel_launch: hipFuncSetAttribute failed\n"); grid = -1; return; }
        if (hipOccupancyMaxActiveBlocksPerMultiprocessor(&per_cu, (const void*)fwd, NTHREADS, LDS_BYTES) != hipSuccess || per_cu < 1) { fprintf(stderr, "kernel_launch: occupancy query says %d\n", per_cu); }
        (void)hipGetLastError();
        grid = cus;
    }
    if (grid < 0) return;
    if (hipMemsetAsync((char*)d_ws + WS_CTL, 0, CTL_ZERO_BYTES, stream) != hipSuccess) return;
    Args a{};
    for (int i = 0; i < 20; ++i) a.in[i] = (const float*)d_in[i];
    a.out = (float*)d_out; a.ws = (unsigned char*)d_ws;
    hipLaunchKernelGGL(fwd, dim3(grid), dim3(NTHREADS), LDS_BYTES, stream, a);
    const hipError_t le = hipPeekAtLastError();
    if (le != hipSuccess) fprintf(stderr, "kernel_launch: launch failed: %s\n", hipGetErrorName(le));
}
```

```cpp
#include <utility>
#include <type_traits>
#include <hip/hip_runtime.h>
#include <cstdio>
#include <cstdint>

#define LAS __attribute__((address_space(3)))
#define GAS __attribute__((address_space(1)))
typedef unsigned short bf16;
typedef short bf16x8 __attribute__((ext_vector_type(8)));
typedef short s16x4 __attribute__((ext_vector_type(4)));
typedef float f32x4 __attribute__((ext_vector_type(4)));
typedef float f32x2 __attribute__((ext_vector_type(2)));
typedef unsigned u32x4 __attribute__((ext_vector_type(4)));
typedef unsigned u32x2 __attribute__((ext_vector_type(2)));
typedef GAS unsigned gu32;
#define RLX_AGENT __ATOMIC_RELAXED, __HIP_MEMORY_SCOPE_AGENT

constexpr int T = 16384, D = 2048, DEPTH = 4, SEQ = 4096, NBATCH = 4;
constexpr int NE = 32, TOPK = 4, FF = 512;
constexpr int HEADS = 8, DV = 256, DK = 128, QKW = 1024, VW = 2048, MIN_COLS = 6176, MIN_MAIN = 6144;
constexpr int CAP = T;
constexpr int MAXSLOT = T * TOPK + NE * 256;
constexpr float ALPHA = 1.6817928305074290f;
constexpr float LN_EPS = 1e-5f;
constexpr float Y_SCALE = 16.0f;
constexpr int NWAVES = 8, NTHREADS = 512;
#ifndef EXP_NO_MOE
#define EXP_NO_MOE 0
#endif

constexpr size_t MiB = 1u << 20;
constexpr size_t WS_CTL = 0, CTL_ZERO_BYTES = 1 * MiB;
constexpr size_t WS_WGU = 1 * MiB;
constexpr size_t WS_WDN = WS_WGU + 512 * MiB;
constexpr size_t WS_WMI = WS_WDN + 256 * MiB;
constexpr size_t WS_WMO = WS_WMI + 48 * MiB;
constexpr size_t WS_WGI = WS_WMO + 16 * MiB;
constexpr size_t WS_WGO = WS_WGI + 32 * MiB;
constexpr size_t WS_WSM = WS_WGO + 16 * MiB;
constexpr size_t WS_WG_T = WS_WSM, WS_WR_T = WS_WSM + 256 * 1024, WS_WS = WS_WSM + 768 * 1024;
constexpr size_t WS_XB = WS_WSM + 2 * MiB;
constexpr size_t WS_X1 = WS_XB + 64 * MiB;
constexpr size_t WS_PRE = WS_X1 + 64 * MiB;
constexpr size_t WS_MIX = WS_PRE + 64 * MiB;
constexpr size_t WS_HACT = WS_MIX + 384 * MiB;
constexpr size_t WS_Y = WS_HACT + 72 * MiB;
constexpr size_t WS_LIST = WS_Y + 288 * MiB;
constexpr size_t WS_TOK = WS_LIST + 2 * MiB;
constexpr size_t WS_GATES = WS_TOK + 1 * MiB;
constexpr size_t WS_X1F8 = WS_GATES + 2 * MiB;
constexpr size_t WS_END = WS_X1F8 + 32 * MiB;

constexpr size_t WS_GU = WS_MIX, WS_GV = WS_MIX + 64 * MiB, WS_GY = WS_MIX + 128 * MiB, WS_VSTAT = WS_MIX + 192 * MiB;
constexpr size_t WS_MQ = WS_MIX, WS_MK = WS_MIX + 32 * MiB, WS_MV = WS_MIX + 64 * MiB, WS_MO = WS_MIX + 128 * MiB, WS_HF = WS_MIX + 192 * MiB, WS_HB = WS_MIX + 256 * MiB, WS_HG = WS_MIX + 320 * MiB;
constexpr int CW_TMO = 0, CW_CODE = 1, CW_BAR = 4096, CW_CNT = 8192;

constexpr int RING_BYTES = 131072;
constexpr int LDS_BYTES = 163840;
constexpr int LDSX_OFF = LDS_BYTES - 4096;
constexpr int XW_BAR = 8, XW_LCNT = 64, XW_LBASE = 96, XW_CNT = 128, XW_TPRE = 160, XW_PSTART = 200, XW_NTILES = 232, XW_TILE_E = 256, XW_INP = 600, XW_WORDS = 1024;
constexpr int XT_PITCH = 4112;
constexpr int RP_PART = 66048, RP_LOG = 82944, LOGP = 36, RP_GB = 90112, RP_LOGA = 106496;

__device__ __forceinline__ unsigned f2bf(float f) { unsigned u = __builtin_bit_cast(unsigned, f); return (u + 0x7fffu + ((u >> 16) & 1u)) >> 16; }
__device__ __forceinline__ unsigned cvt_pk_bf16_nop(float lo, float hi) { unsigned r; asm volatile("v_cvt_pk_bf16_f32 %0, %1, %2\n\ts_nop 1" : "=v"(r) : "v"(lo), "v"(hi)); return r; }
__device__ __forceinline__ unsigned cvt_pk_bf16(float lo, float hi) { unsigned r; asm volatile("v_cvt_pk_bf16_f32 %0, %1, %2" : "=v"(r) : "v"(lo), "v"(hi)); return r; }
__device__ __forceinline__ float bf_lo(unsigned w) { return __builtin_bit_cast(float, w << 16); }
__device__ __forceinline__ float bf_hi(unsigned w) { return __builtin_bit_cast(float, w & 0xffff0000u); }
__device__ __forceinline__ float wave_sum(float v) {
#pragma unroll
    for (int o = 1; o < 64; o <<= 1) v += __shfl_xor(v, o);
    return v;
}
#define LDS_WAIT() asm volatile("s_waitcnt lgkmcnt(0)" ::: "memory")
#define VM_WAIT() asm volatile("s_waitcnt vmcnt(0)" ::: "memory")

namespace pg8 {
constexpr int BM = 256, BK = 64, HALF = 128, HTB = HALF * BK * 2, STAGE_BYTES = 8 * HTB, NXCD = 8, WGM = 8;
__host__ __device__ __forceinline__ int lds_byte(int r, int c) { const int st = (r >> 4) * 2 + (c >> 5), rr = r & 15, cc = c & 31, ob = rr * 64 + cc * 2; return st * 1024 + (ob ^ (((ob >> 9) & 1) << 5)); }
__host__ __device__ __forceinline__ void stage_rc(int b, int& R, int& C) { const int st = b / 1024, sb = b % 1024, swz = sb ^ (((sb >> 9) & 1) << 5); R = (st >> 1) * 16 + swz / 64; C = (st & 1) * 32 + (swz % 64) / 2; }
__host__ __device__ __forceinline__ int perm32(int rho) { const int n = rho >> 4, i = rho & 15; return 8 * (i >> 2) + 4 * n + (i & 3); }

struct Unit { int pm, pn, e, x; };
typedef int v8i_t __attribute__((ext_vector_type(8)));
typedef int v4i_t __attribute__((ext_vector_type(4)));
__device__ __forceinline__ v8i_t cat_v8(bf16x8 lo, bf16x8 hi) { return __builtin_shufflevector(__builtin_bit_cast(v4i_t, lo), __builtin_bit_cast(v4i_t, hi), 0, 1, 2, 3, 4, 5, 6, 7); }

__device__ __forceinline__ void mfma_f8_tied(f32x4& acc, v8i_t a, v8i_t b, int sa, int sb) {
    asm volatile("v_mfma_scale_f32_16x16x128_f8f6f4 %0, %1, %2, %0, %3, %4 op_sel_hi:[0,0,0]" : "+v"(acc) : "v"(a), "v"(b), "v"(sa), "v"(sb));
}
__device__ __forceinline__ int xcd_remap(int wgid, int nwg) { const int q = nwg / NXCD, r = nwg % NXCD, xcd = wgid % NXCD, off = wgid / NXCD; return (xcd < r ? xcd * (q + 1) : r * (q + 1) + (xcd - r) * q) + off; }

template <class Prob, bool ALIGN_EPI = true>
__device__ __forceinline__ void gemm_phase(LAS unsigned char* lds, const Prob& P, int wave_id) {
    int wid = wave_id; asm volatile("" : "+s"(wid)); unsigned z_ = 0u; asm volatile("" : "+v"(z_)); const int lane = (int)__builtin_amdgcn_mbcnt_hi(~0u, __builtin_amdgcn_mbcnt_lo(~0u, z_));
    const int tid = wid * 64 + lane, wr = wid >> 2, wc = wid & 3, fr = lane & 15, fq = lane >> 4;
    constexpr int K = Prob::K, nt = K / BK;
    unsigned voffB[2];
#pragma unroll
    for (int i = 0; i < 2; ++i) { int R, C; stage_rc(tid * 16 + i * 8192, R, C); const int Rb = Prob::PERM ? ((R & ~31) + perm32(R & 31)) : R;
        voffB[i] = (unsigned)(Rb * K + C) * 2u; }
    const size_t kstep = (size_t)(BK * 2);
    const size_t hstep = (size_t)HALF * K * 2;
    const unsigned ldsw = (unsigned)wid * 1024u;
    const int aoff = lds_byte(wr * 64 + fr, fq * 8), boff = lds_byte(wc * 32 + fr, fq * 8);
#define PG8_SA(b, h) (((b) * 2 + (h)) * HTB)
#define PG8_SB(b, h) ((4 + (b) * 2 + (h)) * HTB)
#define PG8_STAGE(bufoff, gbase, v0, v1) do { \
        __builtin_amdgcn_global_load_lds((const unsigned*)((const char*)(gbase) + (v0)), (LAS unsigned*)(lds + (bufoff) + ldsw), 16, 0, 0); \
        __builtin_amdgcn_global_load_lds((const unsigned*)((const char*)(gbase) + (v1)), (LAS unsigned*)(lds + (bufoff) + ldsw + 8192), 16, 0, 0); } while (0)
#define PG8_STB(bufoff, gbase) PG8_STAGE(bufoff, gbase, voffB[0], voffB[1])
#define PG8_LDA(dst, b, h) do { _Pragma("unroll") for (int m = 0; m < 4; ++m) _Pragma("unroll") for (int k = 0; k < 2; ++k) dst[m][k] = *(const LAS bf16x8*)(lds + PG8_SA(b, h) + aoff + m * 2048 + k * 1024); } while (0)
#define PG8_LDB(dst, b, h) do { _Pragma("unroll") for (int n = 0; n < 2; ++n) _Pragma("unroll") for (int k = 0; k < 2; ++k) dst[n][k] = *(const LAS bf16x8*)(lds + PG8_SB(b, h) + boff + n * 2048 + k * 1024); } while (0)
#define PG8_MMA(ai, bj, At, Bt) do { __builtin_amdgcn_s_setprio(1); \
        if constexpr (Prob::FP8) { asm volatile("s_nop 1" ::: "memory"); _Pragma("unroll") for (int m = 0; m < 4; ++m) _Pragma("unroll") for (int n = 0; n < 2; ++n) \
            mfma_f8_tied(acc[ai][bj][m][n], cat_v8(Bt[n][0], Bt[n][1]), cat_v8(At[m][0], At[m][1]), sc_w, sc_x); } \
        else { _Pragma("unroll") for (int m = 0; m < 4; ++m) _Pragma("unroll") for (int n = 0; n < 2; ++n) _Pragma("unroll") for (int k = 0; k < 2; ++k) \
            acc[ai][bj][m][n] = __builtin_amdgcn_mfma_f32_16x16x32_bf16(Bt[n][k], At[m][k], acc[ai][bj][m][n], 0, 0, 0); } \
        __builtin_amdgcn_s_setprio(0); } while (0)
#define PG8_WAIT_V(n) asm volatile("s_waitcnt vmcnt(" #n ")" ::: "memory")
#define PG8_WAIT_L(n) asm volatile("s_waitcnt lgkmcnt(" #n ")" ::: "memory")
#define PG8_BAR __builtin_amdgcn_s_barrier()
#define PG8_SCHED __builtin_amdgcn_sched_barrier(0)
    Unit cur, nxt; int ui = 0;
    if (!P.next(0, cur)) return;
    int sc_w = Prob::SCALE_B, sc_x = 0x7f7f7f7f; if constexpr (Prob::FP8) { asm volatile("" : "+v"(sc_w), "+v"(sc_x)); }
    float zf_ = 0.f; asm volatile("" : "+v"(zf_)); const f32x4 zero4 = (f32x4){zf_, zf_, zf_, zf_};
    f32x4 acc[2][2][4][2];
#pragma unroll
    for (int a = 0; a < 2; ++a)
#pragma unroll
        for (int b = 0; b < 2; ++b)
#pragma unroll
            for (int m = 0; m < 4; ++m)
#pragma unroll
                for (int n = 0; n < 2; ++n) acc[a][b][m][n] = zero4;
    bf16x8 At[4][2], B0[2][2], B1[2][2];
    const char* cA; const char* cB; unsigned va[2][2], vn[2][2];
    P.bases(cur, cA, cB); P.avoff(cur, tid, va);
    PG8_STB(PG8_SB(0, 0), cB); PG8_STB(PG8_SB(0, 1), cB + hstep); PG8_STAGE(PG8_SA(0, 0), cA, va[0][0], va[0][1]); PG8_STAGE(PG8_SA(0, 1), cA, va[1][0], va[1][1]);
    if (wr == 1) PG8_BAR;
    PG8_WAIT_V(2); PG8_BAR;
    PG8_STB(PG8_SB(1, 0), cB + kstep); PG8_STAGE(PG8_SA(1, 0), cA + kstep, va[0][0], va[0][1]); PG8_STB(PG8_SB(1, 1), cB + hstep + kstep);
    PG8_WAIT_V(6); PG8_BAR;
    for (;;) {
        const bool has_next = P.next(ui + 1, nxt);
        const char* nA = cA; const char* nB = cB;
#pragma unroll
        for (int h = 0; h < 2; ++h)
#pragma unroll
            for (int i = 0; i < 2; ++i) vn[h][i] = va[h][i];
        if (has_next) { P.bases(nxt, nA, nB); P.avoff(nxt, tid, vn); }
        for (int t = 0; t < nt; t += 2) {
            const bool last = (t == nt - 2);
            const char* a1 = cA + (size_t)(t + 1) * kstep;
            const char* a2 = last ? nA : cA + (size_t)(t + 2) * kstep; const char* b2 = last ? nB : cB + (size_t)(t + 2) * kstep;
            const char* a3 = a2 + kstep; const char* b3 = b2 + kstep;
            const unsigned s00 = last ? vn[0][0] : va[0][0], s01 = last ? vn[0][1] : va[0][1], s10 = last ? vn[1][0] : va[1][0], s11 = last ? vn[1][1] : va[1][1];
            PG8_LDB(B0, 0, 0); PG8_LDB(B1, 0, 1); PG8_SCHED; PG8_LDA(At, 0, 0); PG8_STAGE(PG8_SA(1, 1), a1, va[1][0], va[1][1]);
            PG8_WAIT_V(8); PG8_WAIT_L(0); PG8_BAR; PG8_MMA(0, 0, At, B0); PG8_MMA(0, 1, At, B1); PG8_BAR; PG8_SCHED;
            PG8_LDA(At, 0, 1); PG8_STB(PG8_SB(0, 0), b2); PG8_STB(PG8_SB(0, 1), b2 + hstep); PG8_STAGE(PG8_SA(0, 0), a2, s00, s01);
            PG8_WAIT_V(8); PG8_WAIT_L(0); PG8_BAR; PG8_MMA(1, 0, At, B0); PG8_MMA(1, 1, At, B1); PG8_BAR; PG8_SCHED;
            PG8_LDB(B0, 1, 0); PG8_LDB(B1, 1, 1); PG8_SCHED; PG8_LDA(At, 1, 0); PG8_STAGE(PG8_SA(0, 1), a2, s10, s11);
            PG8_WAIT_V(8); PG8_WAIT_L(0); PG8_BAR; PG8_MMA(0, 0, At, B0); PG8_MMA(0, 1, At, B1); PG8_BAR; PG8_SCHED;
            PG8_LDA(At, 1, 1); PG8_STB(PG8_SB(1, 0), b3); PG8_STB(PG8_SB(1, 1), b3 + hstep); PG8_STAGE(PG8_SA(1, 0), a3, s00, s01);
            PG8_WAIT_V(8); PG8_WAIT_L(0); PG8_BAR; PG8_MMA(1, 0, At, B0); PG8_MMA(1, 1, At, B1); PG8_BAR; PG8_SCHED;
        }
        if constexpr (ALIGN_EPI) { if (wr == 0) PG8_BAR; }
        if constexpr (Prob::FP8) asm volatile("s_nop 15\n\ts_nop 15" ::: "memory");
        P.epi(acc, cur, wr, wc, fr, fq);
        if (!has_next) break;
#pragma unroll
        for (int a = 0; a < 2; ++a)
#pragma unroll
            for (int b = 0; b < 2; ++b)
#pragma unroll
                for (int m = 0; m < 4; ++m)
#pragma unroll
                    for (int n = 0; n < 2; ++n) acc[a][b][m][n] = zero4;
        cur = nxt; cA = nA; cB = nB; ++ui;
#pragma unroll
        for (int h = 0; h < 2; ++h)
#pragma unroll
            for (int i = 0; i < 2; ++i) va[h][i] = vn[h][i];
        if constexpr (ALIGN_EPI) { if (wr == 1) PG8_BAR; }
    }
    PG8_WAIT_V(0);
    if constexpr (!ALIGN_EPI) { if (wr == 0) PG8_BAR; }
    PG8_BAR;
#undef PG8_SA
#undef PG8_SB
#undef PG8_STAGE
#undef PG8_STB
#undef PG8_LDA
#undef PG8_LDB
#undef PG8_MMA
#undef PG8_WAIT_V
#undef PG8_WAIT_L
#undef PG8_BAR
#undef PG8_SCHED
}
}

#define XB_TMO      128
#define XB_XCNT(j)  (256  + 64 * (j))
#define XB_XSUB(j)  (1280 + 64 * (j))
#define XB_XGEN(j)  (2304 + 64 * (j))
#define XB_TOP      3328
#define XB_TOPGEN   3392
#define XCD_BAR_WORDS 3456
#define XB_SPIN_CAP (1u << 18)
__device__ __forceinline__ unsigned xb_ld(unsigned* p)              { return __hip_atomic_load(p, __ATOMIC_RELAXED, __HIP_MEMORY_SCOPE_AGENT); }
__device__ __forceinline__ unsigned xb_add(unsigned* p, unsigned v) { return __hip_atomic_fetch_add(p, v, __ATOMIC_RELAXED, __HIP_MEMORY_SCOPE_AGENT); }
__device__ __forceinline__ unsigned xb_xcc_id() { return (unsigned)__builtin_amdgcn_s_getreg((3 << 11) | 20) & 0xFu; }
#define XB_SPIN(cond, bar) do { unsigned _sp = 0; while (cond) { __builtin_amdgcn_s_sleep(1); \
    if ((++_sp & 255u) == 0u) { if (xb_ld(&(bar)[XB_TMO])) break; if (_sp > XB_SPIN_CAP) { atomicAdd(&(bar)[XB_TMO], 1u); break; } } } } while (0)
struct XcdBarrier { unsigned* bar; unsigned x; volatile LAS unsigned* st; };
__device__ __forceinline__ XcdBarrier xcd_barrier_post(unsigned* bar, volatile LAS unsigned* st) {
    XcdBarrier b; b.bar = bar; b.x = xb_xcc_id(); b.st = st;
    if (threadIdx.x == 0) (void)xb_add(&bar[XB_XCNT(b.x)], 1u);
    return b;
}
__device__ __forceinline__ void xcd_barrier_complete(unsigned* bar, unsigned x, unsigned& nloc, unsigned& nx) {
    const unsigned G = gridDim.x * gridDim.y * gridDim.z;
    unsigned sum, cnt, mine, sp = 0u;
    for (;;) {
        sum = 0u; cnt = 0u; mine = 0u;
#pragma unroll
        for (unsigned j = 0; j < 16; ++j) { const unsigned c = xb_ld(&bar[XB_XCNT(j)]); sum += c; cnt += (c > 0u) ? 1u : 0u; mine = (j == x) ? c : mine; }
        if (sum == G) break;
        __builtin_amdgcn_s_sleep(1);
        if ((++sp & 255u) == 0u) { if (xb_ld(&bar[XB_TMO])) break; if (sp > XB_SPIN_CAP) { atomicAdd(&bar[XB_TMO], 1u); break; } }
    }
    nloc = mine > 0u ? mine : 1u; nx = cnt > 0u ? cnt : 1u;
}
__device__ __forceinline__ void xcd_barrier(const XcdBarrier& b, bool is_t0) {
    asm volatile("s_waitcnt vmcnt(0)" ::: "memory");
    __syncthreads();
    if (is_t0) {
        unsigned* bar = b.bar;
        __builtin_amdgcn_s_waitcnt(0);
        unsigned nloc = b.st[0], nx = b.st[1];
        if (nloc == 0u) { xcd_barrier_complete(bar, b.x, nloc, nx); b.st[0] = nloc; b.st[1] = nx; }
        const unsigned old = xb_add(&bar[XB_XSUB(b.x)], 1u);
        const unsigned gen = old / nloc;
        if (old + 1u == (gen + 1u) * nloc) {
            __builtin_amdgcn_fence(__ATOMIC_RELEASE, "agent");
            asm volatile("s_waitcnt vmcnt(0)" ::: "memory");
            const unsigned og = xb_add(&bar[XB_TOP], 1u);
            const unsigned tg = og / nx;
            if (og + 1u == (tg + 1u) * nx) xb_add(&bar[XB_TOPGEN], 1u);
            else XB_SPIN(xb_ld(&bar[XB_TOPGEN]) == tg, bar);
            __builtin_amdgcn_fence(__ATOMIC_ACQUIRE, "agent");
            xb_add(&bar[XB_XGEN(b.x)], 1u);
            asm volatile("s_waitcnt vmcnt(0)" ::: "memory");
        } else {
            XB_SPIN(xb_ld(&bar[XB_XGEN(b.x)]) == gen, bar);
            __builtin_amdgcn_fence(__ATOMIC_ACQUIRE, "agent");
            asm volatile("s_waitcnt vmcnt(0)" ::: "memory");
        }
    }
    __syncthreads();
}

struct Frame {
    LAS unsigned char* lds;
    LAS unsigned* X;
    unsigned char* ws_;
    int tid, lane, wave, G;
    __device__ __forceinline__ unsigned char* wsp() const { unsigned char* p = ws_; asm volatile("" : "+s"(p)); return p; }
    __device__ __forceinline__ gu32* ctlp() const { return (gu32*)(wsp() + WS_CTL); }
    __device__ __forceinline__ float* outp() const { return (float*)inp(20); }
    __device__ __forceinline__ const float* inp(int i) const { const unsigned lo = __builtin_amdgcn_readfirstlane(X[XW_INP + 2 * i]), hi = __builtin_amdgcn_readfirstlane(X[XW_INP + 2 * i + 1]);
        return (const float*)(((unsigned long long)hi << 32) | lo); }
    int wave0;
    __device__ __forceinline__ void rethread() { int w = wave0; asm volatile("" : "+s"(w)); unsigned z = 0u; asm volatile("" : "+v"(z)); const int l = (int)__builtin_amdgcn_mbcnt_hi(~0u, __builtin_amdgcn_mbcnt_lo(~0u, z)); wave = w; lane = l; tid = w * 64 + l; }
};
enum { I_X = 0, I_MWIN, I_MBG, I_MNG, I_MWOUT, I_GWIN, I_GBIN, I_GVG, I_GVB, I_GWS, I_GBS, I_GWOUT, I_RW, I_RB, I_EWGU, I_EBGU, I_EWDN, I_EBDN, I_LNG, I_LNB };

constexpr int TR_P = 65, TR_WAVE_BYTES = 64 * TR_P * 4;
__device__ __forceinline__ void tr_item64(const float* W, int N, int k0, int n0, bf16* dst, int Kd, LAS float* scr, int lane) {
    f32x4 v[16];
#pragma unroll
    for (int i = 0; i < 16; ++i) v[i] = *(const GAS f32x4*)(W + (size_t)(k0 + 4 * i + (lane >> 4)) * N + n0 + (lane & 15) * 4);
#pragma unroll
    for (int i = 0; i < 16; ++i) { LAS float* p = scr + (4 * i + (lane >> 4)) * TR_P + (lane & 15) * 4; p[0] = v[i].x; p[1] = v[i].y; p[2] = v[i].z; p[3] = v[i].w; }
    LDS_WAIT(); asm volatile("" ::: "memory");
    const int c = lane & 7;
#pragma unroll
    for (int j = 0; j < 8; ++j) { const int n = (lane >> 3) + 8 * j; const LAS float* s = scr + (8 * c) * TR_P + n;
        u32x4 o; o.x = cvt_pk_bf16(s[0 * TR_P], s[1 * TR_P]); o.y = cvt_pk_bf16(s[2 * TR_P], s[3 * TR_P]); o.z = cvt_pk_bf16(s[4 * TR_P], s[5 * TR_P]); o.w = cvt_pk_bf16(s[6 * TR_P], s[7 * TR_P]);
        *(GAS u32x4*)(dst + (size_t)n * Kd + k0 + 8 * c) = o; }
    LDS_WAIT(); asm volatile("" ::: "memory");
}
__device__ __forceinline__ void tr_item64_f8(const float* W, int N, int k0, int n0, unsigned char* dst, int Kd, LAS float* scr, int lane, float wscale = 64.f) {
    f32x4 v[16];
#pragma unroll
    for (int i = 0; i < 16; ++i) v[i] = *(const GAS f32x4*)(W + (size_t)(k0 + 4 * i + (lane >> 4)) * N + n0 + (lane & 15) * 4);
#pragma unroll
    for (int i = 0; i < 16; ++i) { LAS float* p = scr + (4 * i + (lane >> 4)) * TR_P + (lane & 15) * 4; p[0] = v[i].x; p[1] = v[i].y; p[2] = v[i].z; p[3] = v[i].w; }
    LDS_WAIT(); asm volatile("" ::: "memory");
    const int c = lane & 3;
#pragma unroll
    for (int j = 0; j < 4; ++j) { const int n = (lane >> 2) + 16 * j; const LAS float* s = scr + (16 * c) * TR_P + n; unsigned w[4];
#pragma unroll
        for (int g = 0; g < 4; ++g) { int a_ = 0; a_ = __builtin_amdgcn_cvt_pk_fp8_f32(s[(4 * g) * TR_P] * wscale, s[(4 * g + 1) * TR_P] * wscale, a_, false); a_ = __builtin_amdgcn_cvt_pk_fp8_f32(s[(4 * g + 2) * TR_P] * wscale, s[(4 * g + 3) * TR_P] * wscale, a_, true); w[g] = (unsigned)a_; }
        *(GAS u32x4*)(dst + (size_t)n * Kd + k0 + 16 * c) = (u32x4){w[0], w[1], w[2], w[3]}; }
    LDS_WAIT(); asm volatile("" ::: "memory");
}
__device__ __forceinline__ void tr_item(const float* W, int N, int k0, int n0, bf16* dst, int Kd, LAS float* scr, int lane) {
#pragma unroll 8
    for (int i = 0; i < 32; ++i) { const int kk = 2 * i + (lane >> 5); scr[kk * 33 + (lane & 31)] = W[(size_t)(k0 + kk) * N + n0 + (lane & 31)]; }
    LDS_WAIT(); asm volatile("" ::: "memory");
    const int c = lane & 7;
#pragma unroll
    for (int j = 0; j < 4; ++j) { const int n = (lane >> 3) + 8 * j; const LAS float* s = scr + (8 * c) * 33 + n;
        u32x4 o; o.x = cvt_pk_bf16(s[0 * 33], s[1 * 33]); o.y = cvt_pk_bf16(s[2 * 33], s[3 * 33]); o.z = cvt_pk_bf16(s[4 * 33], s[5 * 33]); o.w = cvt_pk_bf16(s[6 * 33], s[7 * 33]);
        *(GAS u32x4*)(dst + (size_t)n * Kd + k0 + 8 * c) = o; }
    LDS_WAIT(); asm volatile("" ::: "memory");
}

constexpr int CVT_ITEMS = 32 * 32 * 16 + 32 * 8 * 32, CW_CVT = 24576, XW_CVT = 660;
__device__ __forceinline__ void cvt_moe_item(Frame& F, int L, int idx, LAS float* scr) {
    if (idx < 32 * 512) { const int le = L * 32 + idx / 512, q = idx % 512, kb = q % 32, nb = q / 32;
        const int n0 = nb * 64, half = n0 >> 9, nn = n0 & 511, row = (nn >> 7) * 256 + half * 128 + (nn & 127);
        tr_item64_f8(F.inp(I_EWGU) + (size_t)le * D * 1024, 1024, kb * 64, n0, (unsigned char*)(F.wsp() + WS_WGU) + ((size_t)le * 1024 + row) * D, D, scr, F.lane); }
    else { const int r = idx - 32 * 512; const int le = L * 32 + r / 256, q = r % 256, kb = q % 8, nb = q / 8;
        tr_item64_f8(F.inp(I_EWDN) + (size_t)le * FF * D, D, kb * 64, nb * 64, (unsigned char*)(F.wsp() + WS_WDN) + ((size_t)le * D + nb * 64) * FF, FF, scr, F.lane); }
}
__device__ __forceinline__ void cvt_fill(Frame& F, int L, int max_batches) {
    F.rethread();
    LAS float* scr = (LAS float*)(F.lds + F.wave * TR_WAVE_BYTES);
    gu32* ctr = F.ctlp() + CW_CVT + L * 64;
#pragma unroll 1
    for (int bt = 0; max_batches < 0 || bt < max_batches; ++bt) {
        if (F.tid == 0) F.X[XW_CVT] = __hip_atomic_fetch_add(ctr, 8u, RLX_AGENT);
        __syncthreads();
        const int base = (int)F.X[XW_CVT];
        __syncthreads();
        if (base >= CVT_ITEMS) break;
        const int idx = base + F.wave; if (idx < CVT_ITEMS) cvt_moe_item(F, L, idx, scr);
    }
    __syncthreads();
}
constexpr int P0_S0 = 2 * 32 * 96, P0_S1 = 2 * 32 * 32, P0_S2 = 2 * 32 * 64, P0_S3 = 2 * 32 * 32, P0_NI64 = P0_S0 + P0_S1 + P0_S2 + P0_S3 + CVT_ITEMS;
__device__ __forceinline__ void p0a_decode(Frame& F, int it, const float*& src, int& N, unsigned char*& dst, int& Kd, int& f8, float& scale) {
    int r = it;
    if (r < P0_S0) { const int j = r / (32 * 96), q = r % (32 * 96), kb = q % 32, nb = q / 32;
        src = F.inp(I_MWIN) + (size_t)j * D * MIN_COLS + (size_t)(kb * 64) * MIN_COLS + nb * 64; N = MIN_COLS; dst = (unsigned char*)((bf16*)(F.wsp() + WS_WMI) + ((size_t)j * MIN_MAIN + nb * 64) * D + kb * 64); Kd = D; f8 = 0; scale = 1.f; return; } r -= P0_S0;
    if (r < P0_S1) { const int j = r / 1024, q = r % 1024, kb = q % 32, nb = q / 32;
        src = F.inp(I_MWOUT) + (size_t)j * D * D + (size_t)(kb * 64) * D + nb * 64; N = D; dst = (unsigned char*)(F.wsp() + WS_WMO) + ((size_t)j * D + nb * 64) * D + kb * 64; Kd = D; f8 = 1; scale = 128.f; return; } r -= P0_S1;
    if (r < P0_S2) { const int j = r / 2048, q = r % 2048, kb = q % 32, nb = q / 32;
        src = F.inp(I_GWIN) + (size_t)j * D * 4096 + (size_t)(kb * 64) * 4096 + nb * 64; N = 4096; dst = (unsigned char*)((bf16*)(F.wsp() + WS_WGI) + ((size_t)j * 4096 + nb * 64) * D + kb * 64); Kd = D; f8 = 0; scale = 1.f; return; } r -= P0_S2;
    if (r < P0_S3) { const int j = r / 1024, q = r % 1024, kb = q % 32, nb = q / 32;
        src = F.inp(I_GWOUT) + (size_t)j * D * D + (size_t)(kb * 64) * D + nb * 64; N = D; dst = (unsigned char*)(F.wsp() + WS_WGO) + ((size_t)j * D + nb * 64) * D + kb * 64; Kd = D; f8 = 1; scale = 128.f; return; } r -= P0_S3;
    f8 = 1; scale = 64.f;
    if (r < 32 * 512) { const int le = r / 512, q = r % 512, kb = q % 32, nb = q / 32; const int n0 = nb * 64, half = n0 >> 9, nn = n0 & 511, row = (nn >> 7) * 256 + half * 128 + (nn & 127);
        src = F.inp(I_EWGU) + (size_t)le * D * 1024 + (size_t)(kb * 64) * 1024 + n0; N = 1024; dst = (unsigned char*)(F.wsp() + WS_WGU) + ((size_t)le * 1024 + row) * D + kb * 64; Kd = D; }
    else { r -= 32 * 512; const int le = r / 256, q = r % 256, kb = q % 8, nb = q / 8;
        src = F.inp(I_EWDN) + (size_t)le * FF * D + (size_t)(kb * 64) * D + nb * 64; N = D; dst = (unsigned char*)(F.wsp() + WS_WDN) + ((size_t)le * D + nb * 64) * FF + kb * 64; Kd = FF; }
}
__device__ __forceinline__ void tr_load64(const float* src, int N, int lane, f32x4 (&v)[16]) {
#pragma unroll
    for (int i = 0; i < 16; ++i) v[i] = *(const GAS f32x4*)(src + (size_t)(4 * i + (lane >> 4)) * N + (lane & 15) * 4);
}
__device__ __forceinline__ void tr_finish64(const f32x4 (&v)[16], unsigned char* dst, int Kd, int f8, float wscale, LAS float* scr, int lane) {
#pragma unroll
    for (int i = 0; i < 16; ++i) { LAS float* p = scr + (4 * i + (lane >> 4)) * TR_P + (lane & 15) * 4; p[0] = v[i].x; p[1] = v[i].y; p[2] = v[i].z; p[3] = v[i].w; }
    LDS_WAIT(); asm volatile("" ::: "memory");
    if (f8) { const int c = lane & 3;
#pragma unroll
        for (int j = 0; j < 4; ++j) { const int n = (lane >> 2) + 16 * j; const LAS float* s = scr + (16 * c) * TR_P + n; unsigned w[4];
#pragma unroll
            for (int g = 0; g < 4; ++g) { int a_ = 0; a_ = __builtin_amdgcn_cvt_pk_fp8_f32(s[(4 * g) * TR_P] * wscale, s[(4 * g + 1) * TR_P] * wscale, a_, false); a_ = __builtin_amdgcn_cvt_pk_fp8_f32(s[(4 * g + 2) * TR_P] * wscale, s[(4 * g + 3) * TR_P] * wscale, a_, true); w[g] = (unsigned)a_; }
            *(GAS u32x4*)(dst + (size_t)n * Kd + 16 * c) = (u32x4){w[0], w[1], w[2], w[3]}; } }
    else { const int c = lane & 7;
#pragma unroll
        for (int j = 0; j < 8; ++j) { const int n = (lane >> 3) + 8 * j; const LAS float* s = scr + (8 * c) * TR_P + n;
            u32x4 o; o.x = cvt_pk_bf16(s[0 * TR_P], s[1 * TR_P]); o.y = cvt_pk_bf16(s[2 * TR_P], s[3 * TR_P]); o.z = cvt_pk_bf16(s[4 * TR_P], s[5 * TR_P]); o.w = cvt_pk_bf16(s[6 * TR_P], s[7 * TR_P]);
            *(GAS u32x4*)((bf16*)dst + (size_t)n * Kd + 8 * c) = o; } }
    LDS_WAIT(); asm volatile("" ::: "memory");
}
__device__ __forceinline__ void p0a_weights(Frame& F) {
    F.rethread();
    LAS float* scr = (LAS float*)(F.lds + F.wave * TR_WAVE_BYTES);
    const int gw = blockIdx.x * NWAVES + F.wave, NGW = F.G * NWAVES;
    { f32x4 va[16], vb[16]; const float* sA; const float* sB; unsigned char* dA; unsigned char* dB; int nA, nB, kA, kB, fA, fB; float cA, cB;
      int it = gw;
      if (it < P0_NI64) { p0a_decode(F, it, sA, nA, dA, kA, fA, cA); tr_load64(sA, nA, F.lane, va);
#pragma unroll 1
        for (;;) {
            const bool haveB = it + NGW < P0_NI64; p0a_decode(F, haveB ? it + NGW : it, sB, nB, dB, kB, fB, cB); tr_load64(sB, nB, F.lane, vb);
            tr_finish64(va, dA, kA, fA, cA, scr, F.lane);
            if (!haveB) break;
            const bool haveA = it + 2 * NGW < P0_NI64; p0a_decode(F, haveA ? it + 2 * NGW : it + NGW, sA, nA, dA, kA, fA, cA); tr_load64(sA, nA, F.lane, va);
            tr_finish64(vb, dB, kB, fB, cB, scr, F.lane);
            if (!haveA) break;
            it += 2 * NGW; } } }
    { constexpr int SG = 2 * 32, S4 = 4 * 32;
      for (int it = gw; it < SG + S4; it += NGW) { int r = it;
        if (r < SG) { const int j = r / 32, kb = r % 32;
            tr_item(F.inp(I_MWIN) + (size_t)j * D * MIN_COLS, MIN_COLS, kb * 64, MIN_MAIN, (bf16*)(F.wsp() + WS_WG_T) + (size_t)j * 32 * D, D, scr, F.lane); continue; } r -= SG;
        { const int l = r / 32, kb = r % 32;
            tr_item(F.inp(I_RW) + (size_t)l * D * NE, NE, kb * 64, 0, (bf16*)(F.wsp() + WS_WR_T) + (size_t)l * 32 * D, D, scr, F.lane); } } }
    { const float* src = F.inp(I_GWS); bf16* dst = (bf16*)(F.wsp() + WS_WS); const int n4 = 2 * 8 * 128 * 128 / 4;
      for (int i = blockIdx.x * NTHREADS + F.tid; i < n4; i += F.G * NTHREADS) { const f32x4 v = ((const GAS f32x4*)src)[i]; u32x2 o; o.x = cvt_pk_bf16(v.x, v.y); o.y = cvt_pk_bf16(v.z, v.w); ((GAS u32x2*)dst)[i] = o; } }
}

__device__ __forceinline__ void skinny16(Frame& F, const bf16* WT, const float* bias) {
    LAS unsigned char* XT = F.lds; LAS float* PART = (LAS float*)(F.lds + RP_PART); LAS float* LOG = (LAS float*)(F.lds + RP_LOG);
    const int r = F.lane & 15, q = F.lane >> 4;
    float zf_ = 0.f; asm volatile("" : "+v"(zf_)); f32x4 acc0 = (f32x4){zf_, zf_, zf_, zf_}, acc1 = acc0;
#pragma unroll
    for (int ks = 0; ks < 8; ++ks) {
        const int k0 = F.wave * 256 + ks * 32 + 8 * q;
        const bf16x8 a = *(const LAS bf16x8*)(XT + r * XT_PITCH + k0 * 2);
        const bf16x8 b0 = *(const GAS bf16x8*)(WT + (size_t)r * D + k0);
        const bf16x8 b1 = *(const GAS bf16x8*)(WT + (size_t)(16 + r) * D + k0);
        acc0 = __builtin_amdgcn_mfma_f32_16x16x32_bf16(a, b0, acc0, 0, 0, 0);
        acc1 = __builtin_amdgcn_mfma_f32_16x16x32_bf16(a, b1, acc1, 0, 0, 0);
    }
#pragma unroll
    for (int i = 0; i < 4; ++i) { PART[(F.wave * 16 + 4 * q + i) * 33 + r] = acc0[i]; PART[(F.wave * 16 + 4 * q + i) * 33 + 16 + r] = acc1[i]; }
    __syncthreads();
    { const int row = F.tid >> 5, e = F.tid & 31; float s = bias[e];
#pragma unroll
      for (int w = 0; w < 8; ++w) s += PART[(w * 16 + row) * 33 + e];
      LOG[row * LOGP + e] = s; }
    __syncthreads();
}
__device__ __forceinline__ void load_lane_vec32(const float* p, int lane, float (&v)[32]) {
#pragma unroll
    for (int j = 0; j < 4; ++j) { const f32x4 a = *(const GAS f32x4*)(p + 8 * lane + 512 * j), b = *(const GAS f32x4*)(p + 8 * lane + 512 * j + 4);
        v[8 * j + 0] = a.x; v[8 * j + 1] = a.y; v[8 * j + 2] = a.z; v[8 * j + 3] = a.w; v[8 * j + 4] = b.x; v[8 * j + 5] = b.y; v[8 * j + 6] = b.z; v[8 * j + 7] = b.w; }
}
__device__ __forceinline__ void load_row_bf16(const bf16* row, int lane, float (&v)[32]) {
#pragma unroll
    for (int j = 0; j < 4; ++j) { const u32x4 w = *(const GAS u32x4*)(row + 8 * lane + 512 * j);
        v[8 * j + 0] = bf_lo(w.x); v[8 * j + 1] = bf_hi(w.x); v[8 * j + 2] = bf_lo(w.y); v[8 * j + 3] = bf_hi(w.y); v[8 * j + 4] = bf_lo(w.z); v[8 * j + 5] = bf_hi(w.z); v[8 * j + 6] = bf_lo(w.w); v[8 * j + 7] = bf_hi(w.w); }
}
__device__ __forceinline__ void layer_norm32(float (&v)[32], const float (&g)[32], const float (&b)[32]) {
    float s = 0.f;
#pragma unroll
    for (int i = 0; i < 32; ++i) s += v[i];
    const float mean = wave_sum(s) * (1.f / D); float s2 = 0.f;
#pragma unroll
    for (int i = 0; i < 32; ++i) { v[i] -= mean; s2 += v[i] * v[i]; }
    const float rstd = 1.f / sqrtf(wave_sum(s2) * (1.f / D) + LN_EPS);
#pragma unroll
    for (int i = 0; i < 32; ++i) v[i] = v[i] * rstd * g[i] + b[i];
}
__device__ __forceinline__ void layer_norm32_lds(float (&v)[32], const LAS float* GL, const LAS float* BL, int lane) {
    float s = 0.f;
#pragma unroll
    for (int i = 0; i < 32; ++i) s += v[i];
    const float mean = wave_sum(s) * (1.f / D); float s2 = 0.f;
#pragma unroll
    for (int i = 0; i < 32; ++i) { v[i] -= mean; s2 += v[i] * v[i]; }
    const float rstd = 1.f / sqrtf(wave_sum(s2) * (1.f / D) + LN_EPS);
#pragma unroll
    for (int j = 0; j < 4; ++j) { const f32x4 g0 = *(const LAS f32x4*)(GL + 8 * lane + 512 * j), g1 = *(const LAS f32x4*)(GL + 8 * lane + 512 * j + 4), b0 = *(const LAS f32x4*)(BL + 8 * lane + 512 * j), b1 = *(const LAS f32x4*)(BL + 8 * lane + 512 * j + 4);
        v[8 * j + 0] = v[8 * j + 0] * rstd * g0.x + b0.x; v[8 * j + 1] = v[8 * j + 1] * rstd * g0.y + b0.y; v[8 * j + 2] = v[8 * j + 2] * rstd * g0.z + b0.z; v[8 * j + 3] = v[8 * j + 3] * rstd * g0.w + b0.w;
        v[8 * j + 4] = v[8 * j + 4] * rstd * g1.x + b1.x; v[8 * j + 5] = v[8 * j + 5] * rstd * g1.y + b1.y; v[8 * j + 6] = v[8 * j + 6] * rstd * g1.z + b1.z; v[8 * j + 7] = v[8 * j + 7] * rstd * g1.w + b1.w; }
}
__device__ __forceinline__ void store_row_bf16(const float (&v)[32], bf16* grow, LAS unsigned char* xt_row, bool to_lds, int lane) {
#pragma unroll
    for (int j = 0; j < 4; ++j) { u32x4 w; w.x = cvt_pk_bf16(v[8 * j], v[8 * j + 1]); w.y = cvt_pk_bf16(v[8 * j + 2], v[8 * j + 3]); w.z = cvt_pk_bf16(v[8 * j + 4], v[8 * j + 5]); w.w = cvt_pk_bf16(v[8 * j + 6], v[8 * j + 7]);
        *(GAS u32x4*)(grow + 8 * lane + 512 * j) = w;
        if (to_lds) *(LAS u32x4*)(xt_row + (8 * lane + 512 * j) * 2) = w; }
}
__device__ __forceinline__ void p0b_rows(Frame& F) {
    F.rethread();
    const float* x = F.inp(I_X); bf16* XB = (bf16*)(F.wsp() + WS_XB); float* GT = (float*)(F.wsp() + WS_GATES);
    LAS float* LOG = (LAS float*)(F.lds + RP_LOG);
    for (int it = blockIdx.x; it < T / 16; it += F.G) {
#pragma unroll 1
        for (int rr = 0; rr < 2; ++rr) { const int r = F.wave * 2 + rr, t = it * 16 + r; float v[32];
            load_lane_vec32(x + (size_t)t * D, F.lane, v);
            store_row_bf16(v, XB + (size_t)t * D, F.lds + r * XT_PITCH, true, F.lane); }
        __syncthreads();
        skinny16(F, (const bf16*)(F.wsp() + WS_WG_T), F.inp(I_MBG));
        { const int row = F.tid >> 5, e = F.tid & 31; GT[(size_t)(it * 16 + row) * 32 + e] = LOG[row * LOGP + e]; }
    }
    __syncthreads();
}
__device__ __forceinline__ void r1_phase(Frame& F, int layer) {
    F.rethread();
    const bf16* PRE = (const bf16*)(F.wsp() + WS_PRE); bf16* X1 = (bf16*)(F.wsp() + WS_X1);
    int* LIST = (int*)(F.wsp() + WS_LIST); int* EIDX = (int*)(F.wsp() + WS_TOK); int* POS = (int*)(F.wsp() + WS_TOK + 256 * 1024); float* GATE = (float*)(F.wsp() + WS_TOK + 512 * 1024);
    LAS unsigned char* XT = F.lds; LAS float* PART = (LAS float*)(F.lds + RP_PART); LAS float* LOGA = (LAS float*)(F.lds + RP_LOGA);
    gu32* gcnt = F.ctlp() + CW_CNT + layer * 32 * 64;
    const int r16 = F.lane & 15, q = F.lane >> 4;
    float g[32], b[32];
    load_lane_vec32(F.inp(I_LNG) + (size_t)(layer * 2 + 0) * D, F.lane, g); load_lane_vec32(F.inp(I_LNB) + (size_t)(layer * 2 + 0) * D, F.lane, b);
    bf16x8 bw0[8], bw1[8];
    { const bf16* WT = (const bf16*)(F.wsp() + WS_WR_T) + (size_t)layer * 32 * D;
#pragma unroll
      for (int ks = 0; ks < 8; ++ks) { const int k0 = F.wave * 256 + ks * 32 + 8 * q; bw0[ks] = *(const GAS bf16x8*)(WT + (size_t)r16 * D + k0); bw1[ks] = *(const GAS bf16x8*)(WT + (size_t)(16 + r16) * D + k0); } }
    const float* rbias = F.inp(I_RB) + layer * NE;
    if (F.tid < 32) F.X[XW_LCNT + F.tid] = 0u;
    int nit = 0;
    u32x4 praw[4];
    if ((int)blockIdx.x < T / 16) {
#pragma unroll
        for (int j = 0; j < 4; ++j) praw[j] = *(const GAS u32x4*)(PRE + (size_t)((int)blockIdx.x * 16 + F.wave * 2) * D + 8 * F.lane + 512 * j); }
    for (int it = blockIdx.x; it < T / 16; it += F.G, ++nit) {
#pragma unroll 1
        for (int rr = 0; rr < 2; ++rr) { const int r = F.wave * 2 + rr, t = it * 16 + r; float v[32];
#pragma unroll
            for (int j = 0; j < 4; ++j) { const u32x4 w = praw[j];
                v[8 * j + 0] = bf_lo(w.x); v[8 * j + 1] = bf_hi(w.x); v[8 * j + 2] = bf_lo(w.y); v[8 * j + 3] = bf_hi(w.y); v[8 * j + 4] = bf_lo(w.z); v[8 * j + 5] = bf_hi(w.z); v[8 * j + 6] = bf_lo(w.w); v[8 * j + 7] = bf_hi(w.w); }
            { const int tn = rr == 0 ? t + 1 : (it + F.G) * 16 + F.wave * 2;
              if (rr == 0 || it + F.G < T / 16) {
#pragma unroll
                  for (int j = 0; j < 4; ++j) praw[j] = *(const GAS u32x4*)(PRE + (size_t)tn * D + 8 * F.lane + 512 * j); } }
            layer_norm32(v, g, b);
            store_row_bf16(v, X1 + (size_t)t * D, XT + r * XT_PITCH, true, F.lane);
            { unsigned char* x8 = (unsigned char*)(F.wsp() + WS_X1F8) + (size_t)t * D;
#pragma unroll
              for (int j = 0; j < 4; ++j) { int a_ = 0, b_ = 0; a_ = __builtin_amdgcn_cvt_pk_fp8_f32(v[8 * j], v[8 * j + 1], a_, false); a_ = __builtin_amdgcn_cvt_pk_fp8_f32(v[8 * j + 2], v[8 * j + 3], a_, true);
                  b_ = __builtin_amdgcn_cvt_pk_fp8_f32(v[8 * j + 4], v[8 * j + 5], b_, false); b_ = __builtin_amdgcn_cvt_pk_fp8_f32(v[8 * j + 6], v[8 * j + 7], b_, true);
                  *(GAS u32x2*)(x8 + 8 * F.lane + 512 * j) = (u32x2){(unsigned)a_, (unsigned)b_}; } } }
        __syncthreads();
        { float zf_ = 0.f; asm volatile("" : "+v"(zf_)); f32x4 acc0 = (f32x4){zf_, zf_, zf_, zf_}, acc1 = acc0;
#pragma unroll
          for (int ks = 0; ks < 8; ++ks) { const bf16x8 a = *(const LAS bf16x8*)(XT + r16 * XT_PITCH + (F.wave * 256 + ks * 32 + 8 * q) * 2);
              acc0 = __builtin_amdgcn_mfma_f32_16x16x32_bf16(a, bw0[ks], acc0, 0, 0, 0); acc1 = __builtin_amdgcn_mfma_f32_16x16x32_bf16(a, bw1[ks], acc1, 0, 0, 0); }
#pragma unroll
          for (int i = 0; i < 4; ++i) { PART[(F.wave * 16 + 4 * q + i) * 33 + r16] = acc0[i]; PART[(F.wave * 16 + 4 * q + i) * 33 + 16 + r16] = acc1[i]; } }
        __syncthreads();
        { const int row = F.tid >> 5, e = F.tid & 31; float s = rbias[e];
#pragma unroll
          for (int w = 0; w < 8; ++w) s += PART[(w * 16 + row) * 33 + e];
          LOGA[(nit * 16 + row) * LOGP + e] = s; }
    }
    __syncthreads();
    const int nrows = nit * 16; const int row = F.wave * 8 + (F.lane & 7); const bool act = (F.lane < 8) && (row < nrows);
    int e4[4] = {0, 0, 0, 0}; float v4[4] = {0.f, 0.f, 0.f, 0.f}; unsigned rk[4] = {0u, 0u, 0u, 0u};
    if (act) { unsigned mask = 0u; float lv[32];
#pragma unroll
        for (int e4i = 0; e4i < 8; ++e4i) { const f32x4 t = *(const LAS f32x4*)(LOGA + row * LOGP + 4 * e4i); lv[4 * e4i] = t.x; lv[4 * e4i + 1] = t.y; lv[4 * e4i + 2] = t.z; lv[4 * e4i + 3] = t.w; }
#pragma unroll
        for (int k = 0; k < 4; ++k) { float best = -__builtin_inff(); int bi = 0;
#pragma unroll
            for (int e = 0; e < 32; ++e) { const bool ok = (((mask >> e) & 1u) == 0u) && (lv[e] > best); best = ok ? lv[e] : best; bi = ok ? e : bi; }
            mask |= 1u << bi; e4[k] = bi; v4[k] = best; }
        const float e1 = __expf(v4[1] - v4[0]), e2 = __expf(v4[2] - v4[0]), e3 = __expf(v4[3] - v4[0]); const float inv = 1.f / (1.f + e1 + e2 + e3);
        v4[0] = inv; v4[1] = e1 * inv; v4[2] = e2 * inv; v4[3] = e3 * inv;
#pragma unroll
        for (int k = 0; k < 4; ++k) rk[k] = __hip_atomic_fetch_add((LAS unsigned*)(F.X + XW_LCNT + e4[k]), 1u, __ATOMIC_RELAXED, __HIP_MEMORY_SCOPE_WORKGROUP); }
    __syncthreads();
    if (F.tid < 32) { const unsigned c = F.X[XW_LCNT + F.tid]; unsigned base = 0u; if (c) base = __hip_atomic_fetch_add(gcnt + F.tid * 64, c, RLX_AGENT); F.X[XW_LBASE + F.tid] = base; }
    __syncthreads();
    if (act) { const int t = ((int)blockIdx.x + (row >> 4) * F.G) * 16 + (row & 15);
#pragma unroll
        for (int k = 0; k < 4; ++k) { const unsigned pos = F.X[XW_LBASE + e4[k]] + rk[k]; __hip_atomic_store((GAS int*)LIST + ((size_t)e4[k] * CAP + pos), t, RLX_AGENT); EIDX[t * 4 + k] = e4[k]; POS[t * 4 + k] = (int)pos; GATE[t * 4 + k] = v4[k]; } }
    __syncthreads();
}
__device__ __forceinline__ void moe_tables(Frame& F, int layer) {
    F.rethread();
    gu32* gcnt = F.ctlp() + CW_CNT + layer * 32 * 64;
    if (F.tid < 32) F.X[XW_CNT + F.tid] = __hip_atomic_load(gcnt + F.tid * 64, RLX_AGENT);
    __syncthreads();
    if (F.tid == 0) { unsigned run = 0u;
        for (int e = 0; e < 32; ++e) { const unsigned c = F.X[XW_CNT + e], n = (c + 255u) >> 8; F.X[XW_TPRE + e] = run; F.X[XW_PSTART + e] = run * 256u;
            for (unsigned i = 0; i < n; ++i) F.X[XW_TILE_E + run + i] = (unsigned)e; run += n; }
        F.X[XW_TPRE + 32] = run; F.X[XW_NTILES] = run; }
    __syncthreads();
}
__device__ __forceinline__ void r2_phase(Frame& F, int layer, bool last, int gates_j, int kmax) {
    F.rethread();
    const bf16* X1 = (const bf16*)(F.wsp() + WS_X1); const unsigned char* Y = (const unsigned char*)(F.wsp() + WS_Y); bf16* XB = (bf16*)(F.wsp() + WS_XB); float* GT = (float*)(F.wsp() + WS_GATES);
    const int* EIDX = (const int*)(F.wsp() + WS_TOK); const int* POS = (const int*)(F.wsp() + WS_TOK + 256 * 1024); const float* GATE = (const float*)(F.wsp() + WS_TOK + 512 * 1024);
    LAS float* LOG = (LAS float*)(F.lds + RP_LOG);
    LAS float* GL = (LAS float*)(F.lds + RP_GB); LAS float* BL = GL + D;
    { const float* gp = F.inp(I_LNG) + (size_t)(layer * 2 + 1) * D; const float* bp = F.inp(I_LNB) + (size_t)(layer * 2 + 1) * D;
      *(LAS f32x4*)(GL + 4 * F.tid) = *(const GAS f32x4*)(gp + 4 * F.tid); *(LAS f32x4*)(BL + 4 * F.tid) = *(const GAS f32x4*)(bp + 4 * F.tid); }
    __syncthreads();
    for (int it = blockIdx.x; it < T / 16; it += F.G) {
#pragma unroll
        for (int rr = 0; rr < 2; ++rr) { const int r = F.wave * 2 + rr, t = it * 16 + r; float v[32];
            load_row_bf16(X1 + (size_t)t * D, F.lane, v);
#pragma unroll
            for (int i = 0; i < 32; ++i) v[i] *= ALPHA;
#pragma unroll
            for (int k = 0; k < 4; ++k) if (k < kmax) { const int e = __builtin_amdgcn_readfirstlane(EIDX[t * 4 + k]), pos = __builtin_amdgcn_readfirstlane(POS[t * 4 + k]); const float gt = GATE[t * 4 + k];
                const unsigned slot = F.X[XW_PSTART + e] + (unsigned)pos; float yv[32];
                { const unsigned char* yr = Y + (size_t)slot * D;
#pragma unroll
                  for (int j = 0; j < 4; ++j) { const u32x2 w = *(const GAS u32x2*)(yr + 8 * F.lane + 512 * j);
                      yv[8 * j + 0] = __builtin_amdgcn_cvt_f32_fp8((int)w.x, 0); yv[8 * j + 1] = __builtin_amdgcn_cvt_f32_fp8((int)w.x, 1); yv[8 * j + 2] = __builtin_amdgcn_cvt_f32_fp8((int)w.x, 2); yv[8 * j + 3] = __builtin_amdgcn_cvt_f32_fp8((int)w.x, 3);
                      yv[8 * j + 4] = __builtin_amdgcn_cvt_f32_fp8((int)w.y, 0); yv[8 * j + 5] = __builtin_amdgcn_cvt_f32_fp8((int)w.y, 1); yv[8 * j + 6] = __builtin_amdgcn_cvt_f32_fp8((int)w.y, 2); yv[8 * j + 7] = __builtin_amdgcn_cvt_f32_fp8((int)w.y, 3); } }
                const float gts = gt * (1.0f / Y_SCALE);
#pragma unroll
                for (int i = 0; i < 32; ++i) v[i] += gts * yv[i]; }
            layer_norm32_lds(v, GL, BL, F.lane);
            if (last) { float* o = F.outp() + (size_t)t * D;
#pragma unroll
                for (int j = 0; j < 4; ++j) { *(GAS f32x4*)(o + 8 * F.lane + 512 * j) = (f32x4){v[8 * j], v[8 * j + 1], v[8 * j + 2], v[8 * j + 3]}; *(GAS f32x4*)(o + 8 * F.lane + 512 * j + 4) = (f32x4){v[8 * j + 4], v[8 * j + 5], v[8 * j + 6], v[8 * j + 7]}; } }
            else store_row_bf16(v, XB + (size_t)t * D, F.lds + r * XT_PITCH, gates_j >= 0, F.lane); }
        if (gates_j >= 0) {
            __syncthreads();
            skinny16(F, (const bf16*)(F.wsp() + WS_WG_T) + (size_t)gates_j * 32 * D, F.inp(I_MBG) + gates_j * 32);
            { const int row = F.tid >> 5, e = F.tid & 31; GT[(size_t)(it * 16 + row) * 32 + e] = LOG[row * LOGP + e]; }
        }
    }
    __syncthreads();
}
__device__ __forceinline__ void stub_mixer(Frame& F) {
    F.rethread();
    const bf16* XB = (const bf16*)(F.wsp() + WS_XB); bf16* PRE = (bf16*)(F.wsp() + WS_PRE);
    for (size_t i = (size_t)blockIdx.x * NTHREADS + F.tid; i < (size_t)T * D / 8; i += (size_t)F.G * NTHREADS) { const u32x4 w = ((const GAS u32x4*)XB)[i]; u32x4 o;
        o.x = cvt_pk_bf16(bf_lo(w.x) * ALPHA, bf_hi(w.x) * ALPHA); o.y = cvt_pk_bf16(bf_lo(w.y) * ALPHA, bf_hi(w.y) * ALPHA); o.z = cvt_pk_bf16(bf_lo(w.z) * ALPHA, bf_hi(w.z) * ALPHA); o.w = cvt_pk_bf16(bf_lo(w.w) * ALPHA, bf_hi(w.w) * ALPHA);
        ((GAS u32x4*)PRE)[i] = o; }
}


typedef float f32x2_t __attribute__((ext_vector_type(2)));
__device__ __forceinline__ f32x2_t gelu_pk(f32x2_t v) {
    const f32x2_t av = __builtin_elementwise_abs(v), d = av * 0.2316418882f + 1.0f;
    f32x2_t t; t.x = __builtin_amdgcn_rcpf(d.x); t.y = __builtin_amdgcn_rcpf(d.y);
    f32x2_t q = t * 0.5307027145f + (-0.7265760135f); q = q * t + 0.7107068705f; q = q * t + (-0.142248368f); q = q * t + 0.127414796f; q = q * t;
    const f32x2_t s = (v * v) * (-0.72134752044f);
    f32x2_t e; e.x = __builtin_amdgcn_exp2f(s.x); e.y = __builtin_amdgcn_exp2f(s.y);
    const f32x2_t m = v * (q * e), r = v - m;
    f32x2_t o; o.x = v.x < 0.f ? m.x : r.x; o.y = v.y < 0.f ? m.y : r.y; return o;
}
template <int KK, int NN> struct RectBase {
    static constexpr int K = KK; static constexpr bool PERM = true, FP8 = false; static constexpr int SCALE_B = 0x7f7f7f7f;
    const bf16* A; const bf16* Bt; int G, c;
    __device__ __forceinline__ bool next(int i, pg8::Unit& u) const {
        constexpr int nM = T / 256, nN = NN / 256, nwg = nM * nN; const long L = (long)i * G + c; if (L >= nwg) return false;
        const int wgid = pg8::xcd_remap((int)L, nwg); constexpr int nig = pg8::WGM * nN; const int gid = wgid / nig, fm = gid * pg8::WGM, gsz = (nM - fm) < pg8::WGM ? (nM - fm) : pg8::WGM;
        u.pm = fm + ((wgid % nig) % gsz); u.pn = (wgid % nig) / gsz; u.e = 0; u.x = 0; return true;
    }
    __device__ __forceinline__ void bases(const pg8::Unit& u, const char*& cA, const char*& cB) const { cA = (const char*)(A + (size_t)u.pm * 256 * KK); cB = (const char*)(Bt + (size_t)u.pn * 256 * KK); }
    __device__ __forceinline__ void avoff(const pg8::Unit&, int tid, unsigned (&v)[2][2]) const {
#pragma unroll
        for (int i = 0; i < 2; ++i) { int R, C; pg8::stage_rc(tid * 16 + i * 8192, R, C);
#pragma unroll
            for (int h = 0; h < 2; ++h) v[h][i] = (unsigned)((h * 128 + R) * KK + C) * 2u; }
    }
};
struct OutProjProb : RectBase<D / 2, D> {
    static constexpr bool FP8 = true; static constexpr int SCALE_B = 0x78787878;
    const bf16* XB; bf16* PRE;
    __device__ __forceinline__ void epi(const f32x4 (&acc)[2][2][4][2], const pg8::Unit& u, int wr, int wc, int fr, int fq) const {
        const int row0 = u.pm * 256 + wr * 64 + fr, c0 = u.pn * 256 + wc * 32 + 8 * fq;
#pragma unroll
        for (int ai = 0; ai < 2; ++ai)
#pragma unroll
            for (int m = 0; m < 4; ++m) { const size_t off = (size_t)(row0 + ai * 128 + m * 16) * D + c0;
#pragma unroll
                for (int bj = 0; bj < 2; ++bj) { const u32x4 xr = *(const GAS u32x4*)(XB + off + bj * 128); const f32x4 a0 = acc[ai][bj][m][0], a1 = acc[ai][bj][m][1]; u32x4 w;
                    w.x = cvt_pk_bf16(ALPHA * bf_lo(xr.x) + a0[0], ALPHA * bf_hi(xr.x) + a0[1]); w.y = cvt_pk_bf16(ALPHA * bf_lo(xr.y) + a0[2], ALPHA * bf_hi(xr.y) + a0[3]);
                    w.z = cvt_pk_bf16(ALPHA * bf_lo(xr.z) + a1[0], ALPHA * bf_hi(xr.z) + a1[1]); w.w = cvt_pk_bf16(ALPHA * bf_lo(xr.w) + a1[2], ALPHA * bf_hi(xr.w) + a1[3]);
                    *(GAS u32x4*)(PRE + off + bj * 128) = w; }
                asm volatile("" ::: "memory"); }
    }
};
struct GmlpInProb : RectBase<D, 4096> {
    const float* bias; bf16* U; bf16* V; float* VSTAT;
    __device__ __forceinline__ void epi(const f32x4 (&acc)[2][2][4][2], const pg8::Unit& u, int wr, int wc, int fr, int fq) const {
        const int row0 = u.pm * 256 + wr * 64 + fr, ct = u.pn * 256 + wc * 32 + 8 * fq; const bool isv = u.pn >= 8;
        bf16* O = isv ? V : U; const int c0 = isv ? ct - 2048 : ct;
#pragma unroll
        for (int ai = 0; ai < 2; ++ai)
#pragma unroll
            for (int m = 0; m < 4; ++m) { const int row = row0 + ai * 128 + m * 16; float s1 = 0.f, s2 = 0.f;
#pragma unroll
                for (int bj = 0; bj < 2; ++bj) { const f32x4 b0 = *(const GAS f32x4*)(bias + ct + bj * 128), b1 = *(const GAS f32x4*)(bias + ct + bj * 128 + 4);
                    const f32x4 v0 = acc[ai][bj][m][0] + b0, v1 = acc[ai][bj][m][1] + b1;
                    const f32x2_t g0 = gelu_pk((f32x2_t){v0[0], v0[1]}), g1 = gelu_pk((f32x2_t){v0[2], v0[3]}), g2 = gelu_pk((f32x2_t){v1[0], v1[1]}), g3 = gelu_pk((f32x2_t){v1[2], v1[3]});
                    u32x4 w; w.x = cvt_pk_bf16(g0.x, g0.y); w.y = cvt_pk_bf16(g1.x, g1.y); w.z = cvt_pk_bf16(g2.x, g2.y); w.w = cvt_pk_bf16(g3.x, g3.y);
                    *(GAS u32x4*)(O + (isv ? (size_t)((((unsigned)(row >> 7) * 8u + (unsigned)(u.pn - 8)) * 32u + (unsigned)(wc * 4 + fq + bj * 16)) * 128u + (unsigned)(row & 127)) * 8u : (size_t)row * D + c0 + bj * 128)) = w;
                    if (isv) { const float r0 = bf_lo(w.x), r1 = bf_hi(w.x), r2 = bf_lo(w.y), r3 = bf_hi(w.y), r4 = bf_lo(w.z), r5 = bf_hi(w.z), r6 = bf_lo(w.w), r7 = bf_hi(w.w);
                        s1 += ((r0 + r1) + (r2 + r3)) + ((r4 + r5) + (r6 + r7)); s2 += ((r0 * r0 + r1 * r1) + (r2 * r2 + r3 * r3)) + ((r4 * r4 + r5 * r5) + (r6 * r6 + r7 * r7)); } }
                if (isv) { s1 += __shfl_xor(s1, 16); s1 += __shfl_xor(s1, 32); s2 += __shfl_xor(s2, 16); s2 += __shfl_xor(s2, 32);
                    if (fq == 0) *(GAS f32x2_t*)(VSTAT + ((size_t)((u.pn - 8) * 4 + wc) * T + row) * 2) = (f32x2_t){s1, s2}; }
                asm volatile("" ::: "memory"); }
    }
};


constexpr int VT_PITCH = 272, G3_ST = 69632, G3_WS = 70656;
constexpr int G3_GB = 105472, G3_ST2 = 107520;
__device__ __forceinline__ void g3_stats(const float* VSTAT, int row0, int tid, LAS float* STb) {
    f32x2 p[32];
#pragma unroll
    for (int cg = 0; cg < 32; ++cg) p[cg] = *(const GAS f32x2*)(VSTAT + ((size_t)cg * T + row0 + tid) * 2);
    float s1 = 0.f, s2 = 0.f;
#pragma unroll
    for (int cg = 0; cg < 32; ++cg) { s1 += p[cg].x; s2 += p[cg].y; }
    const float mean = s1 * (1.f / D), var = s2 * (1.f / D) - mean * mean; STb[tid * 2] = mean; STb[tid * 2 + 1] = 1.f / sqrtf(var + LN_EPS);
}
__device__ __forceinline__ void g3_phase(Frame& F, int j) {
    F.rethread();
    LAS unsigned char* VT = F.lds; LAS float* GB = (LAS float*)(F.lds + G3_GB);
    const bf16* U = (const bf16*)(F.wsp() + WS_GU); const bf16* V = (const bf16*)(F.wsp() + WS_GV); bf16* YG = (bf16*)(F.wsp() + WS_GY); const float* VSTAT = (const float*)(F.wsp() + WS_VSTAT);
    const float* vg = F.inp(I_GVG) + (size_t)j * D; const float* vb = F.inp(I_GVB) + (size_t)j * D; const float* bs = F.inp(I_GBS) + (size_t)j * 8 * 128;
    const bf16* WS = (const bf16*)(F.wsp() + WS_WS) + (size_t)j * 8 * 128 * 128;
    const int r = F.lane & 15, q = F.lane >> 4;
    const unsigned psel = (F.lane & 1) ? 0x03020706u : 0x05040100u; const int podd = F.lane & 1;
    const int unit0 = blockIdx.x, g = unit0 & 7;
    if (unit0 < 1024) {
        if (F.tid < 128) { g3_stats(VSTAT, (unit0 >> 3) * 128, F.tid, (LAS float*)(F.lds + G3_ST));
            const float* gsrc = (F.tid < 64 ? vg : vb) + g * 256 + 4 * (F.tid & 63); *(LAS f32x4*)(GB + (F.tid < 64 ? 0 : 256) + 4 * (F.tid & 63)) = *(const GAS f32x4*)gsrc; }
        { const bf16* wsg0 = WS + (size_t)g * 128 * 128;
#pragma unroll
          for (int i = 0; i < 4; ++i) { const int p = F.tid + 512 * i; *(LAS u32x4*)(F.lds + G3_WS + (p >> 4) * VT_PITCH + (p & 15) * 16) = *(const GAS u32x4*)(wsg0 + (size_t)(p >> 4) * 128 + (p & 15) * 8); } }
    }
    u32x4 vreg[8];
    if (unit0 < 1024) {
#pragma unroll
        for (int i = 0; i < 8; ++i) { const int qq = F.tid + 512 * i, s = qq & 127, d8 = qq >> 7;
            vreg[i] = *(const GAS u32x4*)(V + (size_t)((((unsigned)(unit0 >> 3) * 8u + (unsigned)g) * 32u + (unsigned)d8) * 128u + (unsigned)s) * 8u); } }
    __syncthreads();
    int par = 0;
    for (int unit = unit0; unit < 1024; unit += F.G, par ^= 1) {
        const int row0 = (unit >> 3) * 128; const LAS float* ST = (const LAS float*)(F.lds + (par ? G3_ST2 : G3_ST));
        u32x2 ureg[8][2]; float bsv[8];
#pragma unroll
        for (int tt = 0; tt < 8; ++tt) { const int t = 16 * tt + r; const size_t off = (size_t)(row0 + t) * D + g * 256 + 32 * F.wave + 4 * q;
            ureg[tt][0] = *(const GAS u32x2*)(U + off); ureg[tt][1] = *(const GAS u32x2*)(U + off + 16); bsv[tt] = *(const GAS float*)(bs + g * 128 + t); }
#pragma unroll
        for (int i = 0; i < 8; ++i) { const int qq = F.tid + 512 * i, s = qq & 127, d0 = (qq >> 7) * 8;
            const u32x4 w = vreg[i]; const float mean = ST[s * 2], rstd = ST[s * 2 + 1];
            const f32x4 g0 = *(const LAS f32x4*)(GB + d0), g1 = *(const LAS f32x4*)(GB + d0 + 4), b0 = *(const LAS f32x4*)(GB + 256 + d0), b1 = *(const LAS f32x4*)(GB + 256 + d0 + 4);
            const float x[8] = {bf_lo(w.x), bf_hi(w.x), bf_lo(w.y), bf_hi(w.y), bf_lo(w.z), bf_hi(w.z), bf_lo(w.w), bf_hi(w.w)};
            const float gg[8] = {g0.x, g0.y, g0.z, g0.w, g1.x, g1.y, g1.z, g1.w}, bb[8] = {b0.x, b0.y, b0.z, b0.w, b1.x, b1.y, b1.z, b1.w};
            LAS unsigned char* vt = VT + (d0 + podd) * VT_PITCH + (s & ~1) * 2;
#pragma unroll
            for (int k = 0; k < 4; ++k) { const unsigned pk = cvt_pk_bf16_nop((x[2 * k] - mean) * rstd * gg[2 * k] + bb[2 * k], (x[2 * k + 1] - mean) * rstd * gg[2 * k + 1] + bb[2 * k + 1]);
                const unsigned y = (unsigned)__builtin_amdgcn_update_dpp(0, (int)pk, 0xB1, 0xf, 0xf, true); *(LAS unsigned*)(vt + (2 * k) * VT_PITCH) = __builtin_amdgcn_perm(y, pk, psel); } }
        __syncthreads();
        bf16x8 af[2][4];
#pragma unroll
        for (int dd = 0; dd < 2; ++dd)
#pragma unroll
            for (int ks = 0; ks < 4; ++ks) af[dd][ks] = *(const LAS bf16x8*)(VT + (16 * (2 * F.wave + dd) + r) * VT_PITCH + (32 * ks + 8 * q) * 2);
        if (unit + F.G < 1024) { const int un = unit + F.G;
#pragma unroll
            for (int i = 0; i < 8; ++i) { const int qq = F.tid + 512 * i, s = qq & 127, d8 = qq >> 7;
                vreg[i] = *(const GAS u32x4*)(V + (size_t)((((unsigned)(un >> 3) * 8u + (unsigned)g) * 32u + (unsigned)d8) * 128u + (unsigned)s) * 8u); }
            if (F.tid < 128) g3_stats(VSTAT, (un >> 3) * 128, F.tid, (LAS float*)(F.lds + (par ? G3_ST : G3_ST2))); }
#pragma unroll
        for (int tt = 0; tt < 8; ++tt) { bf16x8 bfr[4];
#pragma unroll
            for (int ks = 0; ks < 4; ++ks) bfr[ks] = *(const LAS bf16x8*)(F.lds + G3_WS + (16 * tt + r) * VT_PITCH + (32 * ks + 8 * q) * 2);
            f32x4 a0 = (f32x4){0.f, 0.f, 0.f, 0.f}, a1 = a0;
#pragma unroll
            for (int ks = 0; ks < 4; ++ks) { a0 = __builtin_amdgcn_mfma_f32_16x16x32_bf16(af[0][ks], bfr[ks], a0, 0, 0, 0); a1 = __builtin_amdgcn_mfma_f32_16x16x32_bf16(af[1][ks], bfr[ks], a1, 0, 0, 0); }
            const int t = 16 * tt + r; const float bias = bsv[tt]; const size_t off = (size_t)(row0 + t) * D + g * 256 + 32 * F.wave + 4 * q;
            { const u32x2 uu = ureg[tt][0]; int o_ = 0; o_ = __builtin_amdgcn_cvt_pk_fp8_f32(bf_lo(uu.x) * (a0[0] + bias), bf_hi(uu.x) * (a0[1] + bias), o_, false); o_ = __builtin_amdgcn_cvt_pk_fp8_f32(bf_lo(uu.y) * (a0[2] + bias), bf_hi(uu.y) * (a0[3] + bias), o_, true); *(GAS unsigned*)((unsigned char*)YG + off) = (unsigned)o_; }
            { const u32x2 uu = ureg[tt][1]; int o_ = 0; o_ = __builtin_amdgcn_cvt_pk_fp8_f32(bf_lo(uu.x) * (a1[0] + bias), bf_hi(uu.x) * (a1[1] + bias), o_, false); o_ = __builtin_amdgcn_cvt_pk_fp8_f32(bf_lo(uu.y) * (a1[2] + bias), bf_hi(uu.y) * (a1[3] + bias), o_, true); *(GAS unsigned*)((unsigned char*)YG + off + 16) = (unsigned)o_; }
            __builtin_amdgcn_sched_barrier(0); }
        __syncthreads();
    }
}


struct MlstmInProb : RectBase<D, MIN_MAIN> {
    bf16* Q; bf16* Kb; bf16* V; bf16* O;
    __device__ __forceinline__ void epi(const f32x4 (&acc)[2][2][4][2], const pg8::Unit& u, int wr, int wc, int fr, int fq) const {
        bf16* base; float sc = 1.f; unsigned off0, SA, SM, SB;
        const unsigned row0 = (unsigned)(u.pm * 256 + wr * 64 + fr), bb = row0 >> 12, chunk0 = (row0 >> 7) & 31u, s0 = row0 & 127u;
        if (u.pn < 4) { base = Q; sc = 0.08838834764831845f; off0 = row0 * QKW + u.pn * 256 + wc * 32 + 8 * fq; SA = 128u * QKW; SM = 16u * QKW; SB = 128u; }
        else if (u.pn < 8) { base = Kb; const unsigned hb = (unsigned)(u.pn - 4) * 2u, seg = (unsigned)(wc * 4 + fq);
            off0 = ((((bb * 8u + hb) * 32u + chunk0) * 16u + seg) * 128u + s0) * 8u; SA = 16384u; SM = 128u; SB = 524288u; }
        else if (u.pn < 16) { base = V; const unsigned h = (unsigned)(u.pn - 8), v8 = (unsigned)((wc & 1) * 4 + fq);
            off0 = (((((bb * 8u + h) * 4u + (unsigned)(wc >> 1)) * 32u + chunk0) * 8u + v8) * 128u + s0) * 8u; SA = 8192u; SM = 128u; SB = 524288u; }
        else { base = O; off0 = row0 * VW + (u.pn - 16) * 256 + wc * 32 + 8 * fq; SA = 128u * VW; SM = 16u * VW; SB = 128u; }
#pragma unroll
        for (int ai = 0; ai < 2; ++ai)
#pragma unroll
            for (int m = 0; m < 4; ++m) { bf16* rowp = base + (size_t)(off0 + ai * SA + m * SM);
#pragma unroll
                for (int bj = 0; bj < 2; ++bj) { const f32x4 v0 = acc[ai][bj][m][0] * sc, v1 = acc[ai][bj][m][1] * sc;
                    u32x4 w; w.x = cvt_pk_bf16(v0[0], v0[1]); w.y = cvt_pk_bf16(v0[2], v0[3]); w.z = cvt_pk_bf16(v1[0], v1[1]); w.w = cvt_pk_bf16(v1[2], v1[3]);
                    *(GAS u32x4*)(rowp + (size_t)(bj * SB)) = w; } }
    }
};
template <class Fn, int... I> __device__ __forceinline__ void sfor_impl(Fn&& f, std::integer_sequence<int, I...>) { (f(std::integral_constant<int, I>{}), ...); }
template <int N, class Fn> __device__ __forceinline__ void sfor(Fn&& f) { sfor_impl(static_cast<Fn&&>(f), std::make_integer_sequence<int, N>{}); }
template <int OFF> __device__ __forceinline__ bf16x8 lds_ld128(const LAS unsigned char* a) { return *(const LAS bf16x8*)(a + OFF); }
template <int OFF> __device__ __forceinline__ u32x2 lds_ld64(const LAS unsigned char* a) { return *(const LAS u32x2*)(a + OFF); }
#define LDS_LANDED10(a, b) __builtin_amdgcn_sched_barrier(0)
#define MFMA_DRAIN(vec) do { __builtin_amdgcn_sched_barrier(0); const int d_ = __builtin_amdgcn_readfirstlane(__builtin_bit_cast(int, (vec)[0])); asm volatile("" :: "s"(d_)); __builtin_amdgcn_sched_barrier(0); } while (0)
#define SFOR(n, var) sfor<n>([&](auto var##_) __attribute__((always_inline)) { constexpr int var = decltype(var##_)::value;
#define SFOR_END });
constexpr int SP = 272;
constexpr int SC_KI = 0, SC_KT = 34816, SC_VT = 69632, SC_VW = 91392, SC_CT = 113152, SC_TB = 134912, SC_TBF = 672;
__device__ __forceinline__ size_t ktile(int b, int h, int dir, int c, int j, int g) { const int cc = dir ? 31 - c : c, s = dir ? 127 - j : j; return ((size_t)((((b * 8 + h) * 32 + cc) * 16 + g) * 128 + s)) * 8; }
__device__ __forceinline__ size_t vtile(int b, int h, int dvs, int dir, int c, int j, int g) { const int cc = dir ? 31 - c : c, s = dir ? 127 - j : j; return ((size_t)(((((b * 8 + h) * 4 + dvs) * 32 + cc) * 8 + g) * 128 + s)) * 8; }
__device__ __forceinline__ int scan_row(int b, int dir, int c, int j) { return b * SEQ + (dir ? (31 - c) * 128 + (127 - j) : c * 128 + j); }
__device__ __forceinline__ float log_sigmoid(float x) {
    const float e = __expf(-fabsf(x)), u = 1.f + e;
    const float l = (u == 1.f) ? e : __logf(u) * (e * __builtin_amdgcn_rcpf(u - 1.f));
    return fminf(x, 0.f) - l;
}
template <int CTRL, int ROWM> __device__ __forceinline__ float dpp_take(float ident, float v) {
    return __builtin_bit_cast(float, __builtin_amdgcn_update_dpp(__builtin_bit_cast(int, ident), __builtin_bit_cast(int, v), CTRL, ROWM, 0xf, false)); }
__device__ __forceinline__ float wave_scan_add(float x) {
    x += dpp_take<0x111, 0xf>(0.f, x); x += dpp_take<0x112, 0xf>(0.f, x); x += dpp_take<0x114, 0xf>(0.f, x); x += dpp_take<0x118, 0xf>(0.f, x);
    x += dpp_take<0x142, 0xa>(0.f, x); x += dpp_take<0x143, 0xc>(0.f, x); return x; }
__device__ __forceinline__ float wave_scan_max(float x) {
    const float ni = -__builtin_inff();
    x = fmaxf(x, dpp_take<0x111, 0xf>(ni, x)); x = fmaxf(x, dpp_take<0x112, 0xf>(ni, x)); x = fmaxf(x, dpp_take<0x114, 0xf>(ni, x)); x = fmaxf(x, dpp_take<0x118, 0xf>(ni, x));
    x = fmaxf(x, dpp_take<0x142, 0xa>(ni, x)); x = fmaxf(x, dpp_take<0x143, 0xc>(ni, x)); return x; }
__device__ __forceinline__ void scan_gate_load(const float* GT, int b, int dir, int c, int gi, int lane, float (&gv)[4]) {
    const int t0 = scan_row(b, dir, c, 2 * lane), t1 = scan_row(b, dir, c, 2 * lane + 1);
    const GAS float* G = (const GAS float*)GT; gv[0] = G[(size_t)t0 * 32 + gi]; gv[1] = G[(size_t)t1 * 32 + gi]; gv[2] = G[(size_t)t0 * 32 + gi + 8]; gv[3] = G[(size_t)t1 * 32 + gi + 8];
}
__device__ __forceinline__ void scan_tables(LAS float* TB, const float (&gv)[4], int lane, float& m) {
    const float i0 = gv[0], i1 = gv[1], f0 = log_sigmoid(gv[2]), f1 = log_sigmoid(gv[3]);
    const float x = wave_scan_add(f0 + f1);
    const float b1 = x, b0 = x - f1, u0 = i0 - b0, u1 = i1 - b1;
    const float z = wave_scan_max(fmaxf(u0, u1));
    float ex = __shfl_up(z, 1); if (lane == 0) ex = -__builtin_inff();
    const float M0 = fmaxf(m, fmaxf(ex, u0)), M1 = fmaxf(m, z);
    const float Ml = __builtin_bit_cast(float, __builtin_amdgcn_readlane(__builtin_bit_cast(int, M1), 63)), bl = __builtin_bit_cast(float, __builtin_amdgcn_readlane(__builtin_bit_cast(int, b1), 63));
    TB[2 * lane] = u0; TB[2 * lane + 1] = u1; TB[128 + 2 * lane] = M0; TB[128 + 2 * lane + 1] = M1;
    TB[256 + 2 * lane] = __expf(-(b0 + M0)); TB[256 + 2 * lane + 1] = __expf(-(b1 + M1));
    TB[384 + 2 * lane] = __expf(u0 - Ml); TB[384 + 2 * lane + 1] = __expf(u1 - Ml);
    TB[512 + 2 * lane] = __expf(m - M0); TB[512 + 2 * lane + 1] = __expf(m - M1);
    if (lane == 0) TB[640] = __expf(m - Ml);
    m = bl + Ml;
}
__device__ __forceinline__ void m2_scan(Frame& F) {
    F.rethread();
    LAS unsigned char* L = F.lds;
    const bf16* Qg = (const bf16*)(F.wsp() + WS_MQ); const bf16* Kg = (const bf16*)(F.wsp() + WS_MK); const bf16* Vg = (const bf16*)(F.wsp() + WS_MV); const float* GT = (const float*)(F.wsp() + WS_GATES);
    const int w = F.wave, lane = F.lane, c16 = lane & 15, q = lane >> 4, tid = F.tid;
    for (int cblk = blockIdx.x; cblk < 256; cblk += F.G) {
        const int chain = (cblk & 7) * 32 + (cblk >> 3);
        const int dvs = chain & 3, dir = (chain >> 2) & 1, h = (chain >> 3) & 7, b = chain >> 6;
        bf16* Hout = (bf16*)(F.wsp() + (dir ? WS_HB : WS_HF));
        const int qcol0 = h * 128, vcol0 = h * 256 + dvs * 64, gi = 2 * dir * 8 + h;
        const LAS unsigned char* lbase = L + c16 * SP;
        const LAS unsigned char* bKI = lbase + SC_KI + 16 * q; const LAS unsigned char* bCT = lbase + SC_CT + 16 * q; const LAS unsigned char* bVT = lbase + SC_VT + 8 * q;
        const LAS unsigned char* bVW = lbase + SC_VW + 16 * q; const LAS unsigned char* bKT = lbase + SC_KT + 16 * w * SP + 16 * q;
        for (int i = tid; i < 80 * SP / 4; i += NTHREADS) ((LAS unsigned*)(L + SC_CT))[i] = 0u;
        for (int i = tid; i < 16 * SP / 4; i += NTHREADS) { ((LAS unsigned*)(L + SC_VT + 64 * SP))[i] = (i < SP / 4) ? 0x3F803F80u : 0u; ((LAS unsigned*)(L + SC_VW + 64 * SP))[i] = 0u; }
        f32x4 cacc[5];
#pragma unroll
        for (int vt = 0; vt < 5; ++vt) cacc[vt] = (f32x4){0.f, 0.f, 0.f, 0.f};
        const int nK = w < 4 ? 6 : (w < 6 ? 4 : 0), nV = nK >> 1, kbase = w < 4 ? 6 * w : (w == 4 ? 24 : 28), vbase = w < 4 ? 3 * w : (w == 4 ? 12 : 14);
        u32x4 kn[6], vn[3]; bf16x8 qn[4];
#pragma unroll
        for (int i = 0; i < 6; ++i) { kn[i] = (u32x4){0u, 0u, 0u, 0u}; if (i < nK) kn[i] = *(const GAS u32x4*)(Kg + ktile(b, h, dir, 0, 64 * (i & 1) + lane, (kbase + i) >> 1)); }
#pragma unroll
        for (int i = 0; i < 3; ++i) { vn[i] = (u32x4){0u, 0u, 0u, 0u}; if (i < nV) vn[i] = *(const GAS u32x4*)(Vg + vtile(b, h, dvs, dir, 0, 64 * ((vbase + i) & 1) + lane, (vbase + i) >> 1)); }
#pragma unroll
        for (int ks = 0; ks < 4; ++ks) qn[ks] = *(const GAS bf16x8*)(Qg + (size_t)scan_row(b, dir, 0, 16 * w + c16) * QKW + qcol0 + 32 * ks + 8 * q);
        float m_run = 0.f;
        float gv[4] = {0.f, 0.f, 0.f, 0.f};
        if (w == 0) { scan_gate_load(GT, b, dir, 0, gi, lane, gv); scan_tables((LAS float*)(L + SC_TB), gv, lane, m_run); scan_gate_load(GT, b, dir, 1, gi, lane, gv); }
        __syncthreads();
#pragma unroll 1
        for (int c = 0; c < 32; ++c) {
            const LAS float* TB = (const LAS float*)(L + SC_TB) + (c & 1) * SC_TBF;
            bf16x8 qf[4];
#pragma unroll
            for (int ks = 0; ks < 4; ++ks) qf[ks] = qn[ks];
            const unsigned psel = (lane & 1) ? 0x03020706u : 0x05040100u; const int podd = lane & 1;
#pragma unroll
            for (int i = 0; i < 6; ++i) if (i < nK) { const int s = 64 * (i & 1) + lane, d8 = (kbase + i) >> 1; *(LAS u32x4*)(L + SC_KI + s * SP + d8 * 16) = kn[i]; }
#pragma unroll
            for (int i = 0; i < 3; ++i) if (i < nV) { const int s = 64 * ((vbase + i) & 1) + lane, v8 = (vbase + i) >> 1; const u32x4 vv = vn[i];
                LAS unsigned char* vt = L + SC_VT + (8 * v8 + podd) * SP + (s & ~1) * 2; const unsigned ww[4] = {vv.x, vv.y, vv.z, vv.w};
#pragma unroll
                for (int e = 0; e < 4; ++e) { const unsigned y = (unsigned)__builtin_amdgcn_update_dpp(0, (int)ww[e], 0xB1, 0xf, 0xf, true); *(LAS unsigned*)(vt + (2 * e) * SP) = __builtin_amdgcn_perm(y, ww[e], psel); } }
            __syncthreads();
#pragma unroll
            for (int i = 0; i < 6; ++i) if (i < nK) { const int s = 64 * (i & 1) + lane, d8 = (kbase + i) >> 1; const u32x4 kv = kn[i];
                LAS unsigned char* kt = L + SC_KT + (8 * d8 + podd) * SP + (s & ~1) * 2; const unsigned kw[4] = {kv.x, kv.y, kv.z, kv.w};
#pragma unroll
                for (int e = 0; e < 4; ++e) { const unsigned y = (unsigned)__builtin_amdgcn_update_dpp(0, (int)kw[e], 0xB1, 0xf, 0xf, true); *(LAS unsigned*)(kt + (2 * e) * SP) = __builtin_amdgcn_perm(y, kw[e], psel); } }
#pragma unroll
            for (int i = 0; i < 3; ++i) if (i < nV) { const int s = 64 * ((vbase + i) & 1) + lane, v8 = (vbase + i) >> 1; const u32x4 vv = vn[i]; const float wk = TB[384 + s];
                LAS unsigned char* vw = L + SC_VW + (8 * v8 + podd) * SP + (s & ~1) * 2; const unsigned ww[4] = {vv.x, vv.y, vv.z, vv.w};
#pragma unroll
                for (int e = 0; e < 4; ++e) { const unsigned sc = cvt_pk_bf16_nop(bf_lo(ww[e]) * wk, bf_hi(ww[e]) * wk); const unsigned ys = (unsigned)__builtin_amdgcn_update_dpp(0, (int)sc, 0xB1, 0xf, 0xf, true);
                    *(LAS unsigned*)(vw + (2 * e) * SP) = __builtin_amdgcn_perm(ys, sc, psel); } }
            if (tid < 128) *(LAS unsigned short*)(L + SC_VW + 64 * SP + tid * 2) = (unsigned short)f2bf(TB[384 + tid]);
            if (c + 1 < 32) {
                const int cc1 = dir ? 30 - c : c + 1;
                const char* KB = (const char*)Kg + (size_t)(((b * 8 + h) * 32 + cc1)) * 32768;
                const char* VB = (const char*)Vg + (size_t)((((b * 8 + h) * 4 + dvs) * 32 + cc1)) * 16384;
                const char* QB = (const char*)Qg + ((size_t)(b * SEQ + cc1 * 128) * QKW + qcol0) * 2;
                const unsigned lp = 16u * (unsigned)(dir ? 63 - lane : lane);
#pragma unroll
                for (int i = 0; i < 6; ++i) if (i < nK) { const int n = kbase + i, hf = n & 1; kn[i] = *(const GAS u32x4*)(KB + ((unsigned)((n >> 1) * 2048 + (dir ? 1 - hf : hf) * 1024) + lp)); }
#pragma unroll
                for (int i = 0; i < 3; ++i) if (i < nV) { const int n = vbase + i, hf = n & 1; vn[i] = *(const GAS u32x4*)(VB + ((unsigned)((n >> 1) * 2048 + (dir ? 1 - hf : hf) * 1024) + lp)); }
                const unsigned qo = (unsigned)((dir ? 127 - (16 * w + c16) : 16 * w + c16) * (QKW * 2) + 16 * q);
#pragma unroll
                for (int ks = 0; ks < 4; ++ks) qn[ks] = *(const GAS bf16x8*)(QB + (qo + 64u * ks));
            }
            if (w == 0 && c + 1 < 32) { scan_tables((LAS float*)(L + SC_TB) + ((c + 1) & 1) * SC_TBF, gv, lane, m_run); if (c + 2 < 32) scan_gate_load(GT, b, dir, c + 2, gi, lane, gv); }
            const float Mj = TB[128 + 16 * w + c16], iscj = TB[512 + 16 * w + c16], emtj = TB[256 + 16 * w + c16];
            const LAS unsigned char* bTB = (const LAS unsigned char*)TB + 16 * q;
            f32x4 ad[5], ac[5];
#pragma unroll
            for (int vt = 0; vt < 5; ++vt) { ad[vt] = (f32x4){0.f, 0.f, 0.f, 0.f}; ac[vt] = ad[vt]; }
            SFOR(2, kh) bf16x8 r0[5], r1[5];
                SFOR(5, vt) r0[vt] = lds_ld128<16 * vt * SP + 128 * kh>(bCT); r1[vt] = lds_ld128<16 * vt * SP + 128 * kh + 64>(bCT); SFOR_END
                LDS_LANDED10(r0, r1);
#pragma unroll
                for (int vt = 0; vt < 5; ++vt) ad[vt] = __builtin_amdgcn_mfma_f32_16x16x32_bf16(r0[vt], qf[2 * kh], ad[vt], 0, 0, 0);
#pragma unroll
                for (int vt = 0; vt < 5; ++vt) ad[vt] = __builtin_amdgcn_mfma_f32_16x16x32_bf16(r1[vt], qf[2 * kh + 1], ad[vt], 0, 0, 0);
                MFMA_DRAIN(ad[4]);
            SFOR_END
            bf16x8 pf[4];
            SFOR(4, kp) u32x4 t4 = (u32x4){0u, 0u, 0u, 0u};
                if (2 * kp <= w) {
                    bf16x8 a0[5], a1[5];
                    SFOR(4, ks) a0[ks] = lds_ld128<32 * kp * SP + 64 * ks>(bKI); a1[ks] = lds_ld128<(32 * kp + 16) * SP + 64 * ks>(bKI); SFOR_END
                    a0[4] = lds_ld128<32 * kp * 4>(bTB); a1[4] = lds_ld128<(32 * kp + 16) * 4>(bTB);
                    LDS_LANDED10(a0, a1);
                    const f32x4 ua = __builtin_bit_cast(f32x4, a0[4]), ub = __builtin_bit_cast(f32x4, a1[4]);
                    f32x4 s0 = (f32x4){0.f, 0.f, 0.f, 0.f}, s1 = s0;
#pragma unroll
                    for (int ks = 0; ks < 4; ++ks) { s0 = __builtin_amdgcn_mfma_f32_16x16x32_bf16(a0[ks], qf[ks], s0, 0, 0, 0); s1 = __builtin_amdgcn_mfma_f32_16x16x32_bf16(a1[ks], qf[ks], s1, 0, 0, 0); }
                    float p0[4], p1[4]; const int j = 16 * w + c16;
#pragma unroll
                    for (int i = 0; i < 4; ++i) { const int s = 32 * kp + 4 * q + i; p0[i] = (s <= j) ? s0[i] * __expf(ua[i] - Mj) : 0.f; p1[i] = (s + 16 <= j) ? s1[i] * __expf(ub[i] - Mj) : 0.f; }
                    t4.x = cvt_pk_bf16(p0[0], p0[1]); t4.y = cvt_pk_bf16(p0[2], p0[3]); t4.z = cvt_pk_bf16(p1[0], p1[1]); t4.w = cvt_pk_bf16(p1[2], p1[3]); }
                pf[kp] = __builtin_bit_cast(bf16x8, t4);
            SFOR_END
            SFOR(4, kp) if (2 * kp <= w) {
                u32x2 lo[5], hi[5];
                SFOR(5, vt) lo[vt] = lds_ld64<16 * vt * SP + 64 * kp>(bVT); hi[vt] = lds_ld64<16 * vt * SP + 64 * kp + 32>(bVT); SFOR_END
                LDS_LANDED10(lo, hi);
#pragma unroll
                for (int vt = 0; vt < 5; ++vt) { u32x4 t4; t4.x = lo[vt].x; t4.y = lo[vt].y; t4.z = hi[vt].x; t4.w = hi[vt].y; ac[vt] = __builtin_amdgcn_mfma_f32_16x16x32_bf16(__builtin_bit_cast(bf16x8, t4), pf[kp], ac[vt], 0, 0, 0); }
                MFMA_DRAIN(ac[4]); }
            SFOR_END
            f32x4 num[5];
#pragma unroll
            for (int vt = 0; vt < 5; ++vt) num[vt] = ac[vt] + ad[vt] * iscj;
            { const float den = __shfl(num[4][0], c16); const float inv = 1.f / fmaxf(fabsf(den), emtj);
              bf16* hrow = Hout + (size_t)scan_row(b, dir, c, 16 * w + c16) * VW + vcol0 + 4 * q;
#pragma unroll
              for (int vt = 0; vt < 4; ++vt) { u32x2 o; o.x = cvt_pk_bf16(num[vt][0] * inv, num[vt][1] * inv); o.y = cvt_pk_bf16(num[vt][2] * inv, num[vt][3] * inv); *(GAS u32x2*)(hrow + 16 * vt) = o; } }
            __syncthreads();
            { const float decay = TB[640];
#pragma unroll
              for (int vt = 0; vt < 5; ++vt) cacc[vt] = cacc[vt] * decay;
              SFOR(2, kh) bf16x8 b0[5], b1[5], ka0, ka1;
                  ka0 = lds_ld128<128 * kh>(bKT); ka1 = lds_ld128<128 * kh + 64>(bKT);
                  SFOR(5, vt) b0[vt] = lds_ld128<16 * vt * SP + 128 * kh>(bVW); b1[vt] = lds_ld128<16 * vt * SP + 128 * kh + 64>(bVW); SFOR_END
                  LDS_LANDED10(b0, b1);
#pragma unroll
                  for (int vt = 0; vt < 5; ++vt) cacc[vt] = __builtin_amdgcn_mfma_f32_16x16x32_bf16(ka0, b0[vt], cacc[vt], 0, 0, 0);
#pragma unroll
                  for (int vt = 0; vt < 5; ++vt) cacc[vt] = __builtin_amdgcn_mfma_f32_16x16x32_bf16(ka1, b1[vt], cacc[vt], 0, 0, 0);
                  MFMA_DRAIN(cacc[4]);
              SFOR_END
#pragma unroll
              for (int vt = 0; vt < 5; ++vt) { u32x2 o; o.x = cvt_pk_bf16(cacc[vt][0], cacc[vt][1]); o.y = cvt_pk_bf16(cacc[vt][2], cacc[vt][3]); *(LAS u32x2*)(L + SC_CT + (16 * vt + c16) * SP + (16 * w + 4 * q) * 2) = o; } }
            __syncthreads();
        }
    }
}
__device__ __forceinline__ float half_wave_sum(float x) {
    x += __builtin_bit_cast(float, __builtin_amdgcn_update_dpp(0, __builtin_bit_cast(int, x), 0xB1, 0xf, 0xf, true));
    x += __builtin_bit_cast(float, __builtin_amdgcn_update_dpp(0, __builtin_bit_cast(int, x), 0x4E, 0xf, 0xf, true));
    x += __builtin_bit_cast(float, __builtin_amdgcn_update_dpp(0, __builtin_bit_cast(int, x), 0x141, 0xf, 0xf, true));
    x += __builtin_bit_cast(float, __builtin_amdgcn_update_dpp(0, __builtin_bit_cast(int, x), 0x140, 0xf, 0xf, true));
    return x + __shfl_xor(x, 16);
}
__device__ __forceinline__ void m3_combine(Frame& F, int j) {
    F.rethread();
    const bf16* HF = (const bf16*)(F.wsp() + WS_HF); const bf16* HB = (const bf16*)(F.wsp() + WS_HB); const bf16* O = (const bf16*)(F.wsp() + WS_MO); bf16* HG = (bf16*)(F.wsp() + WS_HG);
    float g[32]; load_lane_vec32(F.inp(I_MNG) + (size_t)j * VW, F.lane, g);
    const int t0 = blockIdx.x * NWAVES + F.wave, tstep = F.G * NWAVES;
    u32x4 ra[4], rb[4], ro[4];
#pragma unroll
    for (int jj = 0; jj < 4; ++jj) { ra[jj] = *(const GAS u32x4*)(HF + (size_t)t0 * VW + 8 * F.lane + 512 * jj); rb[jj] = *(const GAS u32x4*)(HB + (size_t)t0 * VW + 8 * F.lane + 512 * jj); ro[jj] = *(const GAS u32x4*)(O + (size_t)t0 * VW + 8 * F.lane + 512 * jj); }
    for (int t = t0; t < T; t += tstep) {
        float a[32], o[32];
#pragma unroll
        for (int jj = 0; jj < 4; ++jj) { const unsigned wa[4] = {ra[jj].x, ra[jj].y, ra[jj].z, ra[jj].w}, wb[4] = {rb[jj].x, rb[jj].y, rb[jj].z, rb[jj].w}, wo[4] = {ro[jj].x, ro[jj].y, ro[jj].z, ro[jj].w};
#pragma unroll
            for (int e = 0; e < 4; ++e) { a[8 * jj + 2 * e] = bf_lo(wa[e]) + bf_lo(wb[e]); a[8 * jj + 2 * e + 1] = bf_hi(wa[e]) + bf_hi(wb[e]); o[8 * jj + 2 * e] = bf_lo(wo[e]); o[8 * jj + 2 * e + 1] = bf_hi(wo[e]); } }
        if (t + tstep < T) { const size_t rn = (size_t)(t + tstep) * VW + 8 * F.lane;
#pragma unroll
            for (int jj = 0; jj < 4; ++jj) { ra[jj] = *(const GAS u32x4*)(HF + rn + 512 * jj); rb[jj] = *(const GAS u32x4*)(HB + rn + 512 * jj); ro[jj] = *(const GAS u32x4*)(O + rn + 512 * jj); } }
#pragma unroll
        for (int jj = 0; jj < 4; ++jj) { float s = 0.f;
#pragma unroll
            for (int e = 0; e < 8; ++e) s += a[8 * jj + e];
            const float mean = half_wave_sum(s) * (1.f / 256.f); float s2 = 0.f;
#pragma unroll
            for (int e = 0; e < 8; ++e) { a[8 * jj + e] -= mean; s2 += a[8 * jj + e] * a[8 * jj + e]; }
            const float rstd = 1.f / sqrtf(half_wave_sum(s2) * (1.f / 256.f) + LN_EPS);
#pragma unroll
            for (int e = 0; e < 8; ++e) a[8 * jj + e] = a[8 * jj + e] * rstd * g[8 * jj + e] * __builtin_amdgcn_rcpf(1.f + __expf(-o[8 * jj + e])); }
        { unsigned char* h8 = (unsigned char*)HG + (size_t)t * VW;
#pragma unroll
          for (int jj = 0; jj < 4; ++jj) { int a_ = 0, b_ = 0; a_ = __builtin_amdgcn_cvt_pk_fp8_f32(a[8 * jj], a[8 * jj + 1], a_, false); a_ = __builtin_amdgcn_cvt_pk_fp8_f32(a[8 * jj + 2], a[8 * jj + 3], a_, true);
              b_ = __builtin_amdgcn_cvt_pk_fp8_f32(a[8 * jj + 4], a[8 * jj + 5], b_, false); b_ = __builtin_amdgcn_cvt_pk_fp8_f32(a[8 * jj + 6], a[8 * jj + 7], b_, true);
              *(GAS u32x2*)(h8 + 8 * F.lane + 512 * jj) = (u32x2){(unsigned)a_, (unsigned)b_}; } }
    }
}

struct MoeOrderBase {
    LAS unsigned* X; int G, c, NT;
    __device__ __forceinline__ bool next_(int i, pg8::Unit& u) const {
        const int ntiles = (int)X[XW_NTILES], nwg = ntiles * NT; const long L = (long)i * G + c; if (L >= nwg) return false;
        const int wgid = pg8::xcd_remap((int)L, nwg); const int ti = wgid / NT; u.pn = wgid % NT;
        u.e = __builtin_amdgcn_readfirstlane((int)X[XW_TILE_E + ti]); u.pm = ti - __builtin_amdgcn_readfirstlane((int)X[XW_TPRE + u.e]); u.x = 0; return true;
    }
};
struct E1Prob : MoeOrderBase {
    static constexpr int K = D / 2; static constexpr bool PERM = true, FP8 = true; static constexpr int SCALE_B = 0x79797979;
    const unsigned char* X1; const unsigned char* Wt; const float* bgu; unsigned char* hact; const int* list;
    __device__ __forceinline__ bool next(int i, pg8::Unit& u) const { return next_(i, u); }
    __device__ __forceinline__ void bases(const pg8::Unit& u, const char*& cA, const char*& cB) const { cA = (const char*)X1; cB = (const char*)(Wt + ((size_t)u.e * 1024 + (size_t)u.pn * 256) * D); }
    __device__ __forceinline__ void avoff(const pg8::Unit& u, int tid, unsigned (&v)[2][2]) const {
        const int cnt = (int)X[XW_CNT + u.e];
#pragma unroll
        for (int i = 0; i < 2; ++i) { int R, C; pg8::stage_rc(tid * 16 + i * 8192, R, C);
#pragma unroll
            for (int h = 0; h < 2; ++h) { int idx = u.pm * 256 + h * 128 + R; idx = idx < cnt ? idx : cnt - 1;
                const int tok = __hip_atomic_load((const GAS int*)list + ((size_t)u.e * CAP + idx), RLX_AGENT); v[h][i] = (unsigned)tok * (unsigned)D + (unsigned)C * 2u; } }
    }
    __device__ __forceinline__ void epi(const f32x4 (&acc)[2][2][4][2], const pg8::Unit& u, int wr, int wc, int fr, int fq) const {
        const unsigned slot0 = X[XW_PSTART + u.e] + (unsigned)u.pm * 256u + (unsigned)(wr * 64 + fr);
        const int hc = u.pn * 128 + wc * 32 + 8 * fq;
        const float* bg = bgu + (size_t)u.e * 1024 + hc;
#pragma unroll
        for (int ai = 0; ai < 2; ++ai)
#pragma unroll
            for (int m = 0; m < 4; ++m) { unsigned char* rowp = hact + (size_t)(slot0 + ai * 128 + m * 16) * FF + hc; float o[8];
#pragma unroll
                for (int n = 0; n < 2; ++n) { const f32x4 bgv = *(const GAS f32x4*)(bg + 4 * n), buv = *(const GAS f32x4*)(bg + 512 + 4 * n);
#pragma unroll
                    for (int j = 0; j < 4; ++j) { float gv = acc[ai][0][m][n][j] + bgv[j], uv = acc[ai][1][m][n][j] + buv[j];
                        gv = fminf(gv, 7.0f); uv = fminf(fmaxf(uv, -7.0f), 7.0f);
                        o[4 * n + j] = (uv + 1.0f) * gv * __builtin_amdgcn_rcpf(1.0f + __expf(-1.702f * gv)); } }
                asm volatile("" ::: "memory");
                u32x2 w; { int a_ = 0, b_ = 0; a_ = __builtin_amdgcn_cvt_pk_fp8_f32(o[0], o[1], a_, false); a_ = __builtin_amdgcn_cvt_pk_fp8_f32(o[2], o[3], a_, true);
                    b_ = __builtin_amdgcn_cvt_pk_fp8_f32(o[4], o[5], b_, false); b_ = __builtin_amdgcn_cvt_pk_fp8_f32(o[6], o[7], b_, true); w.x = (unsigned)a_; w.y = (unsigned)b_; }
                *(GAS u32x2*)rowp = w; }
    }
};
struct E2Prob : MoeOrderBase {
    static constexpr int K = FF / 2; static constexpr bool PERM = true, FP8 = true; static constexpr int SCALE_B = 0x79797979;
    const unsigned char* hact; const unsigned char* Wt; const float* bdn; unsigned char* Y;
    __device__ __forceinline__ bool next(int i, pg8::Unit& u) const { return next_(i, u); }
    __device__ __forceinline__ void bases(const pg8::Unit& u, const char*& cA, const char*& cB) const {
        cA = (const char*)(hact + (size_t)(X[XW_PSTART + u.e] + (unsigned)u.pm * 256u) * FF); cB = (const char*)(Wt + ((size_t)u.e * D + (size_t)u.pn * 256) * FF); }
    __device__ __forceinline__ void avoff(const pg8::Unit&, int tid, unsigned (&v)[2][2]) const {
#pragma unroll
        for (int i = 0; i < 2; ++i) { int R, C; pg8::stage_rc(tid * 16 + i * 8192, R, C);
#pragma unroll
            for (int h = 0; h < 2; ++h) v[h][i] = (unsigned)((h * 128 + R) * (FF / 2) + C) * 2u; }
    }
    __device__ __forceinline__ void epi(const f32x4 (&acc)[2][2][4][2], const pg8::Unit& u, int wr, int wc, int fr, int fq) const {
        const unsigned slot0 = X[XW_PSTART + u.e] + (unsigned)u.pm * 256u + (unsigned)(wr * 64 + fr);
        const int c0 = u.pn * 256 + wc * 32 + 8 * fq;
        const float* bp = bdn + (size_t)u.e * D + c0;
        f32x4 bv[2][2];
#pragma unroll
        for (int bj = 0; bj < 2; ++bj)
#pragma unroll
            for (int n = 0; n < 2; ++n) bv[bj][n] = *(const GAS f32x4*)(bp + bj * 128 + 4 * n);
#pragma unroll
        for (int ai = 0; ai < 2; ++ai)
#pragma unroll
            for (int m = 0; m < 4; ++m) { unsigned char* rowp = Y + (size_t)(slot0 + ai * 128 + m * 16) * D + c0;
#pragma unroll
                for (int bj = 0; bj < 2; ++bj) { const f32x4 v0 = (acc[ai][bj][m][0] + bv[bj][0]) * Y_SCALE, v1 = (acc[ai][bj][m][1] + bv[bj][1]) * Y_SCALE;
                    int a_ = 0, b_ = 0; a_ = __builtin_amdgcn_cvt_pk_fp8_f32(v0[0], v0[1], a_, false); a_ = __builtin_amdgcn_cvt_pk_fp8_f32(v0[2], v0[3], a_, true);
                    b_ = __builtin_amdgcn_cvt_pk_fp8_f32(v1[0], v1[1], b_, false); b_ = __builtin_amdgcn_cvt_pk_fp8_f32(v1[2], v1[3], b_, true);
                    *(GAS u32x2*)(rowp + bj * 128) = (u32x2){(unsigned)a_, (unsigned)b_}; } }
    }
};


#define GRID_BAR() do { XcdBarrier bar_; bar_.bar = (unsigned*)(F.ctlp() + CW_BAR); bar_.x = xb_xcc_id(); bar_.st = (volatile LAS unsigned*)(F.X + XW_BAR); F.rethread(); xcd_barrier(bar_, F.tid == 0); } while (0)
#ifndef REP_M1
#define REP_M1 1
#endif
#ifndef REP_OUT
#define REP_OUT 1
#endif
#ifndef REP_G1
#define REP_G1 1
#endif
#ifndef REP_M3
#define REP_M3 1
#endif
#ifndef REP_P0A
#define REP_P0A 1
#endif
#ifndef REP_SCAN
#define REP_SCAN 1
#endif
#ifndef REP_E1
#define REP_E1 1
#endif
#ifndef REP_E2
#define REP_E2 1
#endif
#ifndef REP_G3
#define REP_G3 1
#endif
#ifndef REP_R2
#define REP_R2 1
#endif
#ifndef FILL_E1
#define FILL_E1 20
#endif
#ifndef FILL_E2
#define FILL_E2 3
#endif
#ifndef MOE_LAYER_MASK
#define MOE_LAYER_MASK 15
#endif
template <int layer> __device__ __forceinline__ void moe_layer(Frame& F) {
    if constexpr ((layer & 1) == 1) {
        constexpr int j = layer / 2;
        for (int rep_ = 0; rep_ < REP_G1; ++rep_) {
        { GmlpInProb P; P.A = (const bf16*)(F.wsp() + WS_XB); P.Bt = (const bf16*)(F.wsp() + WS_WGI) + (size_t)j * 4096 * D; P.G = F.G; P.c = (int)blockIdx.x;
          P.bias = F.inp(I_GBIN) + (size_t)j * 4096; P.U = (bf16*)(F.wsp() + WS_GU); P.V = (bf16*)(F.wsp() + WS_GV); P.VSTAT = (float*)(F.wsp() + WS_VSTAT);
          pg8::gemm_phase<GmlpInProb, true>(F.lds, P, F.wave0); }
        GRID_BAR(); }
        for (int rep = 0; rep < REP_G3; ++rep) { g3_phase(F, j); GRID_BAR(); }
        for (int rep_ = 0; rep_ < REP_OUT; ++rep_) {
        { OutProjProb P; P.A = (const bf16*)(F.wsp() + WS_GY); P.Bt = (const bf16*)(F.wsp() + WS_WGO + (size_t)j * D * D); P.G = F.G; P.c = (int)blockIdx.x;
          P.XB = (const bf16*)(F.wsp() + WS_XB); P.PRE = (bf16*)(F.wsp() + WS_PRE);
          pg8::gemm_phase<OutProjProb, true>(F.lds, P, F.wave0); }
        GRID_BAR(); }
    } else {
        constexpr int j = layer / 2;
        for (int rep_ = 0; rep_ < REP_M1; ++rep_) {
        { MlstmInProb P; P.A = (const bf16*)(F.wsp() + WS_XB); P.Bt = (const bf16*)(F.wsp() + WS_WMI) + (size_t)j * MIN_MAIN * D; P.G = F.G; P.c = (int)blockIdx.x;
          P.Q = (bf16*)(F.wsp() + WS_MQ); P.Kb = (bf16*)(F.wsp() + WS_MK); P.V = (bf16*)(F.wsp() + WS_MV); P.O = (bf16*)(F.wsp() + WS_MO);
          pg8::gemm_phase<MlstmInProb, true>(F.lds, P, F.wave0); }
        GRID_BAR(); }
        for (int rep = 0; rep < REP_SCAN; ++rep) { m2_scan(F); GRID_BAR(); }
        for (int rep_ = 0; rep_ < REP_M3; ++rep_) { m3_combine(F, j); GRID_BAR(); }
        for (int rep_ = 0; rep_ < REP_OUT; ++rep_) {
        { OutProjProb P; P.A = (const bf16*)(F.wsp() + WS_HG); P.Bt = (const bf16*)(F.wsp() + WS_WMO + (size_t)j * D * D); P.G = F.G; P.c = (int)blockIdx.x;
          P.XB = (const bf16*)(F.wsp() + WS_XB); P.PRE = (bf16*)(F.wsp() + WS_PRE);
          pg8::gemm_phase<OutProjProb, true>(F.lds, P, F.wave0); }
        GRID_BAR(); }
    }
    r1_phase(F, layer); GRID_BAR();
    moe_tables(F, layer);
    if constexpr ((MOE_LAYER_MASK >> layer) & 1) {
    for (int rep = 0; rep < REP_E1; ++rep) {
    { E1Prob P; P.X = F.X; P.G = F.G; P.c = (int)blockIdx.x; P.NT = 4; P.X1 = (const unsigned char*)(F.wsp() + WS_X1F8); P.Wt = (const unsigned char*)(F.wsp() + WS_WGU) + (size_t)layer * 32 * 1024 * D;
      P.bgu = F.inp(I_EBGU) + (size_t)layer * 32 * 1024; P.hact = (unsigned char*)(F.wsp() + WS_HACT); P.list = (const int*)(F.wsp() + WS_LIST);
      pg8::gemm_phase<E1Prob, true>(F.lds, P, F.wave0); }
    if constexpr (layer + 1 < DEPTH) { const int nwg = (int)F.X[XW_NTILES] * 4, c = (int)blockIdx.x; const int mine = nwg > c ? (nwg - c + F.G - 1) / F.G : 0, most = (nwg + F.G - 1) / F.G;
        if (mine < most) cvt_fill(F, layer + 1, FILL_E1); }
    GRID_BAR(); }
    for (int rep = 0; rep < REP_E2; ++rep) {
    { E2Prob P; P.X = F.X; P.G = F.G; P.c = (int)blockIdx.x; P.NT = 8; P.hact = (const unsigned char*)(F.wsp() + WS_HACT); P.Wt = (const unsigned char*)(F.wsp() + WS_WDN) + (size_t)layer * 32 * D * FF;
      P.bdn = F.inp(I_EBDN) + (size_t)layer * 32 * D; P.Y = (unsigned char*)(F.wsp() + WS_Y);
      pg8::gemm_phase<E2Prob, true>(F.lds, P, F.wave0); }
    if constexpr (layer + 1 < DEPTH) { const int nwg = (int)F.X[XW_NTILES] * 8, c = (int)blockIdx.x; const int mine = nwg > c ? (nwg - c + F.G - 1) / F.G : 0, most = (nwg + F.G - 1) / F.G;
        if (mine < most) cvt_fill(F, layer + 1, FILL_E2); }
    GRID_BAR(); }
    }
    if constexpr (layer + 1 < DEPTH) cvt_fill(F, layer + 1, -1);
    for (int rep_ = 0; rep_ < REP_R2; ++rep_) {     r2_phase(F, layer, layer == DEPTH - 1, (layer + 1 < DEPTH && ((layer + 1) & 1) == 0) ? (layer + 1) / 2 : -1, ((MOE_LAYER_MASK >> layer) & 1) ? 4 : 0); GRID_BAR(); }
}

struct Args { const float* in[20]; float* out; unsigned char* ws; };
__global__ void __launch_bounds__(NTHREADS, 2) fwd(Args args) {
    extern __shared__ __attribute__((aligned(16))) unsigned char lds_raw[];
    Frame F;
    F.lds = (LAS unsigned char*)lds_raw; F.X = (LAS unsigned*)(F.lds + LDSX_OFF);
    F.tid = threadIdx.x; F.lane = F.tid & 63; F.wave = __builtin_amdgcn_readfirstlane(F.tid >> 6); F.wave0 = F.wave; F.G = gridDim.x;
    F.ws_ = args.ws;
    for (int u = F.tid; u < XW_WORDS; u += NTHREADS) F.X[u] = 0u;
    __syncthreads();
    if (F.tid == 0) {
#pragma unroll
        for (int i = 0; i < 20; ++i) { const unsigned long long p = (unsigned long long)args.in[i]; F.X[XW_INP + 2 * i] = (unsigned)p; F.X[XW_INP + 2 * i + 1] = (unsigned)(p >> 32); }
        { const unsigned long long p = (unsigned long long)args.out; F.X[XW_INP + 40] = (unsigned)p; F.X[XW_INP + 41] = (unsigned)(p >> 32); } }
    __syncthreads();
    (void)xcd_barrier_post((unsigned*)(F.ctlp() + CW_BAR), (volatile LAS unsigned*)(F.X + XW_BAR));

    for (int rep = 0; rep < REP_P0A; ++rep) { p0a_weights(F); GRID_BAR(); }
    p0b_rows(F); GRID_BAR();
#define GRID_BAR_() GRID_BAR()
    moe_layer<0>(F); moe_layer<1>(F); moe_layer<2>(F); moe_layer<3>(F);
}

extern "C" void kernel_launch(void* const* d_in, const int* in_sizes, int n_in, void* d_out, int out_size, void* d_ws, size_t ws_size, hipStream_t stream) {
    static int grid = 0;
    if (grid == 0) {
        if (n_in != 20 || out_size != T * D || ws_size < WS_END) { fprintf(stderr, "kernel_launch: unexpected shapes (n_in %d out %d ws %zu need %zu)\n", n_in, out_size, ws_size, (size_t)WS_END); grid = -1; return; }
        int dev = 0, cus = 0, per_cu = 0;
        if (hipGetDevice(&dev) != hipSuccess || hipDeviceGetAttribute(&cus, hipDeviceAttributeMultiprocessorCount, dev) != hipSuccess) { grid = -1; return; }
        if (hipFuncSetAttribute((const void*)fwd, hipFuncAttributeMaxDynamicSharedMemorySize, LDS_BYTES) != hipSuccess) { fprintf(stderr, "kernel_launch: hipFuncSetAttribute failed\n"); grid = -1; return; }
        if (hipOccupancyMaxActiveBlocksPerMultiprocessor(&per_cu, (const void*)fwd, NTHREADS, LDS_BYTES) != hipSuccess || per_cu < 1) { fprintf(stderr, "kernel_launch: occupancy query says %d\n", per_cu); }
        (void)hipGetLastError();
        grid = cus;
    }
    if (grid < 0) return;
    if (hipMemsetAsync((char*)d_ws + WS_CTL, 0, CTL_ZERO_BYTES, stream) != hipSuccess) return;
    Args a{};
    for (int i = 0; i < 20; ++i) a.in[i] = (const float*)d_in[i];
    a.out = (float*)d_out; a.ws = (unsigned char*)d_ws;
    hipLaunchKernelGGL(fwd, dim3(grid), dim3(NTHREADS), LDS_BYTES, stream, a);
    const hipError_t le = hipPeekAtLastError();
    if (le != hipSuccess) fprintf(stderr, "kernel_launch: launch failed: %s\n", hipGetErrorName(le));
}
```

```cpp
#include <utility>
#include <type_traits>
#include <hip/hip_runtime.h>
#include <cstdio>
#include <cstdint>

#define LAS __attribute__((address_space(3)))
#define GAS __attribute__((address_space(1)))
typedef unsigned short bf16;
typedef short bf16x8 __attribute__((ext_vector_type(8)));
typedef short s16x4 __attribute__((ext_vector_type(4)));
typedef float f32x4 __attribute__((ext_vector_type(4)));
typedef float f32x2 __attribute__((ext_vector_type(2)));
typedef unsigned u32x4 __attribute__((ext_vector_type(4)));
typedef unsigned u32x2 __attribute__((ext_vector_type(2)));
typedef GAS unsigned gu32;
#define RLX_AGENT __ATOMIC_RELAXED, __HIP_MEMORY_SCOPE_AGENT

constexpr int T = 16384, D = 2048, DEPTH = 4, SEQ = 4096, NBATCH = 4;
constexpr int NE = 32, TOPK = 4, FF = 512;
constexpr int HEADS = 8, DV = 256, DK = 128, QKW = 1024, VW = 2048, MIN_COLS = 6176, MIN_MAIN = 6144;
constexpr int CAP = T;
constexpr int MAXSLOT = T * TOPK + NE * 256;
constexpr float ALPHA = 1.6817928305074290f;
constexpr float LN_EPS = 1e-5f;
constexpr float Y_SCALE = 16.0f;
constexpr int NWAVES = 8, NTHREADS = 512;
#ifndef EXP_NO_MOE
#define EXP_NO_MOE 0
#endif

constexpr size_t MiB = 1u << 20;
constexpr size_t WS_CTL = 0, CTL_ZERO_BYTES = 1 * MiB;
constexpr size_t WS_WGU = 1 * MiB;
constexpr size_t WS_WDN = WS_WGU + 512 * MiB;
constexpr size_t WS_WMI = WS_WDN + 256 * MiB;
constexpr size_t WS_WMO = WS_WMI + 48 * MiB;
constexpr size_t WS_WGI = WS_WMO + 16 * MiB;
constexpr size_t WS_WGO = WS_WGI + 32 * MiB;
constexpr size_t WS_WSM = WS_WGO + 16 * MiB;
constexpr size_t WS_WG_T = WS_WSM, WS_WR_T = WS_WSM + 256 * 1024, WS_WS = WS_WSM + 768 * 1024;
constexpr size_t WS_XB = WS_WSM + 2 * MiB;
constexpr size_t WS_X1 = WS_XB + 64 * MiB;
constexpr size_t WS_PRE = WS_X1 + 64 * MiB;
constexpr size_t WS_MIX = WS_PRE + 64 * MiB;
constexpr size_t WS_HACT = WS_MIX + 384 * MiB;
constexpr size_t WS_Y = WS_HACT + 72 * MiB;
constexpr size_t WS_LIST = WS_Y + 288 * MiB;
constexpr size_t WS_TOK = WS_LIST + 2 * MiB;
constexpr size_t WS_GATES = WS_TOK + 1 * MiB;
constexpr size_t WS_X1F8 = WS_GATES + 2 * MiB;
constexpr size_t WS_END = WS_X1F8 + 32 * MiB;

constexpr size_t WS_GU = WS_MIX, WS_GV = WS_MIX + 64 * MiB, WS_GY = WS_MIX + 128 * MiB, WS_VSTAT = WS_MIX + 192 * MiB;
constexpr size_t WS_MQ = WS_MIX, WS_MK = WS_MIX + 32 * MiB, WS_MV = WS_MIX + 64 * MiB, WS_MO = WS_MIX + 128 * MiB, WS_HF = WS_MIX + 192 * MiB, WS_HB = WS_MIX + 256 * MiB, WS_HG = WS_MIX + 320 * MiB;
constexpr int CW_TMO = 0, CW_CODE = 1, CW_BAR = 4096, CW_CNT = 8192;

constexpr int RING_BYTES = 131072;
constexpr int LDS_BYTES = 163840;
constexpr int LDSX_OFF = LDS_BYTES - 4096;
constexpr int XW_BAR = 8, XW_LCNT = 64, XW_LBASE = 96, XW_CNT = 128, XW_TPRE = 160, XW_PSTART = 200, XW_NTILES = 232, XW_TILE_E = 256, XW_INP = 600, XW_WORDS = 1024;
constexpr int XT_PITCH = 4112;
constexpr int RP_PART = 66048, RP_LOG = 82944, LOGP = 36, RP_GB = 90112, RP_LOGA = 106496;

__device__ __forceinline__ unsigned f2bf(float f) { unsigned u = __builtin_bit_cast(unsigned, f); return (u + 0x7fffu + ((u >> 16) & 1u)) >> 16; }
__device__ __forceinline__ unsigned cvt_pk_bf16_nop(float lo, float hi) { unsigned r; asm volatile("v_cvt_pk_bf16_f32 %0, %1, %2\n\ts_nop 1" : "=v"(r) : "v"(lo), "v"(hi)); return r; }
__device__ __forceinline__ unsigned cvt_pk_bf16(float lo, float hi) { unsigned r; asm volatile("v_cvt_pk_bf16_f32 %0, %1, %2" : "=v"(r) : "v"(lo), "v"(hi)); return r; }
__device__ __forceinline__ float bf_lo(unsigned w) { return __builtin_bit_cast(float, w << 16); }
__device__ __forceinline__ float bf_hi(unsigned w) { return __builtin_bit_cast(float, w & 0xffff0000u); }
__device__ __forceinline__ float wave_sum(float v) {
#pragma unroll
    for (int o = 1; o < 64; o <<= 1) v += __shfl_xor(v, o);
    return v;
}
#define LDS_WAIT() asm volatile("s_waitcnt lgkmcnt(0)" ::: "memory")
#define VM_WAIT() asm volatile("s_waitcnt vmcnt(0)" ::: "memory")

namespace pg8 {
constexpr int BM = 256, BK = 64, HALF = 128, HTB = HALF * BK * 2, STAGE_BYTES = 8 * HTB, NXCD = 8, WGM = 8;
__host__ __device__ __forceinline__ int lds_byte(int r, int c) { const int st = (r >> 4) * 2 + (c >> 5), rr = r & 15, cc = c & 31, ob = rr * 64 + cc * 2; return st * 1024 + (ob ^ (((ob >> 9) & 1) << 5)); }
__host__ __device__ __forceinline__ void stage_rc(int b, int& R, int& C) { const int st = b / 1024, sb = b % 1024, swz = sb ^ (((sb >> 9) & 1) << 5); R = (st >> 1) * 16 + swz / 64; C = (st & 1) * 32 + (swz % 64) / 2; }
__host__ __device__ __forceinline__ int perm32(int rho) { const int n = rho >> 4, i = rho & 15; return 8 * (i >> 2) + 4 * n + (i & 3); }

struct Unit { int pm, pn, e, x; };
typedef int v8i_t __attribute__((ext_vector_type(8)));
typedef int v4i_t __attribute__((ext_vector_type(4)));
__device__ __forceinline__ v8i_t cat_v8(bf16x8 lo, bf16x8 hi) { return __builtin_shufflevector(__builtin_bit_cast(v4i_t, lo), __builtin_bit_cast(v4i_t, hi), 0, 1, 2, 3, 4, 5, 6, 7); }

__device__ __forceinline__ void mfma_f8_tied(f32x4& acc, v8i_t a, v8i_t b, int sa, int sb) {
    asm volatile("v_mfma_scale_f32_16x16x128_f8f6f4 %0, %1, %2, %0, %3, %4 op_sel_hi:[0,0,0]" : "+v"(acc) : "v"(a), "v"(b), "v"(sa), "v"(sb));
}
__device__ __forceinline__ int xcd_remap(int wgid, int nwg) { const int q = nwg / NXCD, r = nwg % NXCD, xcd = wgid % NXCD, off = wgid / NXCD; return (xcd < r ? xcd * (q + 1) : r * (q + 1) + (xcd - r) * q) + off; }

template <class Prob, bool ALIGN_EPI = true>
__device__ __forceinline__ void gemm_phase(LAS unsigned char* lds, const Prob& P, int wave_id) {
    int wid = wave_id; asm volatile("" : "+s"(wid)); unsigned z_ = 0u; asm volatile("" : "+v"(z_)); const int lane = (int)__builtin_amdgcn_mbcnt_hi(~0u, __builtin_amdgcn_mbcnt_lo(~0u, z_));
    const int tid = wid * 64 + lane, wr = wid >> 2, wc = wid & 3, fr = lane & 15, fq = lane >> 4;
    constexpr int K = Prob::K, nt = K / BK;
    unsigned voffB[2];
#pragma unroll
    for (int i = 0; i < 2; ++i) { int R, C; stage_rc(tid * 16 + i * 8192, R, C); const int Rb = Prob::PERM ? ((R & ~31) + perm32(R & 31)) : R;
        voffB[i] = (unsigned)(Rb * K + C) * 2u; }
    const size_t kstep = (size_t)(BK * 2);
    const size_t hstep = (size_t)HALF * K * 2;
    const unsigned ldsw = (unsigned)wid * 1024u;
    const int aoff = lds_byte(wr * 64 + fr, fq * 8), boff = lds_byte(wc * 32 + fr, fq * 8);
#define PG8_SA(b, h) (((b) * 2 + (h)) * HTB)
#define PG8_SB(b, h) ((4 + (b) * 2 + (h)) * HTB)
#define PG8_STAGE(bufoff, gbase, v0, v1) do { \
        __builtin_amdgcn_global_load_lds((const unsigned*)((const char*)(gbase) + (v0)), (LAS unsigned*)(lds + (bufoff) + ldsw), 16, 0, 0); \
        __builtin_amdgcn_global_load_lds((const unsigned*)((const char*)(gbase) + (v1)), (LAS unsigned*)(lds + (bufoff) + ldsw + 8192), 16, 0, 0); } while (0)
#define PG8_STB(bufoff, gbase) PG8_STAGE(bufoff, gbase, voffB[0], voffB[1])
#define PG8_LDA(dst, b, h) do { _Pragma("unroll") for (int m = 0; m < 4; ++m) _Pragma("unroll") for (int k = 0; k < 2; ++k) dst[m][k] = *(const LAS bf16x8*)(lds + PG8_SA(b, h) + aoff + m * 2048 + k * 1024); } while (0)
#define PG8_LDB(dst, b, h) do { _Pragma("unroll") for (int n = 0; n < 2; ++n) _Pragma("unroll") for (int k = 0; k < 2; ++k) dst[n][k] = *(const LAS bf16x8*)(lds + PG8_SB(b, h) + boff + n * 2048 + k * 1024); } while (0)
#define PG8_MMA(ai, bj, At, Bt) do { __builtin_amdgcn_s_setprio(1); \
        if constexpr (Prob::FP8) { asm volatile("s_nop 1" ::: "memory"); _Pragma("unroll") for (int m = 0; m < 4; ++m) _Pragma("unroll") for (int n = 0; n < 2; ++n) \
            mfma_f8_tied(acc[ai][bj][m][n], cat_v8(Bt[n][0], Bt[n][1]), cat_v8(At[m][0], At[m][1]), sc_w, sc_x); } \
        else { _Pragma("unroll") for (int m = 0; m < 4; ++m) _Pragma("unroll") for (int n = 0; n < 2; ++n) _Pragma("unroll") for (int k = 0; k < 2; ++k) \
            acc[ai][bj][m][n] = __builtin_amdgcn_mfma_f32_16x16x32_bf16(Bt[n][k], At[m][k], acc[ai][bj][m][n], 0, 0, 0); } \
        __builtin_amdgcn_s_setprio(0); } while (0)
#define PG8_WAIT_V(n) asm volatile("s_waitcnt vmcnt(" #n ")" ::: "memory")
#define PG8_WAIT_L(n) asm volatile("s_waitcnt lgkmcnt(" #n ")" ::: "memory")
#define PG8_BAR __builtin_amdgcn_s_barrier()
#define PG8_SCHED __builtin_amdgcn_sched_barrier(0)
    Unit cur, nxt; int ui = 0;
    if (!P.next(0, cur)) return;
    int sc_w = Prob::SCALE_B, sc_x = 0x7f7f7f7f; if constexpr (Prob::FP8) { asm volatile("" : "+v"(sc_w), "+v"(sc_x)); }
    float zf_ = 0.f; asm volatile("" : "+v"(zf_)); const f32x4 zero4 = (f32x4){zf_, zf_, zf_, zf_};
    f32x4 acc[2][2][4][2];
#pragma unroll
    for (int a = 0; a < 2; ++a)
#pragma unroll
        for (int b = 0; b < 2; ++b)
#pragma unroll
            for (int m = 0; m < 4; ++m)
#pragma unroll
                for (int n = 0; n < 2; ++n) acc[a][b][m][n] = zero4;
    bf16x8 At[4][2], B0[2][2], B1[2][2];
    const char* cA; const char* cB; unsigned va[2][2], vn[2][2];
    P.bases(cur, cA, cB); P.avoff(cur, tid, va);
    PG8_STB(PG8_SB(0, 0), cB); PG8_STB(PG8_SB(0, 1), cB + hstep); PG8_STAGE(PG8_SA(0, 0), cA, va[0][0], va[0][1]); PG8_STAGE(PG8_SA(0, 1), cA, va[1][0], va[1][1]);
    if (wr == 1) PG8_BAR;
    PG8_WAIT_V(2); PG8_BAR;
    PG8_STB(PG8_SB(1, 0), cB + kstep); PG8_STAGE(PG8_SA(1, 0), cA + kstep, va[0][0], va[0][1]); PG8_STB(PG8_SB(1, 1), cB + hstep + kstep);
    PG8_WAIT_V(6); PG8_BAR;
    for (;;) {
        const bool has_next = P.next(ui + 1, nxt);
        const char* nA = cA; const char* nB = cB;
#pragma unroll
        for (int h = 0; h < 2; ++h)
#pragma unroll
            for (int i = 0; i < 2; ++i) vn[h][i] = va[h][i];
        if (has_next) { P.bases(nxt, nA, nB); P.avoff(nxt, tid, vn); }
        for (int t = 0; t < nt; t += 2) {
            const bool last = (t == nt - 2);
            const char* a1 = cA + (size_t)(t + 1) * kstep;
            const char* a2 = last ? nA : cA + (size_t)(t + 2) * kstep; const char* b2 = last ? nB : cB + (size_t)(t + 2) * kstep;
            const char* a3 = a2 + kstep; const char* b3 = b2 + kstep;
            const unsigned s00 = last ? vn[0][0] : va[0][0], s01 = last ? vn[0][1] : va[0][1], s10 = last ? vn[1][0] : va[1][0], s11 = last ? vn[1][1] : va[1][1];
            PG8_LDB(B0, 0, 0); PG8_LDB(B1, 0, 1); PG8_SCHED; PG8_LDA(At, 0, 0); PG8_STAGE(PG8_SA(1, 1), a1, va[1][0], va[1][1]);
            PG8_WAIT_V(8); PG8_WAIT_L(0); PG8_BAR; PG8_MMA(0, 0, At, B0); PG8_MMA(0, 1, At, B1); PG8_BAR; PG8_SCHED;
            PG8_LDA(At, 0, 1); PG8_STB(PG8_SB(0, 0), b2); PG8_STB(PG8_SB(0, 1), b2 + hstep); PG8_STAGE(PG8_SA(0, 0), a2, s00, s01);
            PG8_WAIT_V(8); PG8_WAIT_L(0); PG8_BAR; PG8_MMA(1, 0, At, B0); PG8_MMA(1, 1, At, B1); PG8_BAR; PG8_SCHED;
            PG8_LDB(B0, 1, 0); PG8_LDB(B1, 1, 1); PG8_SCHED; PG8_LDA(At, 1, 0); PG8_STAGE(PG8_SA(0, 1), a2, s10, s11);
            PG8_WAIT_V(8); PG8_WAIT_L(0); PG8_BAR; PG8_MMA(0, 0, At, B0); PG8_MMA(0, 1, At, B1); PG8_BAR; PG8_SCHED;
            PG8_LDA(At, 1, 1); PG8_STB(PG8_SB(1, 0), b3); PG8_STB(PG8_SB(1, 1), b3 + hstep); PG8_STAGE(PG8_SA(1, 0), a3, s00, s01);
            PG8_WAIT_V(8); PG8_WAIT_L(0); PG8_BAR; PG8_MMA(1, 0, At, B0); PG8_MMA(1, 1, At, B1); PG8_BAR; PG8_SCHED;
        }
        if constexpr (ALIGN_EPI) { if (wr == 0) PG8_BAR; }
        if constexpr (Prob::FP8) asm volatile("s_nop 15\n\ts_nop 15" ::: "memory");
        P.epi(acc, cur, wr, wc, fr, fq);
        if (!has_next) break;
#pragma unroll
        for (int a = 0; a < 2; ++a)
#pragma unroll
            for (int b = 0; b < 2; ++b)
#pragma unroll
                for (int m = 0; m < 4; ++m)
#pragma unroll
                    for (int n = 0; n < 2; ++n) acc[a][b][m][n] = zero4;
        cur = nxt; cA = nA; cB = nB; ++ui;
#pragma unroll
        for (int h = 0; h < 2; ++h)
#pragma unroll
            for (int i = 0; i < 2; ++i) va[h][i] = vn[h][i];
        if constexpr (ALIGN_EPI) { if (wr == 1) PG8_BAR; }
    }
    PG8_WAIT_V(0);
    if constexpr (!ALIGN_EPI) { if (wr == 0) PG8_BAR; }
    PG8_BAR;
#undef PG8_SA
#undef PG8_SB
#undef PG8_STAGE
#undef PG8_STB
#undef PG8_LDA
#undef PG8_LDB
#undef PG8_MMA
#undef PG8_WAIT_V
#undef PG8_WAIT_L
#undef PG8_BAR
#undef PG8_SCHED
}
}

#define XB_TMO      128
#define XB_XCNT(j)  (256  + 64 * (j))
#define XB_XSUB(j)  (1280 + 64 * (j))
#define XB_XGEN(j)  (2304 + 64 * (j))
#define XB_TOP      3328
#define XB_TOPGEN   3392
#define XCD_BAR_WORDS 3456
#define XB_SPIN_CAP (1u << 18)
__device__ __forceinline__ unsigned xb_ld(unsigned* p)              { return __hip_atomic_load(p, __ATOMIC_RELAXED, __HIP_MEMORY_SCOPE_AGENT); }
__device__ __forceinline__ unsigned xb_add(unsigned* p, unsigned v) { return __hip_atomic_fetch_add(p, v, __ATOMIC_RELAXED, __HIP_MEMORY_SCOPE_AGENT); }
__device__ __forceinline__ unsigned xb_xcc_id() { return (unsigned)__builtin_amdgcn_s_getreg((3 << 11) | 20) & 0xFu; }
#define XB_SPIN(cond, bar) do { unsigned _sp = 0; while (cond) { __builtin_amdgcn_s_sleep(1); \
    if ((++_sp & 255u) == 0u) { if (xb_ld(&(bar)[XB_TMO])) break; if (_sp > XB_SPIN_CAP) { atomicAdd(&(bar)[XB_TMO], 1u); break; } } } } while (0)
struct XcdBarrier { unsigned* bar; unsigned x; volatile LAS unsigned* st; };
__device__ __forceinline__ XcdBarrier xcd_barrier_post(unsigned* bar, volatile LAS unsigned* st) {
    XcdBarrier b; b.bar = bar; b.x = xb_xcc_id(); b.st = st;
    if (threadIdx.x == 0) (void)xb_add(&bar[XB_XCNT(b.x)], 1u);
    return b;
}
__device__ __forceinline__ void xcd_barrier_complete(unsigned* bar, unsigned x, unsigned& nloc, unsigned& nx) {
    const unsigned G = gridDim.x * gridDim.y * gridDim.z;
    unsigned sum, cnt, mine, sp = 0u;
    for (;;) {
        sum = 0u; cnt = 0u; mine = 0u;
#pragma unroll
        for (unsigned j = 0; j < 16; ++j) { const unsigned c = xb_ld(&bar[XB_XCNT(j)]); sum += c; cnt += (c > 0u) ? 1u : 0u; mine = (j == x) ? c : mine; }
        if (sum == G) break;
        __builtin_amdgcn_s_sleep(1);
        if ((++sp & 255u) == 0u) { if (xb_ld(&bar[XB_TMO])) break; if (sp > XB_SPIN_CAP) { atomicAdd(&bar[XB_TMO], 1u); break; } }
    }
    nloc = mine > 0u ? mine : 1u; nx = cnt > 0u ? cnt : 1u;
}
__device__ __forceinline__ void xcd_barrier(const XcdBarrier& b, bool is_t0) {
    asm volatile("s_waitcnt vmcnt(0)" ::: "memory");
    __syncthreads();
    if (is_t0) {
        unsigned* bar = b.bar;
        __builtin_amdgcn_s_waitcnt(0);
        unsigned nloc = b.st[0], nx = b.st[1];
        if (nloc == 0u) { xcd_barrier_complete(bar, b.x, nloc, nx); b.st[0] = nloc; b.st[1] = nx; }
        const unsigned old = xb_add(&bar[XB_XSUB(b.x)], 1u);
        const unsigned gen = old / nloc;
        if (old + 1u == (gen + 1u) * nloc) {
            __builtin_amdgcn_fence(__ATOMIC_RELEASE, "agent");
            asm volatile("s_waitcnt vmcnt(0)" ::: "memory");
            const unsigned og = xb_add(&bar[XB_TOP], 1u);
            const unsigned tg = og / nx;
            if (og + 1u == (tg + 1u) * nx) xb_add(&bar[XB_TOPGEN], 1u);
            else XB_SPIN(xb_ld(&bar[XB_TOPGEN]) == tg, bar);
            __builtin_amdgcn_fence(__ATOMIC_ACQUIRE, "agent");
            xb_add(&bar[XB_XGEN(b.x)], 1u);
            asm volatile("s_waitcnt vmcnt(0)" ::: "memory");
        } else {
            XB_SPIN(xb_ld(&bar[XB_XGEN(b.x)]) == gen, bar);
            __builtin_amdgcn_fence(__ATOMIC_ACQUIRE, "agent");
            asm volatile("s_waitcnt vmcnt(0)" ::: "memory");
        }
    }
    __syncthreads();
}

struct Frame {
    LAS unsigned char* lds;
    LAS unsigned* X;
    unsigned char* ws_;
    int tid, lane, wave, G;
    __device__ __forceinline__ unsigned char* wsp() const { unsigned char* p = ws_; asm volatile("" : "+s"(p)); return p; }
    __device__ __forceinline__ gu32* ctlp() const { return (gu32*)(wsp() + WS_CTL); }
    __device__ __forceinline__ float* outp() const { return (float*)inp(20); }
    __device__ __forceinline__ const float* inp(int i) const { const unsigned lo = __builtin_amdgcn_readfirstlane(X[XW_INP + 2 * i]), hi = __builtin_amdgcn_readfirstlane(X[XW_INP + 2 * i + 1]);
        return (const float*)(((unsigned long long)hi << 32) | lo); }
    int wave0;
    __device__ __forceinline__ void rethread() { int w = wave0; asm volatile("" : "+s"(w)); unsigned z = 0u; asm volatile("" : "+v"(z)); const int l = (int)__builtin_amdgcn_mbcnt_hi(~0u, __builtin_amdgcn_mbcnt_lo(~0u, z)); wave = w; lane = l; tid = w * 64 + l; }
};
enum { I_X = 0, I_MWIN, I_MBG, I_MNG, I_MWOUT, I_GWIN, I_GBIN, I_GVG, I_GVB, I_GWS, I_GBS, I_GWOUT, I_RW, I_RB, I_EWGU, I_EBGU, I_EWDN, I_EBDN, I_LNG, I_LNB };

constexpr int TR_P = 65, TR_WAVE_BYTES = 64 * TR_P * 4;
__device__ __forceinline__ void tr_item64(const float* W, int N, int k0, int n0, bf16* dst, int Kd, LAS float* scr, int lane) {
    f32x4 v[16];
#pragma unroll
    for (int i = 0; i < 16; ++i) v[i] = *(const GAS f32x4*)(W + (size_t)(k0 + 4 * i + (lane >> 4)) * N + n0 + (lane & 15) * 4);
#pragma unroll
    for (int i = 0; i < 16; ++i) { LAS float* p = scr + (4 * i + (lane >> 4)) * TR_P + (lane & 15) * 4; p[0] = v[i].x; p[1] = v[i].y; p[2] = v[i].z; p[3] = v[i].w; }
    LDS_WAIT(); asm volatile("" ::: "memory");
    const int c = lane & 7;
#pragma unroll
    for (int j = 0; j < 8; ++j) { const int n = (lane >> 3) + 8 * j; const LAS float* s = scr + (8 * c) * TR_P + n;
        u32x4 o; o.x = cvt_pk_bf16(s[0 * TR_P], s[1 * TR_P]); o.y = cvt_pk_bf16(s[2 * TR_P], s[3 * TR_P]); o.z = cvt_pk_bf16(s[4 * TR_P], s[5 * TR_P]); o.w = cvt_pk_bf16(s[6 * TR_P], s[7 * TR_P]);
        *(GAS u32x4*)(dst + (size_t)n * Kd + k0 + 8 * c) = o; }
    LDS_WAIT(); asm volatile("" ::: "memory");
}
__device__ __forceinline__ void tr_item64_f8(const float* W, int N, int k0, int n0, unsigned char* dst, int Kd, LAS float* scr, int lane, float wscale = 64.f) {
    f32x4 v[16];
#pragma unroll
    for (int i = 0; i < 16; ++i) v[i] = *(const GAS f32x4*)(W + (size_t)(k0 + 4 * i + (lane >> 4)) * N + n0 + (lane & 15) * 4);
#pragma unroll
    for (int i = 0; i < 16; ++i) { LAS float* p = scr + (4 * i + (lane >> 4)) * TR_P + (lane & 15) * 4; p[0] = v[i].x; p[1] = v[i].y; p[2] = v[i].z; p[3] = v[i].w; }
    LDS_WAIT(); asm volatile("" ::: "memory");
    const int c = lane & 3;
#pragma unroll
    for (int j = 0; j < 4; ++j) { const int n = (lane >> 2) + 16 * j; const LAS float* s = scr + (16 * c) * TR_P + n; unsigned w[4];
#pragma unroll
        for (int g = 0; g < 4; ++g) { int a_ = 0; a_ = __builtin_amdgcn_cvt_pk_fp8_f32(s[(4 * g) * TR_P] * wscale, s[(4 * g + 1) * TR_P] * wscale, a_, false); a_ = __builtin_amdgcn_cvt_pk_fp8_f32(s[(4 * g + 2) * TR_P] * wscale, s[(4 * g + 3) * TR_P] * wscale, a_, true); w[g] = (unsigned)a_; }
        *(GAS u32x4*)(dst + (size_t)n * Kd + k0 + 16 * c) = (u32x4){w[0], w[1], w[2], w[3]}; }
    LDS_WAIT(); asm volatile("" ::: "memory");
}
__device__ __forceinline__ void tr_item(const float* W, int N, int k0, int n0, bf16* dst, int Kd, LAS float* scr, int lane) {
#pragma unroll 8
    for (int i = 0; i < 32; ++i) { const int kk = 2 * i + (lane >> 5); scr[kk * 33 + (lane & 31)] = W[(size_t)(k0 + kk) * N + n0 + (lane & 31)]; }
    LDS_WAIT(); asm volatile("" ::: "memory");
    const int c = lane & 7;
#pragma unroll
    for (int j = 0; j < 4; ++j) { const int n = (lane >> 3) + 8 * j; const LAS float* s = scr + (8 * c) * 33 + n;
        u32x4 o; o.x = cvt_pk_bf16(s[0 * 33], s[1 * 33]); o.y = cvt_pk_bf16(s[2 * 33], s[3 * 33]); o.z = cvt_pk_bf16(s[4 * 33], s[5 * 33]); o.w = cvt_pk_bf16(s[6 * 33], s[7 * 33]);
        *(GAS u32x4*)(dst + (size_t)n * Kd + k0 + 8 * c) = o; }
    LDS_WAIT(); asm volatile("" ::: "memory");
}

constexpr int CVT_ITEMS = 32 * 32 * 16 + 32 * 8 * 32, CW_CVT = 24576, XW_CVT = 660;
__device__ __forceinline__ void cvt_moe_item(Frame& F, int L, int idx, LAS float* scr) {
    if (idx < 32 * 512) { const int le = L * 32 + idx / 512, q = idx % 512, kb = q % 32, nb = q / 32;
        const int n0 = nb * 64, half = n0 >> 9, nn = n0 & 511, row = (nn >> 7) * 256 + half * 128 + (nn & 127);
        tr_item64_f8(F.inp(I_EWGU) + (size_t)le * D * 1024, 1024, kb * 64, n0, (unsigned char*)(F.wsp() + WS_WGU) + ((size_t)le * 1024 + row) * D, D, scr, F.lane); }
    else { const int r = idx - 32 * 512; const int le = L * 32 + r / 256, q = r % 256, kb = q % 8, nb = q / 8;
        tr_item64_f8(F.inp(I_EWDN) + (size_t)le * FF * D, D, kb * 64, nb * 64, (unsigned char*)(F.wsp() + WS_WDN) + ((size_t)le * D + nb * 64) * FF, FF, scr, F.lane); }
}
__device__ __forceinline__ void cvt_fill(Frame& F, int L, int max_batches) {
    F.rethread();
    LAS float* scr = (LAS float*)(F.lds + F.wave * TR_WAVE_BYTES);
    gu32* ctr = F.ctlp() + CW_CVT + L * 64;
#pragma unroll 1
    for (int bt = 0; max_batches < 0 || bt < max_batches; ++bt) {
        if (F.tid == 0) F.X[XW_CVT] = __hip_atomic_fetch_add(ctr, 8u, RLX_AGENT);
        __syncthreads();
        const int base = (int)F.X[XW_CVT];
        __syncthreads();
        if (base >= CVT_ITEMS) break;
        const int idx = base + F.wave; if (idx < CVT_ITEMS) cvt_moe_item(F, L, idx, scr);
    }
    __syncthreads();
}
constexpr int P0_S0 = 2 * 32 * 96, P0_S1 = 2 * 32 * 32, P0_S2 = 2 * 32 * 64, P0_S3 = 2 * 32 * 32, P0_NI64 = P0_S0 + P0_S1 + P0_S2 + P0_S3 + CVT_ITEMS;
__device__ __forceinline__ void p0a_decode(Frame& F, int it, const float*& src, int& N, unsigned char*& dst, int& Kd, int& f8, float& scale) {
    int r = it;
    if (r < P0_S0) { const int j = r / (32 * 96), q = r % (32 * 96), kb = q % 32, nb = q / 32;
        src = F.inp(I_MWIN) + (size_t)j * D * MIN_COLS + (size_t)(kb * 64) * MIN_COLS + nb * 64; N = MIN_COLS; dst = (unsigned char*)((bf16*)(F.wsp() + WS_WMI) + ((size_t)j * MIN_MAIN + nb * 64) * D + kb * 64); Kd = D; f8 = 0; scale = 1.f; return; } r -= P0_S0;
    if (r < P0_S1) { const int j = r / 1024, q = r % 1024, kb = q % 32, nb = q / 32;
        src = F.inp(I_MWOUT) + (size_t)j * D * D + (size_t)(kb * 64) * D + nb * 64; N = D; dst = (unsigned char*)(F.wsp() + WS_WMO) + ((size_t)j * D + nb * 64) * D + kb * 64; Kd = D; f8 = 1; scale = 128.f; return; } r -= P0_S1;
    if (r < P0_S2) { const int j = r / 2048, q = r % 2048, kb = q % 32, nb = q / 32;
        src = F.inp(I_GWIN) + (size_t)j * D * 4096 + (size_t)(kb * 64) * 4096 + nb * 64; N = 4096; dst = (unsigned char*)((bf16*)(F.wsp() + WS_WGI) + ((size_t)j * 4096 + nb * 64) * D + kb * 64); Kd = D; f8 = 0; scale = 1.f; return; } r -= P0_S2;
    if (r < P0_S3) { const int j = r / 1024, q = r % 1024, kb = q % 32, nb = q / 32;
        src = F.inp(I_GWOUT) + (size_t)j * D * D + (size_t)(kb * 64) * D + nb * 64; N = D; dst = (unsigned char*)(F.wsp() + WS_WGO) + ((size_t)j * D + nb * 64) * D + kb * 64; Kd = D; f8 = 1; scale = 128.f; return; } r -= P0_S3;
    f8 = 1; scale = 64.f;
    if (r < 32 * 512) { const int le = r / 512, q = r % 512, kb = q % 32, nb = q / 32; const int n0 = nb * 64, half = n0 >> 9, nn = n0 & 511, row = (nn >> 7) * 256 + half * 128 + (nn & 127);
        src = F.inp(I_EWGU) + (size_t)le * D * 1024 + (size_t)(kb * 64) * 1024 + n0; N = 1024; dst = (unsigned char*)(F.wsp() + WS_WGU) + ((size_t)le * 1024 + row) * D + kb * 64; Kd = D; }
    else { r -= 32 * 512; const int le = r / 256, q = r % 256, kb = q % 8, nb = q / 8;
        src = F.inp(I_EWDN) + (size_t)le * FF * D + (size_t)(kb * 64) * D + nb * 64; N = D; dst = (unsigned char*)(F.wsp() + WS_WDN) + ((size_t)le * D + nb * 64) * FF + kb * 64; Kd = FF; }
}
__device__ __forceinline__ void tr_load64(const float* src, int N, int lane, f32x4 (&v)[16]) {
#pragma unroll
    for (int i = 0; i < 16; ++i) v[i] = *(const GAS f32x4*)(src + (size_t)(4 * i + (lane >> 4)) * N + (lane & 15) * 4);
}
__device__ __forceinline__ void tr_finish64(const f32x4 (&v)[16], unsigned char* dst, int Kd, int f8, float wscale, LAS float* scr, int lane) {
#pragma unroll
    for (int i = 0; i < 16; ++i) { LAS float* p = scr + (4 * i + (lane >> 4)) * TR_P + (lane & 15) * 4; p[0] = v[i].x; p[1] = v[i].y; p[2] = v[i].z; p[3] = v[i].w; }
    LDS_WAIT(); asm volatile("" ::: "memory");
    if (f8) { const int c = lane & 3;
#pragma unroll
        for (int j = 0; j < 4; ++j) { const int n = (lane >> 2) + 16 * j; const LAS float* s = scr + (16 * c) * TR_P + n; unsigned w[4];
#pragma unroll
            for (int g = 0; g < 4; ++g) { int a_ = 0; a_ = __builtin_amdgcn_cvt_pk_fp8_f32(s[(4 * g) * TR_P] * wscale, s[(4 * g + 1) * TR_P] * wscale, a_, false); a_ = __builtin_amdgcn_cvt_pk_fp8_f32(s[(4 * g + 2) * TR_P] * wscale, s[(4 * g + 3) * TR_P] * wscale, a_, true); w[g] = (unsigned)a_; }
            *(GAS u32x4*)(dst + (size_t)n * Kd + 16 * c) = (u32x4){w[0], w[1], w[2], w[3]}; } }
    else { const int c = lane & 7;
#pragma unroll
        for (int j = 0; j < 8; ++j) { const int n = (lane >> 3) + 8 * j; const LAS float* s = scr + (8 * c) * TR_P + n;
            u32x4 o; o.x = cvt_pk_bf16(s[0 * TR_P], s[1 * TR_P]); o.y = cvt_pk_bf16(s[2 * TR_P], s[3 * TR_P]); o.z = cvt_pk_bf16(s[4 * TR_P], s[5 * TR_P]); o.w = cvt_pk_bf16(s[6 * TR_P], s[7 * TR_P]);
            *(GAS u32x4*)((bf16*)dst + (size_t)n * Kd + 8 * c) = o; } }
    LDS_WAIT(); asm volatile("" ::: "memory");
}
__device__ __forceinline__ void p0a_weights(Frame& F) {
    F.rethread();
    LAS float* scr = (LAS float*)(F.lds + F.wave * TR_WAVE_BYTES);
    const int gw = blockIdx.x * NWAVES + F.wave, NGW = F.G * NWAVES;
    { f32x4 va[16], vb[16]; const float* sA; const float* sB; unsigned char* dA; unsigned char* dB; int nA, nB, kA, kB, fA, fB; float cA, cB;
      int it = gw;
      if (it < P0_NI64) { p0a_decode(F, it, sA, nA, dA, kA, fA, cA); tr_load64(sA, nA, F.lane, va);
#pragma unroll 1
        for (;;) {
            const bool haveB = it + NGW < P0_NI64; p0a_decode(F, haveB ? it + NGW : it, sB, nB, dB, kB, fB, cB); tr_load64(sB, nB, F.lane, vb);
            tr_finish64(va, dA, kA, fA, cA, scr, F.lane);
            if (!haveB) break;
            const bool haveA = it + 2 * NGW < P0_NI64; p0a_decode(F, haveA ? it + 2 * NGW : it + NGW, sA, nA, dA, kA, fA, cA); tr_load64(sA, nA, F.lane, va);
            tr_finish64(vb, dB, kB, fB, cB, scr, F.lane);
            if (!haveA) break;
            it += 2 * NGW; } } }
    { constexpr int SG = 2 * 32, S4 = 4 * 32;
      for (int it = gw; it < SG + S4; it += NGW) { int r = it;
        if (r < SG) { const int j = r / 32, kb = r % 32;
            tr_item(F.inp(I_MWIN) + (size_t)j * D * MIN_COLS, MIN_COLS, kb * 64, MIN_MAIN, (bf16*)(F.wsp() + WS_WG_T) + (size_t)j * 32 * D, D, scr, F.lane); continue; } r -= SG;
        { const int l = r / 32, kb = r % 32;
            tr_item(F.inp(I_RW) + (size_t)l * D * NE, NE, kb * 64, 0, (bf16*)(F.wsp() + WS_WR_T) + (size_t)l * 32 * D, D, scr, F.lane); } } }
    { const float* src = F.inp(I_GWS); bf16* dst = (bf16*)(F.wsp() + WS_WS); const int n4 = 2 * 8 * 128 * 128 / 4;
      for (int i = blockIdx.x * NTHREADS + F.tid; i < n4; i += F.G * NTHREADS) { const f32x4 v = ((const GAS f32x4*)src)[i]; u32x2 o; o.x = cvt_pk_bf16(v.x, v.y); o.y = cvt_pk_bf16(v.z, v.w); ((GAS u32x2*)dst)[i] = o; } }
}

__device__ __forceinline__ void skinny16(Frame& F, const bf16* WT, const float* bias) {
    LAS unsigned char* XT = F.lds; LAS float* PART = (LAS float*)(F.lds + RP_PART); LAS float* LOG = (LAS float*)(F.lds + RP_LOG);
    const int r = F.lane & 15, q = F.lane >> 4;
    float zf_ = 0.f; asm volatile("" : "+v"(zf_)); f32x4 acc0 = (f32x4){zf_, zf_, zf_, zf_}, acc1 = acc0;
#pragma unroll
    for (int ks = 0; ks < 8; ++ks) {
        const int k0 = F.wave * 256 + ks * 32 + 8 * q;
        const bf16x8 a = *(const LAS bf16x8*)(XT + r * XT_PITCH + k0 * 2);
        const bf16x8 b0 = *(const GAS bf16x8*)(WT + (size_t)r * D + k0);
        const bf16x8 b1 = *(const GAS bf16x8*)(WT + (size_t)(16 + r) * D + k0);
        acc0 = __builtin_amdgcn_mfma_f32_16x16x32_bf16(a, b0, acc0, 0, 0, 0);
        acc1 = __builtin_amdgcn_mfma_f32_16x16x32_bf16(a, b1, acc1, 0, 0, 0);
    }
#pragma unroll
    for (int i = 0; i < 4; ++i) { PART[(F.wave * 16 + 4 * q + i) * 33 + r] = acc0[i]; PART[(F.wave * 16 + 4 * q + i) * 33 + 16 + r] = acc1[i]; }
    __syncthreads();
    { const int row = F.tid >> 5, e = F.tid & 31; float s = bias[e];
#pragma unroll
      for (int w = 0; w < 8; ++w) s += PART[(w * 16 + row) * 33 + e];
      LOG[row * LOGP + e] = s; }
    __syncthreads();
}
__device__ __forceinline__ void load_lane_vec32(const float* p, int lane, float (&v)[32]) {
#pragma unroll
    for (int j = 0; j < 4; ++j) { const f32x4 a = *(const GAS f32x4*)(p + 8 * lane + 512 * j), b = *(const GAS f32x4*)(p + 8 * lane + 512 * j + 4);
        v[8 * j + 0] = a.x; v[8 * j + 1] = a.y; v[8 * j + 2] = a.z; v[8 * j + 3] = a.w; v[8 * j + 4] = b.x; v[8 * j + 5] = b.y; v[8 * j + 6] = b.z; v[8 * j + 7] = b.w; }
}
__device__ __forceinline__ void load_row_bf16(const bf16* row, int lane, float (&v)[32]) {
#pragma unroll
    for (int j = 0; j < 4; ++j) { const u32x4 w = *(const GAS u32x4*)(row + 8 * lane + 512 * j);
        v[8 * j + 0] = bf_lo(w.x); v[8 * j + 1] = bf_hi(w.x); v[8 * j + 2] = bf_lo(w.y); v[8 * j + 3] = bf_hi(w.y); v[8 * j + 4] = bf_lo(w.z); v[8 * j + 5] = bf_hi(w.z); v[8 * j + 6] = bf_lo(w.w); v[8 * j + 7] = bf_hi(w.w); }
}
__device__ __forceinline__ void layer_norm32(float (&v)[32], const float (&g)[32], const float (&b)[32]) {
    float s = 0.f;
#pragma unroll
    for (int i = 0; i < 32; ++i) s += v[i];
    const float mean = wave_sum(s) * (1.f / D); float s2 = 0.f;
#pragma unroll
    for (int i = 0; i < 32; ++i) { v[i] -= mean; s2 += v[i] * v[i]; }
    const float rstd = 1.f / sqrtf(wave_sum(s2) * (1.f / D) + LN_EPS);
#pragma unroll
    for (int i = 0; i < 32; ++i) v[i] = v[i] * rstd * g[i] + b[i];
}
__device__ __forceinline__ void layer_norm32_lds(float (&v)[32], const LAS float* GL, const LAS float* BL, int lane) {
    float s = 0.f;
#pragma unroll
    for (int i = 0; i < 32; ++i) s += v[i];
    const float mean = wave_sum(s) * (1.f / D); float s2 = 0.f;
#pragma unroll
    for (int i = 0; i < 32; ++i) { v[i] -= mean; s2 += v[i] * v[i]; }
    const float rstd = 1.f / sqrtf(wave_sum(s2) * (1.f / D) + LN_EPS);
#pragma unroll
    for (int j = 0; j < 4; ++j) { const f32x4 g0 = *(const LAS f32x4*)(GL + 8 * lane + 512 * j), g1 = *(const LAS f32x4*)(GL + 8 * lane + 512 * j + 4), b0 = *(const LAS f32x4*)(BL + 8 * lane + 512 * j), b1 = *(const LAS f32x4*)(BL + 8 * lane + 512 * j + 4);
        v[8 * j + 0] = v[8 * j + 0] * rstd * g0.x + b0.x; v[8 * j + 1] = v[8 * j + 1] * rstd * g0.y + b0.y; v[8 * j + 2] = v[8 * j + 2] * rstd * g0.z + b0.z; v[8 * j + 3] = v[8 * j + 3] * rstd * g0.w + b0.w;
        v[8 * j + 4] = v[8 * j + 4] * rstd * g1.x + b1.x; v[8 * j + 5] = v[8 * j + 5] * rstd * g1.y + b1.y; v[8 * j + 6] = v[8 * j + 6] * rstd * g1.z + b1.z; v[8 * j + 7] = v[8 * j + 7] * rstd * g1.w + b1.w; }
}
__device__ __forceinline__ void store_row_bf16(const float (&v)[32], bf16* grow, LAS unsigned char* xt_row, bool to_lds, int lane) {
#pragma unroll
    for (int j = 0; j < 4; ++j) { u32x4 w; w.x = cvt_pk_bf16(v[8 * j], v[8 * j + 1]); w.y = cvt_pk_bf16(v[8 * j + 2], v[8 * j + 3]); w.z = cvt_pk_bf16(v[8 * j + 4], v[8 * j + 5]); w.w = cvt_pk_bf16(v[8 * j + 6], v[8 * j + 7]);
        *(GAS u32x4*)(grow + 8 * lane + 512 * j) = w;
        if (to_lds) *(LAS u32x4*)(xt_row + (8 * lane + 512 * j) * 2) = w; }
}
__device__ __forceinline__ void p0b_rows(Frame& F) {
    F.rethread();
    const float* x = F.inp(I_X); bf16* XB = (bf16*)(F.wsp() + WS_XB); float* GT = (float*)(F.wsp() + WS_GATES);
    LAS float* LOG = (LAS float*)(F.lds + RP_LOG);
    for (int it = blockIdx.x; it < T / 16; it += F.G) {
#pragma unroll 1
        for (int rr = 0; rr < 2; ++rr) { const int r = F.wave * 2 + rr, t = it * 16 + r; float v[32];
            load_lane_vec32(x + (size_t)t * D, F.lane, v);
            store_row_bf16(v, XB + (size_t)t * D, F.lds + r * XT_PITCH, true, F.lane); }
        __syncthreads();
        skinny16(F, (const bf16*)(F.wsp() + WS_WG_T), F.inp(I_MBG));
        { const int row = F.tid >> 5, e = F.tid & 31; GT[(size_t)(it * 16 + row) * 32 + e] = LOG[row * LOGP + e]; }
    }
    __syncthreads();
}
__device__ __forceinline__ void r1_phase(Frame& F, int layer) {
    F.rethread();
    const bf16* PRE = (const bf16*)(F.wsp() + WS_PRE); bf16* X1 = (bf16*)(F.wsp() + WS_X1);
    int* LIST = (int*)(F.wsp() + WS_LIST); int* EIDX = (int*)(F.wsp() + WS_TOK); int* POS = (int*)(F.wsp() + WS_TOK + 256 * 1024); float* GATE = (float*)(F.wsp() + WS_TOK + 512 * 1024);
    LAS unsigned char* XT = F.lds; LAS float* PART = (LAS float*)(F.lds + RP_PART); LAS float* LOGA = (LAS float*)(F.lds + RP_LOGA);
    gu32* gcnt = F.ctlp() + CW_CNT + layer * 32 * 64;
    const int r16 = F.lane & 15, q = F.lane >> 4;
    float g[32], b[32];
    load_lane_vec32(F.inp(I_LNG) + (size_t)(layer * 2 + 0) * D, F.lane, g); load_lane_vec32(F.inp(I_LNB) + (size_t)(layer * 2 + 0) * D, F.lane, b);
    bf16x8 bw0[8], bw1[8];
    { const bf16* WT = (const bf16*)(F.wsp() + WS_WR_T) + (size_t)layer * 32 * D;
#pragma unroll
      for (int ks = 0; ks < 8; ++ks) { const int k0 = F.wave * 256 + ks * 32 + 8 * q; bw0[ks] = *(const GAS bf16x8*)(WT + (size_t)r16 * D + k0); bw1[ks] = *(const GAS bf16x8*)(WT + (size_t)(16 + r16) * D + k0); } }
    const float* rbias = F.inp(I_RB) + layer * NE;
    if (F.tid < 32) F.X[XW_LCNT + F.tid] = 0u;
    int nit = 0;
    u32x4 praw[4];
    if ((int)blockIdx.x < T / 16) {
#pragma unroll
        for (int j = 0; j < 4; ++j) praw[j] = *(const GAS u32x4*)(PRE + (size_t)((int)blockIdx.x * 16 + F.wave * 2) * D + 8 * F.lane + 512 * j); }
    for (int it = blockIdx.x; it < T / 16; it += F.G, ++nit) {
#pragma unroll 1
        for (int rr = 0; rr < 2; ++rr) { const int r = F.wave * 2 + rr, t = it * 16 + r; float v[32];
#pragma unroll
            for (int j = 0; j < 4; ++j) { const u32x4 w = praw[j];
                v[8 * j + 0] = bf_lo(w.x); v[8 * j + 1] = bf_hi(w.x); v[8 * j + 2] = bf_lo(w.y); v[8 * j + 3] = bf_hi(w.y); v[8 * j + 4] = bf_lo(w.z); v[8 * j + 5] = bf_hi(w.z); v[8 * j + 6] = bf_lo(w.w); v[8 * j + 7] = bf_hi(w.w); }
            { const int tn = rr == 0 ? t + 1 : (it + F.G) * 16 + F.wave * 2;
              if (rr == 0 || it + F.G < T / 16) {
#pragma unroll
                  for (int j = 0; j < 4; ++j) praw[j] = *(const GAS u32x4*)(PRE + (size_t)tn * D + 8 * F.lane + 512 * j); } }
            layer_norm32(v, g, b);
            store_row_bf16(v, X1 + (size_t)t * D, XT + r * XT_PITCH, true, F.lane);
            { unsigned char* x8 = (unsigned char*)(F.wsp() + WS_X1F8) + (size_t)t * D;
#pragma unroll
              for (int j = 0; j < 4; ++j) { int a_ = 0, b_ = 0; a_ = __builtin_amdgcn_cvt_pk_fp8_f32(v[8 * j], v[8 * j + 1], a_, false); a_ = __builtin_amdgcn_cvt_pk_fp8_f32(v[8 * j + 2], v[8 * j + 3], a_, true);
                  b_ = __builtin_amdgcn_cvt_pk_fp8_f32(v[8 * j + 4], v[8 * j + 5], b_, false); b_ = __builtin_amdgcn_cvt_pk_fp8_f32(v[8 * j + 6], v[8 * j + 7], b_, true);
                  *(GAS u32x2*)(x8 + 8 * F.lane + 512 * j) = (u32x2){(unsigned)a_, (unsigned)b_}; } } }
        __syncthreads();
        { float zf_ = 0.f; asm volatile("" : "+v"(zf_)); f32x4 acc0 = (f32x4){zf_, zf_, zf_, zf_}, acc1 = acc0;
#pragma unroll
          for (int ks = 0; ks < 8; ++ks) { const bf16x8 a = *(const LAS bf16x8*)(XT + r16 * XT_PITCH + (F.wave * 256 + ks * 32 + 8 * q) * 2);
              acc0 = __builtin_amdgcn_mfma_f32_16x16x32_bf16(a, bw0[ks], acc0, 0, 0, 0); acc1 = __builtin_amdgcn_mfma_f32_16x16x32_bf16(a, bw1[ks], acc1, 0, 0, 0); }
#pragma unroll
          for (int i = 0; i < 4; ++i) { PART[(F.wave * 16 + 4 * q + i) * 33 + r16] = acc0[i]; PART[(F.wave * 16 + 4 * q + i) * 33 + 16 + r16] = acc1[i]; } }
        __syncthreads();
        { const int row = F.tid >> 5, e = F.tid & 31; float s = rbias[e];
#pragma unroll
          for (int w = 0; w < 8; ++w) s += PART[(w * 16 + row) * 33 + e];
          LOGA[(nit * 16 + row) * LOGP + e] = s; }
    }
    __syncthreads();
    const int nrows = nit * 16; const int row = F.wave * 8 + (F.lane & 7); const bool act = (F.lane < 8) && (row < nrows);
    int e4[4] = {0, 0, 0, 0}; float v4[4] = {0.f, 0.f, 0.f, 0.f}; unsigned rk[4] = {0u, 0u, 0u, 0u};
    if (act) { unsigned mask = 0u; float lv[32];
#pragma unroll
        for (int e4i = 0; e4i < 8; ++e4i) { const f32x4 t = *(const LAS f32x4*)(LOGA + row * LOGP + 4 * e4i); lv[4 * e4i] = t.x; lv[4 * e4i + 1] = t.y; lv[4 * e4i + 2] = t.z; lv[4 * e4i + 3] = t.w; }
#pragma unroll
        for (int k = 0; k < 4; ++k) { float best = -__builtin_inff(); int bi = 0;
#pragma unroll
            for (int e = 0; e < 32; ++e) { const bool ok = (((mask >> e) & 1u) == 0u) && (lv[e] > best); best = ok ? lv[e] : best; bi = ok ? e : bi; }
            mask |= 1u << bi; e4[k] = bi; v4[k] = best; }
        const float e1 = __expf(v4[1] - v4[0]), e2 = __expf(v4[2] - v4[0]), e3 = __expf(v4[3] - v4[0]); const float inv = 1.f / (1.f + e1 + e2 + e3);
        v4[0] = inv; v4[1] = e1 * inv; v4[2] = e2 * inv; v4[3] = e3 * inv;
#pragma unroll
        for (int k = 0; k < 4; ++k) rk[k] = __hip_atomic_fetch_add((LAS unsigned*)(F.X + XW_LCNT + e4[k]), 1u, __ATOMIC_RELAXED, __HIP_MEMORY_SCOPE_WORKGROUP); }
    __syncthreads();
    if (F.tid < 32) { const unsigned c = F.X[XW_LCNT + F.tid]; unsigned base = 0u; if (c) base = __hip_atomic_fetch_add(gcnt + F.tid * 64, c, RLX_AGENT); F.X[XW_LBASE + F.tid] = base; }
    __syncthreads();
    if (act) { const int t = ((int)blockIdx.x + (row >> 4) * F.G) * 16 + (row & 15);
#pragma unroll
        for (int k = 0; k < 4; ++k) { const unsigned pos = F.X[XW_LBASE + e4[k]] + rk[k]; __hip_atomic_store((GAS int*)LIST + ((size_t)e4[k] * CAP + pos), t, RLX_AGENT); EIDX[t * 4 + k] = e4[k]; POS[t * 4 + k] = (int)pos; GATE[t * 4 + k] = v4[k]; } }
    __syncthreads();
}
__device__ __forceinline__ void moe_tables(Frame& F, int layer) {
    F.rethread();
    gu32* gcnt = F.ctlp() + CW_CNT + layer * 32 * 64;
    if (F.tid < 32) F.X[XW_CNT + F.tid] = __hip_atomic_load(gcnt + F.tid * 64, RLX_AGENT);
    __syncthreads();
    if (F.tid == 0) { unsigned run = 0u;
        for (int e = 0; e < 32; ++e) { const unsigned c = F.X[XW_CNT + e], n = (c + 255u) >> 8; F.X[XW_TPRE + e] = run; F.X[XW_PSTART + e] = run * 256u;
            for (unsigned i = 0; i < n; ++i) F.X[XW_TILE_E + run + i] = (unsigned)e; run += n; }
        F.X[XW_TPRE + 32] = run; F.X[XW_NTILES] = run; }
    __syncthreads();
}
__device__ __forceinline__ void r2_phase(Frame& F, int layer, bool last, int gates_j, int kmax) {
    F.rethread();
    const bf16* X1 = (const bf16*)(F.wsp() + WS_X1); const unsigned char* Y = (const unsigned char*)(F.wsp() + WS_Y); bf16* XB = (bf16*)(F.wsp() + WS_XB); float* GT = (float*)(F.wsp() + WS_GATES);
    const int* EIDX = (const int*)(F.wsp() + WS_TOK); const int* POS = (const int*)(F.wsp() + WS_TOK + 256 * 1024); const float* GATE = (const float*)(F.wsp() + WS_TOK + 512 * 1024);
    LAS float* LOG = (LAS float*)(F.lds + RP_LOG);
    LAS float* GL = (LAS float*)(F.lds + RP_GB); LAS float* BL = GL + D;
    { const float* gp = F.inp(I_LNG) + (size_t)(layer * 2 + 1) * D; const float* bp = F.inp(I_LNB) + (size_t)(layer * 2 + 1) * D;
      *(LAS f32x4*)(GL + 4 * F.tid) = *(const GAS f32x4*)(gp + 4 * F.tid); *(LAS f32x4*)(BL + 4 * F.tid) = *(const GAS f32x4*)(bp + 4 * F.tid); }
    __syncthreads();
    const int pl = F.lane < 12 ? F.lane : 0; const int* tokl = EIDX + (pl >> 2) * 65536 + (pl & 3);
    int pk = 0;
    if ((int)blockIdx.x < T / 16) pk = *(const GAS int*)(tokl + ((int)blockIdx.x * 16 + F.wave * 2) * 4);
    for (int it = blockIdx.x; it < T / 16; it += F.G) {
#pragma unroll
        for (int rr = 0; rr < 2; ++rr) { const int r = F.wave * 2 + rr, t = it * 16 + r; float v[32];
            load_row_bf16(X1 + (size_t)t * D, F.lane, v);
            const int ck = pk;
            { const int tn = rr == 0 ? t + 1 : (it + F.G) * 16 + F.wave * 2; if (rr == 0 || it + F.G < T / 16) pk = *(const GAS int*)(tokl + tn * 4); }
#pragma unroll
            for (int i = 0; i < 32; ++i) v[i] *= ALPHA;
#pragma unroll
            for (int k = 0; k < 4; ++k) if (k < kmax) { const int e = __builtin_amdgcn_readlane(ck, k), pos = __builtin_amdgcn_readlane(ck, 4 + k); const float gt = __builtin_bit_cast(float, __builtin_amdgcn_readlane(ck, 8 + k));
                const unsigned slot = F.X[XW_PSTART + e] + (unsigned)pos; float yv[32];
                { const unsigned char* yr = Y + (size_t)slot * D;
#pragma unroll
                  for (int j = 0; j < 4; ++j) { const u32x2 w = *(const GAS u32x2*)(yr + 8 * F.lane + 512 * j);
                      yv[8 * j + 0] = __builtin_amdgcn_cvt_f32_fp8((int)w.x, 0); yv[8 * j + 1] = __builtin_amdgcn_cvt_f32_fp8((int)w.x, 1); yv[8 * j + 2] = __builtin_amdgcn_cvt_f32_fp8((int)w.x, 2); yv[8 * j + 3] = __builtin_amdgcn_cvt_f32_fp8((int)w.x, 3);
                      yv[8 * j + 4] = __builtin_amdgcn_cvt_f32_fp8((int)w.y, 0); yv[8 * j + 5] = __builtin_amdgcn_cvt_f32_fp8((int)w.y, 1); yv[8 * j + 6] = __builtin_amdgcn_cvt_f32_fp8((int)w.y, 2); yv[8 * j + 7] = __builtin_amdgcn_cvt_f32_fp8((int)w.y, 3); } }
                const float gts = gt * (1.0f / Y_SCALE);
#pragma unroll
                for (int i = 0; i < 32; ++i) v[i] += gts * yv[i]; }
            layer_norm32_lds(v, GL, BL, F.lane);
            if (last) { float* o = F.outp() + (size_t)t * D;
#pragma unroll
                for (int j = 0; j < 4; ++j) { *(GAS f32x4*)(o + 8 * F.lane + 512 * j) = (f32x4){v[8 * j], v[8 * j + 1], v[8 * j + 2], v[8 * j + 3]}; *(GAS f32x4*)(o + 8 * F.lane + 512 * j + 4) = (f32x4){v[8 * j + 4], v[8 * j + 5], v[8 * j + 6], v[8 * j + 7]}; } }
            else store_row_bf16(v, XB + (size_t)t * D, F.lds + r * XT_PITCH, gates_j >= 0, F.lane); }
        if (gates_j >= 0) {
            __syncthreads();
            skinny16(F, (const bf16*)(F.wsp() + WS_WG_T) + (size_t)gates_j * 32 * D, F.inp(I_MBG) + gates_j * 32);
            { const int row = F.tid >> 5, e = F.tid & 31; GT[(size_t)(it * 16 + row) * 32 + e] = LOG[row * LOGP + e]; }
        }
    }
    __syncthreads();
}
__device__ __forceinline__ void stub_mixer(Frame& F) {
    F.rethread();
    const bf16* XB = (const bf16*)(F.wsp() + WS_XB); bf16* PRE = (bf16*)(F.wsp() + WS_PRE);
    for (size_t i = (size_t)blockIdx.x * NTHREADS + F.tid; i < (size_t)T * D / 8; i += (size_t)F.G * NTHREADS) { const u32x4 w = ((const GAS u32x4*)XB)[i]; u32x4 o;
        o.x = cvt_pk_bf16(bf_lo(w.x) * ALPHA, bf_hi(w.x) * ALPHA); o.y = cvt_pk_bf16(bf_lo(w.y) * ALPHA, bf_hi(w.y) * ALPHA); o.z = cvt_pk_bf16(bf_lo(w.z) * ALPHA, bf_hi(w.z) * ALPHA); o.w = cvt_pk_bf16(bf_lo(w.w) * ALPHA, bf_hi(w.w) * ALPHA);
        ((GAS u32x4*)PRE)[i] = o; }
}


typedef float f32x2_t __attribute__((ext_vector_type(2)));
__device__ __forceinline__ f32x2_t gelu_pk(f32x2_t v) {
    const f32x2_t av = __builtin_elementwise_abs(v), d = av * 0.2316418882f + 1.0f;
    f32x2_t t; t.x = __builtin_amdgcn_rcpf(d.x); t.y = __builtin_amdgcn_rcpf(d.y);
    f32x2_t q = t * 0.5307027145f + (-0.7265760135f); q = q * t + 0.7107068705f; q = q * t + (-0.142248368f); q = q * t + 0.127414796f; q = q * t;
    const f32x2_t s = (v * v) * (-0.72134752044f);
    f32x2_t e; e.x = __builtin_amdgcn_exp2f(s.x); e.y = __builtin_amdgcn_exp2f(s.y);
    const f32x2_t m = v * (q * e), r = v - m;
    f32x2_t o; o.x = v.x < 0.f ? m.x : r.x; o.y = v.y < 0.f ? m.y : r.y; return o;
}
template <int KK, int NN> struct RectBase {
    static constexpr int K = KK; static constexpr bool PERM = true, FP8 = false; static constexpr int SCALE_B = 0x7f7f7f7f;
    const bf16* A; const bf16* Bt; int G, c;
    __device__ __forceinline__ bool next(int i, pg8::Unit& u) const {
        constexpr int nM = T / 256, nN = NN / 256, nwg = nM * nN; const long L = (long)i * G + c; if (L >= nwg) return false;
        const int wgid = pg8::xcd_remap((int)L, nwg); constexpr int nig = pg8::WGM * nN; const int gid = wgid / nig, fm = gid * pg8::WGM, gsz = (nM - fm) < pg8::WGM ? (nM - fm) : pg8::WGM;
        u.pm = fm + ((wgid % nig) % gsz); u.pn = (wgid % nig) / gsz; u.e = 0; u.x = 0; return true;
    }
    __device__ __forceinline__ void bases(const pg8::Unit& u, const char*& cA, const char*& cB) const { cA = (const char*)(A + (size_t)u.pm * 256 * KK); cB = (const char*)(Bt + (size_t)u.pn * 256 * KK); }
    __device__ __forceinline__ void avoff(const pg8::Unit&, int tid, unsigned (&v)[2][2]) const {
#pragma unroll
        for (int i = 0; i < 2; ++i) { int R, C; pg8::stage_rc(tid * 16 + i * 8192, R, C);
#pragma unroll
            for (int h = 0; h < 2; ++h) v[h][i] = (unsigned)((h * 128 + R) * KK + C) * 2u; }
    }
};
struct OutProjProb : RectBase<D / 2, D> {
    static constexpr bool FP8 = true; static constexpr int SCALE_B = 0x78787878;
    const bf16* XB; bf16* PRE;
    __device__ __forceinline__ void epi(const f32x4 (&acc)[2][2][4][2], const pg8::Unit& u, int wr, int wc, int fr, int fq) const {
        const int row0 = u.pm * 256 + wr * 64 + fr, c0 = u.pn * 256 + wc * 32 + 8 * fq;
#pragma unroll
        for (int ai = 0; ai < 2; ++ai)
#pragma unroll
            for (int m = 0; m < 4; ++m) { const size_t off = (size_t)(row0 + ai * 128 + m * 16) * D + c0;
#pragma unroll
                for (int bj = 0; bj < 2; ++bj) { const u32x4 xr = *(const GAS u32x4*)(XB + off + bj * 128); const f32x4 a0 = acc[ai][bj][m][0], a1 = acc[ai][bj][m][1]; u32x4 w;
                    w.x = cvt_pk_bf16(ALPHA * bf_lo(xr.x) + a0[0], ALPHA * bf_hi(xr.x) + a0[1]); w.y = cvt_pk_bf16(ALPHA * bf_lo(xr.y) + a0[2], ALPHA * bf_hi(xr.y) + a0[3]);
                    w.z = cvt_pk_bf16(ALPHA * bf_lo(xr.z) + a1[0], ALPHA * bf_hi(xr.z) + a1[1]); w.w = cvt_pk_bf16(ALPHA * bf_lo(xr.w) + a1[2], ALPHA * bf_hi(xr.w) + a1[3]);
                    *(GAS u32x4*)(PRE + off + bj * 128) = w; }
                asm volatile("" ::: "memory"); }
    }
};
struct GmlpInProb : RectBase<D, 4096> {
    const float* bias; bf16* U; bf16* V; float* VSTAT;
    __device__ __forceinline__ void epi(const f32x4 (&acc)[2][2][4][2], const pg8::Unit& u, int wr, int wc, int fr, int fq) const {
        const int row0 = u.pm * 256 + wr * 64 + fr, ct = u.pn * 256 + wc * 32 + 8 * fq; const bool isv = u.pn >= 8;
        bf16* O = isv ? V : U; const int c0 = isv ? ct - 2048 : ct;
#pragma unroll
        for (int ai = 0; ai < 2; ++ai)
#pragma unroll
            for (int m = 0; m < 4; ++m) { const int row = row0 + ai * 128 + m * 16; float s1 = 0.f, s2 = 0.f;
#pragma unroll
                for (int bj = 0; bj < 2; ++bj) { const f32x4 b0 = *(const GAS f32x4*)(bias + ct + bj * 128), b1 = *(const GAS f32x4*)(bias + ct + bj * 128 + 4);
                    const f32x4 v0 = acc[ai][bj][m][0] + b0, v1 = acc[ai][bj][m][1] + b1;
                    const f32x2_t g0 = gelu_pk((f32x2_t){v0[0], v0[1]}), g1 = gelu_pk((f32x2_t){v0[2], v0[3]}), g2 = gelu_pk((f32x2_t){v1[0], v1[1]}), g3 = gelu_pk((f32x2_t){v1[2], v1[3]});
                    u32x4 w; w.x = cvt_pk_bf16(g0.x, g0.y); w.y = cvt_pk_bf16(g1.x, g1.y); w.z = cvt_pk_bf16(g2.x, g2.y); w.w = cvt_pk_bf16(g3.x, g3.y);
                    *(GAS u32x4*)(O + (isv ? (size_t)((((unsigned)(row >> 7) * 8u + (unsigned)(u.pn - 8)) * 32u + (unsigned)(wc * 4 + fq + bj * 16)) * 128u + (unsigned)(row & 127)) * 8u : (size_t)row * D + c0 + bj * 128)) = w;
                    if (isv) { const float r0 = bf_lo(w.x), r1 = bf_hi(w.x), r2 = bf_lo(w.y), r3 = bf_hi(w.y), r4 = bf_lo(w.z), r5 = bf_hi(w.z), r6 = bf_lo(w.w), r7 = bf_hi(w.w);
                        s1 += ((r0 + r1) + (r2 + r3)) + ((r4 + r5) + (r6 + r7)); s2 += ((r0 * r0 + r1 * r1) + (r2 * r2 + r3 * r3)) + ((r4 * r4 + r5 * r5) + (r6 * r6 + r7 * r7)); } }
                if (isv) { s1 += __shfl_xor(s1, 16); s1 += __shfl_xor(s1, 32); s2 += __shfl_xor(s2, 16); s2 += __shfl_xor(s2, 32);
                    if (fq == 0) *(GAS f32x2_t*)(VSTAT + ((size_t)((u.pn - 8) * 4 + wc) * T + row) * 2) = (f32x2_t){s1, s2}; }
                asm volatile("" ::: "memory"); }
    }
};


constexpr int VT_PITCH = 272, G3_ST = 69632, G3_WS = 70656;
constexpr int G3_GB = 105472, G3_ST2 = 107520;
__device__ __forceinline__ void g3_stats(const float* VSTAT, int row0, int tid, LAS float* STb) {
    f32x2 p[32];
#pragma unroll
    for (int cg = 0; cg < 32; ++cg) p[cg] = *(const GAS f32x2*)(VSTAT + ((size_t)cg * T + row0 + tid) * 2);
    float s1 = 0.f, s2 = 0.f;
#pragma unroll
    for (int cg = 0; cg < 32; ++cg) { s1 += p[cg].x; s2 += p[cg].y; }
    const float mean = s1 * (1.f / D), var = s2 * (1.f / D) - mean * mean; STb[tid * 2] = mean; STb[tid * 2 + 1] = 1.f / sqrtf(var + LN_EPS);
}
__device__ __forceinline__ void g3_phase(Frame& F, int j) {
    F.rethread();
    LAS unsigned char* VT = F.lds; LAS float* GB = (LAS float*)(F.lds + G3_GB);
    const bf16* U = (const bf16*)(F.wsp() + WS_GU); const bf16* V = (const bf16*)(F.wsp() + WS_GV); bf16* YG = (bf16*)(F.wsp() + WS_GY); const float* VSTAT = (const float*)(F.wsp() + WS_VSTAT);
    const float* vg = F.inp(I_GVG) + (size_t)j * D; const float* vb = F.inp(I_GVB) + (size_t)j * D; const float* bs = F.inp(I_GBS) + (size_t)j * 8 * 128;
    const bf16* WS = (const bf16*)(F.wsp() + WS_WS) + (size_t)j * 8 * 128 * 128;
    const int r = F.lane & 15, q = F.lane >> 4;
    const unsigned psel = (F.lane & 1) ? 0x03020706u : 0x05040100u; const int podd = F.lane & 1;
    const int unit0 = blockIdx.x, g = unit0 & 7;
    if (unit0 < 1024) {
        if (F.tid < 128) { g3_stats(VSTAT, (unit0 >> 3) * 128, F.tid, (LAS float*)(F.lds + G3_ST));
            const float* gsrc = (F.tid < 64 ? vg : vb) + g * 256 + 4 * (F.tid & 63); *(LAS f32x4*)(GB + (F.tid < 64 ? 0 : 256) + 4 * (F.tid & 63)) = *(const GAS f32x4*)gsrc; }
        { const bf16* wsg0 = WS + (size_t)g * 128 * 128;
#pragma unroll
          for (int i = 0; i < 4; ++i) { const int p = F.tid + 512 * i; *(LAS u32x4*)(F.lds + G3_WS + (p >> 4) * VT_PITCH + (p & 15) * 16) = *(const GAS u32x4*)(wsg0 + (size_t)(p >> 4) * 128 + (p & 15) * 8); } }
    }
    u32x4 vreg[8];
    if (unit0 < 1024) {
#pragma unroll
        for (int i = 0; i < 8; ++i) { const int qq = F.tid + 512 * i, s = qq & 127, d8 = qq >> 7;
            vreg[i] = *(const GAS u32x4*)(V + (size_t)((((unsigned)(unit0 >> 3) * 8u + (unsigned)g) * 32u + (unsigned)d8) * 128u + (unsigned)s) * 8u); } }
    __syncthreads();
    int par = 0;
    for (int unit = unit0; unit < 1024; unit += F.G, par ^= 1) {
        const int row0 = (unit >> 3) * 128; const LAS float* ST = (const LAS float*)(F.lds + (par ? G3_ST2 : G3_ST));
        u32x2 ureg[8][2]; float bsv[8];
#pragma unroll
        for (int tt = 0; tt < 8; ++tt) { const int t = 16 * tt + r; const size_t off = (size_t)(row0 + t) * D + g * 256 + 32 * F.wave + 4 * q;
            ureg[tt][0] = *(const GAS u32x2*)(U + off); ureg[tt][1] = *(const GAS u32x2*)(U + off + 16); bsv[tt] = *(const GAS float*)(bs + g * 128 + t); }
#pragma unroll
        for (int i = 0; i < 8; ++i) { const int qq = F.tid + 512 * i, s = qq & 127, d0 = (qq >> 7) * 8;
            const u32x4 w = vreg[i]; const float mean = ST[s * 2], rstd = ST[s * 2 + 1];
            const f32x4 g0 = *(const LAS f32x4*)(GB + d0), g1 = *(const LAS f32x4*)(GB + d0 + 4), b0 = *(const LAS f32x4*)(GB + 256 + d0), b1 = *(const LAS f32x4*)(GB + 256 + d0 + 4);
            const float x[8] = {bf_lo(w.x), bf_hi(w.x), bf_lo(w.y), bf_hi(w.y), bf_lo(w.z), bf_hi(w.z), bf_lo(w.w), bf_hi(w.w)};
            const float gg[8] = {g0.x, g0.y, g0.z, g0.w, g1.x, g1.y, g1.z, g1.w}, bb[8] = {b0.x, b0.y, b0.z, b0.w, b1.x, b1.y, b1.z, b1.w};
            LAS unsigned char* vt = VT + (d0 + podd) * VT_PITCH + (s & ~1) * 2;
#pragma unroll
            for (int k = 0; k < 4; ++k) { const unsigned pk = cvt_pk_bf16_nop((x[2 * k] - mean) * rstd * gg[2 * k] + bb[2 * k], (x[2 * k + 1] - mean) * rstd * gg[2 * k + 1] + bb[2 * k + 1]);
                const unsigned y = (unsigned)__builtin_amdgcn_update_dpp(0, (int)pk, 0xB1, 0xf, 0xf, true); *(LAS unsigned*)(vt + (2 * k) * VT_PITCH) = __builtin_amdgcn_perm(y, pk, psel); } }
        __syncthreads();
        bf16x8 af[2][4];
#pragma unroll
        for (int dd = 0; dd < 2; ++dd)
#pragma unroll
            for (int ks = 0; ks < 4; ++ks) af[dd][ks] = *(const LAS bf16x8*)(VT + (16 * (2 * F.wave + dd) + r) * VT_PITCH + (32 * ks + 8 * q) * 2);
        if (unit + F.G < 1024) { const int un = unit + F.G;
#pragma unroll
            for (int i = 0; i < 8; ++i) { const int qq = F.tid + 512 * i, s = qq & 127, d8 = qq >> 7;
                vreg[i] = *(const GAS u32x4*)(V + (size_t)((((unsigned)(un >> 3) * 8u + (unsigned)g) * 32u + (unsigned)d8) * 128u + (unsigned)s) * 8u); }
            if (F.tid < 128) g3_stats(VSTAT, (un >> 3) * 128, F.tid, (LAS float*)(F.lds + (par ? G3_ST : G3_ST2))); }
#pragma unroll
        for (int tt = 0; tt < 8; ++tt) { bf16x8 bfr[4];
#pragma unroll
            for (int ks = 0; ks < 4; ++ks) bfr[ks] = *(const LAS bf16x8*)(F.lds + G3_WS + (16 * tt + r) * VT_PITCH + (32 * ks + 8 * q) * 2);
            f32x4 a0 = (f32x4){0.f, 0.f, 0.f, 0.f}, a1 = a0;
#pragma unroll
            for (int ks = 0; ks < 4; ++ks) { a0 = __builtin_amdgcn_mfma_f32_16x16x32_bf16(af[0][ks], bfr[ks], a0, 0, 0, 0); a1 = __builtin_amdgcn_mfma_f32_16x16x32_bf16(af[1][ks], bfr[ks], a1, 0, 0, 0); }
            const int t = 16 * tt + r; const float bias = bsv[tt]; const size_t off = (size_t)(row0 + t) * D + g * 256 + 32 * F.wave + 4 * q;
            { const u32x2 uu = ureg[tt][0]; int o_ = 0; o_ = __builtin_amdgcn_cvt_pk_fp8_f32(bf_lo(uu.x) * (a0[0] + bias), bf_hi(uu.x) * (a0[1] + bias), o_, false); o_ = __builtin_amdgcn_cvt_pk_fp8_f32(bf_lo(uu.y) * (a0[2] + bias), bf_hi(uu.y) * (a0[3] + bias), o_, true); *(GAS unsigned*)((unsigned char*)YG + off) = (unsigned)o_; }
            { const u32x2 uu = ureg[tt][1]; int o_ = 0; o_ = __builtin_amdgcn_cvt_pk_fp8_f32(bf_lo(uu.x) * (a1[0] + bias), bf_hi(uu.x) * (a1[1] + bias), o_, false); o_ = __builtin_amdgcn_cvt_pk_fp8_f32(bf_lo(uu.y) * (a1[2] + bias), bf_hi(uu.y) * (a1[3] + bias), o_, true); *(GAS unsigned*)((unsigned char*)YG + off + 16) = (unsigned)o_; }
            __builtin_amdgcn_sched_barrier(0); }
        __syncthreads();
    }
}


struct MlstmInProb : RectBase<D, MIN_MAIN> {
    bf16* Q; bf16* Kb; bf16* V; bf16* O;
    __device__ __forceinline__ void epi(const f32x4 (&acc)[2][2][4][2], const pg8::Unit& u, int wr, int wc, int fr, int fq) const {
        bf16* base; float sc = 1.f; unsigned off0, SA, SM, SB;
        const unsigned row0 = (unsigned)(u.pm * 256 + wr * 64 + fr), bb = row0 >> 12, chunk0 = (row0 >> 7) & 31u, s0 = row0 & 127u;
        if (u.pn < 4) { base = Q; sc = 0.08838834764831845f; off0 = row0 * QKW + u.pn * 256 + wc * 32 + 8 * fq; SA = 128u * QKW; SM = 16u * QKW; SB = 128u; }
        else if (u.pn < 8) { base = Kb; const unsigned hb = (unsigned)(u.pn - 4) * 2u, seg = (unsigned)(wc * 4 + fq);
            off0 = ((((bb * 8u + hb) * 32u + chunk0) * 16u + seg) * 128u + s0) * 8u; SA = 16384u; SM = 128u; SB = 524288u; }
        else if (u.pn < 16) { base = V; const unsigned h = (unsigned)(u.pn - 8), v8 = (unsigned)((wc & 1) * 4 + fq);
            off0 = (((((bb * 8u + h) * 4u + (unsigned)(wc >> 1)) * 32u + chunk0) * 8u + v8) * 128u + s0) * 8u; SA = 8192u; SM = 128u; SB = 524288u; }
        else { base = O; off0 = row0 * VW + (u.pn - 16) * 256 + wc * 32 + 8 * fq; SA = 128u * VW; SM = 16u * VW; SB = 128u; }
#pragma unroll
        for (int ai = 0; ai < 2; ++ai)
#pragma unroll
            for (int m = 0; m < 4; ++m) { bf16* rowp = base + (size_t)(off0 + ai * SA + m * SM);
#pragma unroll
                for (int bj = 0; bj < 2; ++bj) { const f32x4 v0 = acc[ai][bj][m][0] * sc, v1 = acc[ai][bj][m][1] * sc;
                    u32x4 w; w.x = cvt_pk_bf16(v0[0], v0[1]); w.y = cvt_pk_bf16(v0[2], v0[3]); w.z = cvt_pk_bf16(v1[0], v1[1]); w.w = cvt_pk_bf16(v1[2], v1[3]);
                    *(GAS u32x4*)(rowp + (size_t)(bj * SB)) = w; } }
    }
};
template <class Fn, int... I> __device__ __forceinline__ void sfor_impl(Fn&& f, std::integer_sequence<int, I...>) { (f(std::integral_constant<int, I>{}), ...); }
template <int N, class Fn> __device__ __forceinline__ void sfor(Fn&& f) { sfor_impl(static_cast<Fn&&>(f), std::make_integer_sequence<int, N>{}); }
template <int OFF> __device__ __forceinline__ bf16x8 lds_ld128(const LAS unsigned char* a) { return *(const LAS bf16x8*)(a + OFF); }
template <int OFF> __device__ __forceinline__ u32x2 lds_ld64(const LAS unsigned char* a) { return *(const LAS u32x2*)(a + OFF); }
#define LDS_LANDED10(a, b) __builtin_amdgcn_sched_barrier(0)
#define MFMA_DRAIN(vec) do { __builtin_amdgcn_sched_barrier(0); const int d_ = __builtin_amdgcn_readfirstlane(__builtin_bit_cast(int, (vec)[0])); asm volatile("" :: "s"(d_)); __builtin_amdgcn_sched_barrier(0); } while (0)
#define SFOR(n, var) sfor<n>([&](auto var##_) __attribute__((always_inline)) { constexpr int var = decltype(var##_)::value;
#define SFOR_END });
constexpr int SP = 272;
constexpr int SC_KI = 0, SC_KT = 34816, SC_VT = 69632, SC_VW = 91392, SC_CT = 113152, SC_TB = 134912, SC_TBF = 672;
__device__ __forceinline__ size_t ktile(int b, int h, int dir, int c, int j, int g) { const int cc = dir ? 31 - c : c, s = dir ? 127 - j : j; return ((size_t)((((b * 8 + h) * 32 + cc) * 16 + g) * 128 + s)) * 8; }
__device__ __forceinline__ size_t vtile(int b, int h, int dvs, int dir, int c, int j, int g) { const int cc = dir ? 31 - c : c, s = dir ? 127 - j : j; return ((size_t)(((((b * 8 + h) * 4 + dvs) * 32 + cc) * 8 + g) * 128 + s)) * 8; }
__device__ __forceinline__ int scan_row(int b, int dir, int c, int j) { return b * SEQ + (dir ? (31 - c) * 128 + (127 - j) : c * 128 + j); }
__device__ __forceinline__ float log_sigmoid(float x) {
    const float e = __expf(-fabsf(x)), u = 1.f + e;
    const float l = (u == 1.f) ? e : __logf(u) * (e * __builtin_amdgcn_rcpf(u - 1.f));
    return fminf(x, 0.f) - l;
}
template <int CTRL, int ROWM> __device__ __forceinline__ float dpp_take(float ident, float v) {
    return __builtin_bit_cast(float, __builtin_amdgcn_update_dpp(__builtin_bit_cast(int, ident), __builtin_bit_cast(int, v), CTRL, ROWM, 0xf, false)); }
__device__ __forceinline__ float wave_scan_add(float x) {
    x += dpp_take<0x111, 0xf>(0.f, x); x += dpp_take<0x112, 0xf>(0.f, x); x += dpp_take<0x114, 0xf>(0.f, x); x += dpp_take<0x118, 0xf>(0.f, x);
    x += dpp_take<0x142, 0xa>(0.f, x); x += dpp_take<0x143, 0xc>(0.f, x); return x; }
__device__ __forceinline__ float wave_scan_max(float x) {
    const float ni = -__builtin_inff();
    x = fmaxf(x, dpp_take<0x111, 0xf>(ni, x)); x = fmaxf(x, dpp_take<0x112, 0xf>(ni, x)); x = fmaxf(x, dpp_take<0x114, 0xf>(ni, x)); x = fmaxf(x, dpp_take<0x118, 0xf>(ni, x));
    x = fmaxf(x, dpp_take<0x142, 0xa>(ni, x)); x = fmaxf(x, dpp_take<0x143, 0xc>(ni, x)); return x; }
__device__ __forceinline__ void scan_gate_load(const float* GT, int b, int dir, int c, int gi, int lane, float (&gv)[4]) {
    const int t0 = scan_row(b, dir, c, 2 * lane), t1 = scan_row(b, dir, c, 2 * lane + 1);
    const GAS float* G = (const GAS float*)GT; gv[0] = G[(size_t)t0 * 32 + gi]; gv[1] = G[(size_t)t1 * 32 + gi]; gv[2] = G[(size_t)t0 * 32 + gi + 8]; gv[3] = G[(size_t)t1 * 32 + gi + 8];
}
__device__ __forceinline__ void scan_tables(LAS float* TB, const float (&gv)[4], int lane, float& m) {
    const float i0 = gv[0], i1 = gv[1], f0 = log_sigmoid(gv[2]), f1 = log_sigmoid(gv[3]);
    const float x = wave_scan_add(f0 + f1);
    const float b1 = x, b0 = x - f1, u0 = i0 - b0, u1 = i1 - b1;
    const float z = wave_scan_max(fmaxf(u0, u1));
    float ex = __shfl_up(z, 1); if (lane == 0) ex = -__builtin_inff();
    const float M0 = fmaxf(m, fmaxf(ex, u0)), M1 = fmaxf(m, z);
    const float Ml = __builtin_bit_cast(float, __builtin_amdgcn_readlane(__builtin_bit_cast(int, M1), 63)), bl = __builtin_bit_cast(float, __builtin_amdgcn_readlane(__builtin_bit_cast(int, b1), 63));
    TB[2 * lane] = u0; TB[2 * lane + 1] = u1; TB[128 + 2 * lane] = M0; TB[128 + 2 * lane + 1] = M1;
    TB[256 + 2 * lane] = __expf(-(b0 + M0)); TB[256 + 2 * lane + 1] = __expf(-(b1 + M1));
    TB[384 + 2 * lane] = __expf(u0 - Ml); TB[384 + 2 * lane + 1] = __expf(u1 - Ml);
    TB[512 + 2 * lane] = __expf(m - M0); TB[512 + 2 * lane + 1] = __expf(m - M1);
    if (lane == 0) TB[640] = __expf(m - Ml);
    m = bl + Ml;
}
__device__ __forceinline__ void m2_scan(Frame& F) {
    F.rethread();
    LAS unsigned char* L = F.lds;
    const bf16* Qg = (const bf16*)(F.wsp() + WS_MQ); const bf16* Kg = (const bf16*)(F.wsp() + WS_MK); const bf16* Vg = (const bf16*)(F.wsp() + WS_MV); const float* GT = (const float*)(F.wsp() + WS_GATES);
    const int w = F.wave, lane = F.lane, c16 = lane & 15, q = lane >> 4, tid = F.tid;
    for (int cblk = blockIdx.x; cblk < 256; cblk += F.G) {
        const int chain = (cblk & 7) * 32 + (cblk >> 3);
        const int dvs = chain & 3, dir = (chain >> 2) & 1, h = (chain >> 3) & 7, b = chain >> 6;
        bf16* Hout = (bf16*)(F.wsp() + (dir ? WS_HB : WS_HF));
        const int qcol0 = h * 128, vcol0 = h * 256 + dvs * 64, gi = 2 * dir * 8 + h;
        const LAS unsigned char* lbase = L + c16 * SP;
        const LAS unsigned char* bKI = lbase + SC_KI + 16 * q; const LAS unsigned char* bCT = lbase + SC_CT + 16 * q; const LAS unsigned char* bVT = lbase + SC_VT + 8 * q;
        const LAS unsigned char* bVW = lbase + SC_VW + 16 * q; const LAS unsigned char* bKT = lbase + SC_KT + 16 * w * SP + 16 * q;
        for (int i = tid; i < 80 * SP / 4; i += NTHREADS) ((LAS unsigned*)(L + SC_CT))[i] = 0u;
        for (int i = tid; i < 16 * SP / 4; i += NTHREADS) { ((LAS unsigned*)(L + SC_VT + 64 * SP))[i] = (i < SP / 4) ? 0x3F803F80u : 0u; ((LAS unsigned*)(L + SC_VW + 64 * SP))[i] = 0u; }
        f32x4 cacc[5];
#pragma unroll
        for (int vt = 0; vt < 5; ++vt) cacc[vt] = (f32x4){0.f, 0.f, 0.f, 0.f};
        const int nK = w < 4 ? 6 : (w < 6 ? 4 : 0), nV = nK >> 1, kbase = w < 4 ? 6 * w : (w == 4 ? 24 : 28), vbase = w < 4 ? 3 * w : (w == 4 ? 12 : 14);
        u32x4 kn[6], vn[3]; bf16x8 qn[4];
#pragma unroll
        for (int i = 0; i < 6; ++i) { kn[i] = (u32x4){0u, 0u, 0u, 0u}; if (i < nK) kn[i] = *(const GAS u32x4*)(Kg + ktile(b, h, dir, 0, 64 * (i & 1) + lane, (kbase + i) >> 1)); }
#pragma unroll
        for (int i = 0; i < 3; ++i) { vn[i] = (u32x4){0u, 0u, 0u, 0u}; if (i < nV) vn[i] = *(const GAS u32x4*)(Vg + vtile(b, h, dvs, dir, 0, 64 * ((vbase + i) & 1) + lane, (vbase + i) >> 1)); }
#pragma unroll
        for (int ks = 0; ks < 4; ++ks) qn[ks] = *(const GAS bf16x8*)(Qg + (size_t)scan_row(b, dir, 0, 16 * w + c16) * QKW + qcol0 + 32 * ks + 8 * q);
        float m_run = 0.f;
        float gv[4] = {0.f, 0.f, 0.f, 0.f};
        if (w == 0) { scan_gate_load(GT, b, dir, 0, gi, lane, gv); scan_tables((LAS float*)(L + SC_TB), gv, lane, m_run); scan_gate_load(GT, b, dir, 1, gi, lane, gv); }
        __syncthreads();
#pragma unroll 1
        for (int c = 0; c < 32; ++c) {
            const LAS float* TB = (const LAS float*)(L + SC_TB) + (c & 1) * SC_TBF;
            bf16x8 qf[4];
#pragma unroll
            for (int ks = 0; ks < 4; ++ks) qf[ks] = qn[ks];
            const unsigned psel = (lane & 1) ? 0x03020706u : 0x05040100u; const int podd = lane & 1;
#pragma unroll
            for (int i = 0; i < 6; ++i) if (i < nK) { const int s = 64 * (i & 1) + lane, d8 = (kbase + i) >> 1; *(LAS u32x4*)(L + SC_KI + s * SP + d8 * 16) = kn[i]; }
#pragma unroll
            for (int i = 0; i < 3; ++i) if (i < nV) { const int s = 64 * ((vbase + i) & 1) + lane, v8 = (vbase + i) >> 1; const u32x4 vv = vn[i];
                LAS unsigned char* vt = L + SC_VT + (8 * v8 + podd) * SP + (s & ~1) * 2; const unsigned ww[4] = {vv.x, vv.y, vv.z, vv.w};
#pragma unroll
                for (int e = 0; e < 4; ++e) { const unsigned y = (unsigned)__builtin_amdgcn_update_dpp(0, (int)ww[e], 0xB1, 0xf, 0xf, true); *(LAS unsigned*)(vt + (2 * e) * SP) = __builtin_amdgcn_perm(y, ww[e], psel); } }
            __syncthreads();
#pragma unroll
            for (int i = 0; i < 6; ++i) if (i < nK) { const int s = 64 * (i & 1) + lane, d8 = (kbase + i) >> 1; const u32x4 kv = kn[i];
                LAS unsigned char* kt = L + SC_KT + (8 * d8 + podd) * SP + (s & ~1) * 2; const unsigned kw[4] = {kv.x, kv.y, kv.z, kv.w};
#pragma unroll
                for (int e = 0; e < 4; ++e) { const unsigned y = (unsigned)__builtin_amdgcn_update_dpp(0, (int)kw[e], 0xB1, 0xf, 0xf, true); *(LAS unsigned*)(kt + (2 * e) * SP) = __builtin_amdgcn_perm(y, kw[e], psel); } }
#pragma unroll
            for (int i = 0; i < 3; ++i) if (i < nV) { const int s = 64 * ((vbase + i) & 1) + lane, v8 = (vbase + i) >> 1; const u32x4 vv = vn[i]; const float wk = TB[384 + s];
                LAS unsigned char* vw = L + SC_VW + (8 * v8 + podd) * SP + (s & ~1) * 2; const unsigned ww[4] = {vv.x, vv.y, vv.z, vv.w};
#pragma unroll
                for (int e = 0; e < 4; ++e) { const unsigned sc = cvt_pk_bf16_nop(bf_lo(ww[e]) * wk, bf_hi(ww[e]) * wk); const unsigned ys = (unsigned)__builtin_amdgcn_update_dpp(0, (int)sc, 0xB1, 0xf, 0xf, true);
                    *(LAS unsigned*)(vw + (2 * e) * SP) = __builtin_amdgcn_perm(ys, sc, psel); } }
            if (tid < 128) *(LAS unsigned short*)(L + SC_VW + 64 * SP + tid * 2) = (unsigned short)f2bf(TB[384 + tid]);
            if (c + 1 < 32) {
                const int cc1 = dir ? 30 - c : c + 1;
                const char* KB = (const char*)Kg + (size_t)(((b * 8 + h) * 32 + cc1)) * 32768;
                const char* VB = (const char*)Vg + (size_t)((((b * 8 + h) * 4 + dvs) * 32 + cc1)) * 16384;
                const char* QB = (const char*)Qg + ((size_t)(b * SEQ + cc1 * 128) * QKW + qcol0) * 2;
                const unsigned lp = 16u * (unsigned)(dir ? 63 - lane : lane);
#pragma unroll
                for (int i = 0; i < 6; ++i) if (i < nK) { const int n = kbase + i, hf = n & 1; kn[i] = *(const GAS u32x4*)(KB + ((unsigned)((n >> 1) * 2048 + (dir ? 1 - hf : hf) * 1024) + lp)); }
#pragma unroll
                for (int i = 0; i < 3; ++i) if (i < nV) { const int n = vbase + i, hf = n & 1; vn[i] = *(const GAS u32x4*)(VB + ((unsigned)((n >> 1) * 2048 + (dir ? 1 - hf : hf) * 1024) + lp)); }
                const unsigned qo = (unsigned)((dir ? 127 - (16 * w + c16) : 16 * w + c16) * (QKW * 2) + 16 * q);
#pragma unroll
                for (int ks = 0; ks < 4; ++ks) qn[ks] = *(const GAS bf16x8*)(QB + (qo + 64u * ks));
            }
            if (w == 0 && c + 1 < 32) { scan_tables((LAS float*)(L + SC_TB) + ((c + 1) & 1) * SC_TBF, gv, lane, m_run); if (c + 2 < 32) scan_gate_load(GT, b, dir, c + 2, gi, lane, gv); }
            const float Mj = TB[128 + 16 * w + c16], iscj = TB[512 + 16 * w + c16], emtj = TB[256 + 16 * w + c16];
            const LAS unsigned char* bTB = (const LAS unsigned char*)TB + 16 * q;
            f32x4 ad[5], ac[5];
#pragma unroll
            for (int vt = 0; vt < 5; ++vt) { ad[vt] = (f32x4){0.f, 0.f, 0.f, 0.f}; ac[vt] = ad[vt]; }
            SFOR(2, kh) bf16x8 r0[5], r1[5];
                SFOR(5, vt) r0[vt] = lds_ld128<16 * vt * SP + 128 * kh>(bCT); r1[vt] = lds_ld128<16 * vt * SP + 128 * kh + 64>(bCT); SFOR_END
                LDS_LANDED10(r0, r1);
#pragma unroll
                for (int vt = 0; vt < 5; ++vt) ad[vt] = __builtin_amdgcn_mfma_f32_16x16x32_bf16(r0[vt], qf[2 * kh], ad[vt], 0, 0, 0);
#pragma unroll
                for (int vt = 0; vt < 5; ++vt) ad[vt] = __builtin_amdgcn_mfma_f32_16x16x32_bf16(r1[vt], qf[2 * kh + 1], ad[vt], 0, 0, 0);
                MFMA_DRAIN(ad[4]);
            SFOR_END
            bf16x8 pf[4];
            SFOR(4, kp) u32x4 t4 = (u32x4){0u, 0u, 0u, 0u};
                if (2 * kp <= w) {
                    bf16x8 a0[5], a1[5];
                    SFOR(4, ks) a0[ks] = lds_ld128<32 * kp * SP + 64 * ks>(bKI); a1[ks] = lds_ld128<(32 * kp + 16) * SP + 64 * ks>(bKI); SFOR_END
                    a0[4] = lds_ld128<32 * kp * 4>(bTB); a1[4] = lds_ld128<(32 * kp + 16) * 4>(bTB);
                    LDS_LANDED10(a0, a1);
                    const f32x4 ua = __builtin_bit_cast(f32x4, a0[4]), ub = __builtin_bit_cast(f32x4, a1[4]);
                    f32x4 s0 = (f32x4){0.f, 0.f, 0.f, 0.f}, s1 = s0;
#pragma unroll
                    for (int ks = 0; ks < 4; ++ks) { s0 = __builtin_amdgcn_mfma_f32_16x16x32_bf16(a0[ks], qf[ks], s0, 0, 0, 0); s1 = __builtin_amdgcn_mfma_f32_16x16x32_bf16(a1[ks], qf[ks], s1, 0, 0, 0); }
                    float p0[4], p1[4]; const int j = 16 * w + c16;
#pragma unroll
                    for (int i = 0; i < 4; ++i) { const int s = 32 * kp + 4 * q + i; p0[i] = (s <= j) ? s0[i] * __expf(ua[i] - Mj) : 0.f; p1[i] = (s + 16 <= j) ? s1[i] * __expf(ub[i] - Mj) : 0.f; }
                    t4.x = cvt_pk_bf16(p0[0], p0[1]); t4.y = cvt_pk_bf16(p0[2], p0[3]); t4.z = cvt_pk_bf16(p1[0], p1[1]); t4.w = cvt_pk_bf16(p1[2], p1[3]); }
                pf[kp] = __builtin_bit_cast(bf16x8, t4);
            SFOR_END
            SFOR(4, kp) if (2 * kp <= w) {
                u32x2 lo[5], hi[5];
                SFOR(5, vt) lo[vt] = lds_ld64<16 * vt * SP + 64 * kp>(bVT); hi[vt] = lds_ld64<16 * vt * SP + 64 * kp + 32>(bVT); SFOR_END
                LDS_LANDED10(lo, hi);
#pragma unroll
                for (int vt = 0; vt < 5; ++vt) { u32x4 t4; t4.x = lo[vt].x; t4.y = lo[vt].y; t4.z = hi[vt].x; t4.w = hi[vt].y; ac[vt] = __builtin_amdgcn_mfma_f32_16x16x32_bf16(__builtin_bit_cast(bf16x8, t4), pf[kp], ac[vt], 0, 0, 0); }
                MFMA_DRAIN(ac[4]); }
            SFOR_END
            f32x4 num[5];
#pragma unroll
            for (int vt = 0; vt < 5; ++vt) num[vt] = ac[vt] + ad[vt] * iscj;
            { const float den = __shfl(num[4][0], c16); const float inv = 1.f / fmaxf(fabsf(den), emtj);
              bf16* hrow = Hout + (size_t)scan_row(b, dir, c, 16 * w + c16) * VW + vcol0 + 4 * q;
#pragma unroll
              for (int vt = 0; vt < 4; ++vt) { u32x2 o; o.x = cvt_pk_bf16(num[vt][0] * inv, num[vt][1] * inv); o.y = cvt_pk_bf16(num[vt][2] * inv, num[vt][3] * inv); *(GAS u32x2*)(hrow + 16 * vt) = o; } }
            __syncthreads();
            { const float decay = TB[640];
#pragma unroll
              for (int vt = 0; vt < 5; ++vt) cacc[vt] = cacc[vt] * decay;
              SFOR(2, kh) bf16x8 b0[5], b1[5], ka0, ka1;
                  ka0 = lds_ld128<128 * kh>(bKT); ka1 = lds_ld128<128 * kh + 64>(bKT);
                  SFOR(5, vt) b0[vt] = lds_ld128<16 * vt * SP + 128 * kh>(bVW); b1[vt] = lds_ld128<16 * vt * SP + 128 * kh + 64>(bVW); SFOR_END
                  LDS_LANDED10(b0, b1);
#pragma unroll
                  for (int vt = 0; vt < 5; ++vt) cacc[vt] = __builtin_amdgcn_mfma_f32_16x16x32_bf16(ka0, b0[vt], cacc[vt], 0, 0, 0);
#pragma unroll
                  for (int vt = 0; vt < 5; ++vt) cacc[vt] = __builtin_amdgcn_mfma_f32_16x16x32_bf16(ka1, b1[vt], cacc[vt], 0, 0, 0);
                  MFMA_DRAIN(cacc[4]);
              SFOR_END
#pragma unroll
              for (int vt = 0; vt < 5; ++vt) { u32x2 o; o.x = cvt_pk_bf16(cacc[vt][0], cacc[vt][1]); o.y = cvt_pk_bf16(cacc[vt][2], cacc[vt][3]); *(LAS u32x2*)(L + SC_CT + (16 * vt + c16) * SP + (16 * w + 4 * q) * 2) = o; } }
            __syncthreads();
        }
    }
}
__device__ __forceinline__ float half_wave_sum(float x) {
    x += __builtin_bit_cast(float, __builtin_amdgcn_update_dpp(0, __builtin_bit_cast(int, x), 0xB1, 0xf, 0xf, true));
    x += __builtin_bit_cast(float, __builtin_amdgcn_update_dpp(0, __builtin_bit_cast(int, x), 0x4E, 0xf, 0xf, true));
    x += __builtin_bit_cast(float, __builtin_amdgcn_update_dpp(0, __builtin_bit_cast(int, x), 0x141, 0xf, 0xf, true));
    x += __builtin_bit_cast(float, __builtin_amdgcn_update_dpp(0, __builtin_bit_cast(int, x), 0x140, 0xf, 0xf, true));
    return x + __shfl_xor(x, 16);
}
__device__ __forceinline__ void m3_combine(Frame& F, int j) {
    F.rethread();
    const bf16* HF = (const bf16*)(F.wsp() + WS_HF); const bf16* HB = (const bf16*)(F.wsp() + WS_HB); const bf16* O = (const bf16*)(F.wsp() + WS_MO); bf16* HG = (bf16*)(F.wsp() + WS_HG);
    float g[32]; load_lane_vec32(F.inp(I_MNG) + (size_t)j * VW, F.lane, g);
    const int t0 = blockIdx.x * NWAVES + F.wave, tstep = F.G * NWAVES;
    u32x4 ra[4], rb[4], ro[4];
#pragma unroll
    for (int jj = 0; jj < 4; ++jj) { ra[jj] = *(const GAS u32x4*)(HF + (size_t)t0 * VW + 8 * F.lane + 512 * jj); rb[jj] = *(const GAS u32x4*)(HB + (size_t)t0 * VW + 8 * F.lane + 512 * jj); ro[jj] = *(const GAS u32x4*)(O + (size_t)t0 * VW + 8 * F.lane + 512 * jj); }
    for (int t = t0; t < T; t += tstep) {
        float a[32], o[32];
#pragma unroll
        for (int jj = 0; jj < 4; ++jj) { const unsigned wa[4] = {ra[jj].x, ra[jj].y, ra[jj].z, ra[jj].w}, wb[4] = {rb[jj].x, rb[jj].y, rb[jj].z, rb[jj].w}, wo[4] = {ro[jj].x, ro[jj].y, ro[jj].z, ro[jj].w};
#pragma unroll
            for (int e = 0; e < 4; ++e) { a[8 * jj + 2 * e] = bf_lo(wa[e]) + bf_lo(wb[e]); a[8 * jj + 2 * e + 1] = bf_hi(wa[e]) + bf_hi(wb[e]); o[8 * jj + 2 * e] = bf_lo(wo[e]); o[8 * jj + 2 * e + 1] = bf_hi(wo[e]); } }
        if (t + tstep < T) { const size_t rn = (size_t)(t + tstep) * VW + 8 * F.lane;
#pragma unroll
            for (int jj = 0; jj < 4; ++jj) { ra[jj] = *(const GAS u32x4*)(HF + rn + 512 * jj); rb[jj] = *(const GAS u32x4*)(HB + rn + 512 * jj); ro[jj] = *(const GAS u32x4*)(O + rn + 512 * jj); } }
#pragma unroll
        for (int jj = 0; jj < 4; ++jj) { float s = 0.f;
#pragma unroll
            for (int e = 0; e < 8; ++e) s += a[8 * jj + e];
            const float mean = half_wave_sum(s) * (1.f / 256.f); float s2 = 0.f;
#pragma unroll
            for (int e = 0; e < 8; ++e) { a[8 * jj + e] -= mean; s2 += a[8 * jj + e] * a[8 * jj + e]; }
            const float rstd = 1.f / sqrtf(half_wave_sum(s2) * (1.f / 256.f) + LN_EPS);
#pragma unroll
            for (int e = 0; e < 8; ++e) a[8 * jj + e] = a[8 * jj + e] * rstd * g[8 * jj + e] * __builtin_amdgcn_rcpf(1.f + __expf(-o[8 * jj + e])); }
        { unsigned char* h8 = (unsigned char*)HG + (size_t)t * VW;
#pragma unroll
          for (int jj = 0; jj < 4; ++jj) { int a_ = 0, b_ = 0; a_ = __builtin_amdgcn_cvt_pk_fp8_f32(a[8 * jj], a[8 * jj + 1], a_, false); a_ = __builtin_amdgcn_cvt_pk_fp8_f32(a[8 * jj + 2], a[8 * jj + 3], a_, true);
              b_ = __builtin_amdgcn_cvt_pk_fp8_f32(a[8 * jj + 4], a[8 * jj + 5], b_, false); b_ = __builtin_amdgcn_cvt_pk_fp8_f32(a[8 * jj + 6], a[8 * jj + 7], b_, true);
              *(GAS u32x2*)(h8 + 8 * F.lane + 512 * jj) = (u32x2){(unsigned)a_, (unsigned)b_}; } }
    }
}

struct MoeOrderBase {
    LAS unsigned* X; int G, c, NT;
    __device__ __forceinline__ bool next_(int i, pg8::Unit& u) const {
        const int ntiles = (int)X[XW_NTILES], nwg = ntiles * NT; const long L = (long)i * G + c; if (L >= nwg) return false;
        const int wgid = pg8::xcd_remap((int)L, nwg); const int ti = wgid / NT; u.pn = wgid % NT;
        u.e = __builtin_amdgcn_readfirstlane((int)X[XW_TILE_E + ti]); u.pm = ti - __builtin_amdgcn_readfirstlane((int)X[XW_TPRE + u.e]); u.x = 0; return true;
    }
};
struct E1Prob : MoeOrderBase {
    static constexpr int K = D / 2; static constexpr bool PERM = true, FP8 = true; static constexpr int SCALE_B = 0x79797979;
    const unsigned char* X1; const unsigned char* Wt; const float* bgu; unsigned char* hact; const int* list;
    __device__ __forceinline__ bool next(int i, pg8::Unit& u) const { return next_(i, u); }
    __device__ __forceinline__ void bases(const pg8::Unit& u, const char*& cA, const char*& cB) const { cA = (const char*)X1; cB = (const char*)(Wt + ((size_t)u.e * 1024 + (size_t)u.pn * 256) * D); }
    __device__ __forceinline__ void avoff(const pg8::Unit& u, int tid, unsigned (&v)[2][2]) const {
        const int cnt = (int)X[XW_CNT + u.e];
#pragma unroll
        for (int i = 0; i < 2; ++i) { int R, C; pg8::stage_rc(tid * 16 + i * 8192, R, C);
#pragma unroll
            for (int h = 0; h < 2; ++h) { int idx = u.pm * 256 + h * 128 + R; idx = idx < cnt ? idx : cnt - 1;
                const int tok = __hip_atomic_load((const GAS int*)list + ((size_t)u.e * CAP + idx), RLX_AGENT); v[h][i] = (unsigned)tok * (unsigned)D + (unsigned)C * 2u; } }
    }
    __device__ __forceinline__ void epi(const f32x4 (&acc)[2][2][4][2], const pg8::Unit& u, int wr, int wc, int fr, int fq) const {
        const unsigned slot0 = X[XW_PSTART + u.e] + (unsigned)u.pm * 256u + (unsigned)(wr * 64 + fr);
        const int hc = u.pn * 128 + wc * 32 + 8 * fq;
        const float* bg = bgu + (size_t)u.e * 1024 + hc;
#pragma unroll
        for (int ai = 0; ai < 2; ++ai)
#pragma unroll
            for (int m = 0; m < 4; ++m) { unsigned char* rowp = hact + (size_t)(slot0 + ai * 128 + m * 16) * FF + hc; float o[8];
#pragma unroll
                for (int n = 0; n < 2; ++n) { const f32x4 bgv = *(const GAS f32x4*)(bg + 4 * n), buv = *(const GAS f32x4*)(bg + 512 + 4 * n);
#pragma unroll
                    for (int j = 0; j < 4; ++j) { float gv = acc[ai][0][m][n][j] + bgv[j], uv = acc[ai][1][m][n][j] + buv[j];
                        gv = fminf(gv, 7.0f); uv = fminf(fmaxf(uv, -7.0f), 7.0f);
                        o[4 * n + j] = (uv + 1.0f) * gv * __builtin_amdgcn_rcpf(1.0f + __expf(-1.702f * gv)); } }
                asm volatile("" ::: "memory");
                u32x2 w; { int a_ = 0, b_ = 0; a_ = __builtin_amdgcn_cvt_pk_fp8_f32(o[0], o[1], a_, false); a_ = __builtin_amdgcn_cvt_pk_fp8_f32(o[2], o[3], a_, true);
                    b_ = __builtin_amdgcn_cvt_pk_fp8_f32(o[4], o[5], b_, false); b_ = __builtin_amdgcn_cvt_pk_fp8_f32(o[6], o[7], b_, true); w.x = (unsigned)a_; w.y = (unsigned)b_; }
                *(GAS u32x2*)rowp = w; }
    }
};
struct E2Prob : MoeOrderBase {
    static constexpr int K = FF / 2; static constexpr bool PERM = true, FP8 = true; static constexpr int SCALE_B = 0x79797979;
    const unsigned char* hact; const unsigned char* Wt; const float* bdn; unsigned char* Y;
    __device__ __forceinline__ bool next(int i, pg8::Unit& u) const { return next_(i, u); }
    __device__ __forceinline__ void bases(const pg8::Unit& u, const char*& cA, const char*& cB) const {
        cA = (const char*)(hact + (size_t)(X[XW_PSTART + u.e] + (unsigned)u.pm * 256u) * FF); cB = (const char*)(Wt + ((size_t)u.e * D + (size_t)u.pn * 256) * FF); }
    __device__ __forceinline__ void avoff(const pg8::Unit&, int tid, unsigned (&v)[2][2]) const {
#pragma unroll
        for (int i = 0; i < 2; ++i) { int R, C; pg8::stage_rc(tid * 16 + i * 8192, R, C);
#pragma unroll
            for (int h = 0; h < 2; ++h) v[h][i] = (unsigned)((h * 128 + R) * (FF / 2) + C) * 2u; }
    }
    __device__ __forceinline__ void epi(const f32x4 (&acc)[2][2][4][2], const pg8::Unit& u, int wr, int wc, int fr, int fq) const {
        const unsigned slot0 = X[XW_PSTART + u.e] + (unsigned)u.pm * 256u + (unsigned)(wr * 64 + fr);
        const int c0 = u.pn * 256 + wc * 32 + 8 * fq;
        const float* bp = bdn + (size_t)u.e * D + c0;
        f32x4 bv[2][2];
#pragma unroll
        for (int bj = 0; bj < 2; ++bj)
#pragma unroll
            for (int n = 0; n < 2; ++n) bv[bj][n] = *(const GAS f32x4*)(bp + bj * 128 + 4 * n);
#pragma unroll
        for (int ai = 0; ai < 2; ++ai)
#pragma unroll
            for (int m = 0; m < 4; ++m) { unsigned char* rowp = Y + (size_t)(slot0 + ai * 128 + m * 16) * D + c0;
#pragma unroll
                for (int bj = 0; bj < 2; ++bj) { const f32x4 v0 = (acc[ai][bj][m][0] + bv[bj][0]) * Y_SCALE, v1 = (acc[ai][bj][m][1] + bv[bj][1]) * Y_SCALE;
                    int a_ = 0, b_ = 0; a_ = __builtin_amdgcn_cvt_pk_fp8_f32(v0[0], v0[1], a_, false); a_ = __builtin_amdgcn_cvt_pk_fp8_f32(v0[2], v0[3], a_, true);
                    b_ = __builtin_amdgcn_cvt_pk_fp8_f32(v1[0], v1[1], b_, false); b_ = __builtin_amdgcn_cvt_pk_fp8_f32(v1[2], v1[3], b_, true);
                    *(GAS u32x2*)(rowp + bj * 128) = (u32x2){(unsigned)a_, (unsigned)b_}; } }
    }
};


#define GRID_BAR() do { XcdBarrier bar_; bar_.bar = (unsigned*)(F.ctlp() + CW_BAR); bar_.x = xb_xcc_id(); bar_.st = (volatile LAS unsigned*)(F.X + XW_BAR); F.rethread(); xcd_barrier(bar_, F.tid == 0); } while (0)
#ifndef REP_M1
#define REP_M1 1
#endif
#ifndef REP_OUT
#define REP_OUT 1
#endif
#ifndef REP_G1
#define REP_G1 1
#endif
#ifndef REP_M3
#define REP_M3 1
#endif
#ifndef REP_P0A
#define REP_P0A 1
#endif
#ifndef REP_SCAN
#define REP_SCAN 1
#endif
#ifndef REP_E1
#define REP_E1 1
#endif
#ifndef REP_E2
#define REP_E2 1
#endif
#ifndef REP_G3
#define REP_G3 1
#endif
#ifndef REP_R2
#define REP_R2 1
#endif
#ifndef FILL_E1
#define FILL_E1 20
#endif
#ifndef FILL_E2
#define FILL_E2 3
#endif
#ifndef MOE_LAYER_MASK
#define MOE_LAYER_MASK 15
#endif
template <int layer> __device__ __forceinline__ void moe_layer(Frame& F) {
    if constexpr ((layer & 1) == 1) {
        constexpr int j = layer / 2;
        for (int rep_ = 0; rep_ < REP_G1; ++rep_) {
        { GmlpInProb P; P.A = (const bf16*)(F.wsp() + WS_XB); P.Bt = (const bf16*)(F.wsp() + WS_WGI) + (size_t)j * 4096 * D; P.G = F.G; P.c = (int)blockIdx.x;
          P.bias = F.inp(I_GBIN) + (size_t)j * 4096; P.U = (bf16*)(F.wsp() + WS_GU); P.V = (bf16*)(F.wsp() + WS_GV); P.VSTAT = (float*)(F.wsp() + WS_VSTAT);
          pg8::gemm_phase<GmlpInProb, true>(F.lds, P, F.wave0); }
        GRID_BAR(); }
        for (int rep = 0; rep < REP_G3; ++rep) { g3_phase(F, j); GRID_BAR(); }
        for (int rep_ = 0; rep_ < REP_OUT; ++rep_) {
        { OutProjProb P; P.A = (const bf16*)(F.wsp() + WS_GY); P.Bt = (const bf16*)(F.wsp() + WS_WGO + (size_t)j * D * D); P.G = F.G; P.c = (int)blockIdx.x;
          P.XB = (const bf16*)(F.wsp() + WS_XB); P.PRE = (bf16*)(F.wsp() + WS_PRE);
          pg8::gemm_phase<OutProjProb, true>(F.lds, P, F.wave0); }
        GRID_BAR(); }
    } else {
        constexpr int j = layer / 2;
        for (int rep_ = 0; rep_ < REP_M1; ++rep_) {
        { MlstmInProb P; P.A = (const bf16*)(F.wsp() + WS_XB); P.Bt = (const bf16*)(F.wsp() + WS_WMI) + (size_t)j * MIN_MAIN * D; P.G = F.G; P.c = (int)blockIdx.x;
          P.Q = (bf16*)(F.wsp() + WS_MQ); P.Kb = (bf16*)(F.wsp() + WS_MK); P.V = (bf16*)(F.wsp() + WS_MV); P.O = (bf16*)(F.wsp() + WS_MO);
          pg8::gemm_phase<MlstmInProb, true>(F.lds, P, F.wave0); }
        GRID_BAR(); }
        for (int rep = 0; rep < REP_SCAN; ++rep) { m2_scan(F); GRID_BAR(); }
        for (int rep_ = 0; rep_ < REP_M3; ++rep_) { m3_combine(F, j); GRID_BAR(); }
        for (int rep_ = 0; rep_ < REP_OUT; ++rep_) {
        { OutProjProb P; P.A = (const bf16*)(F.wsp() + WS_HG); P.Bt = (const bf16*)(F.wsp() + WS_WMO + (size_t)j * D * D); P.G = F.G; P.c = (int)blockIdx.x;
          P.XB = (const bf16*)(F.wsp() + WS_XB); P.PRE = (bf16*)(F.wsp() + WS_PRE);
          pg8::gemm_phase<OutProjProb, true>(F.lds, P, F.wave0); }
        GRID_BAR(); }
    }
    r1_phase(F, layer); GRID_BAR();
    moe_tables(F, layer);
    if constexpr ((MOE_LAYER_MASK >> layer) & 1) {
    for (int rep = 0; rep < REP_E1; ++rep) {
    { E1Prob P; P.X = F.X; P.G = F.G; P.c = (int)blockIdx.x; P.NT = 4; P.X1 = (const unsigned char*)(F.wsp() + WS_X1F8); P.Wt = (const unsigned char*)(F.wsp() + WS_WGU) + (size_t)layer * 32 * 1024 * D;
      P.bgu = F.inp(I_EBGU) + (size_t)layer * 32 * 1024; P.hact = (unsigned char*)(F.wsp() + WS_HACT); P.list = (const int*)(F.wsp() + WS_LIST);
      pg8::gemm_phase<E1Prob, true>(F.lds, P, F.wave0); }
    if constexpr (layer + 1 < DEPTH) { const int nwg = (int)F.X[XW_NTILES] * 4, c = (int)blockIdx.x; const int mine = nwg > c ? (nwg - c + F.G - 1) / F.G : 0, most = (nwg + F.G - 1) / F.G;
        if (mine < most) cvt_fill(F, layer + 1, FILL_E1); }
    GRID_BAR(); }
    for (int rep = 0; rep < REP_E2; ++rep) {
    { E2Prob P; P.X = F.X; P.G = F.G; P.c = (int)blockIdx.x; P.NT = 8; P.hact = (const unsigned char*)(F.wsp() + WS_HACT); P.Wt = (const unsigned char*)(F.wsp() + WS_WDN) + (size_t)layer * 32 * D * FF;
      P.bdn = F.inp(I_EBDN) + (size_t)layer * 32 * D; P.Y = (unsigned char*)(F.wsp() + WS_Y);
      pg8::gemm_phase<E2Prob, true>(F.lds, P, F.wave0); }
    if constexpr (layer + 1 < DEPTH) { const int nwg = (int)F.X[XW_NTILES] * 8, c = (int)blockIdx.x; const int mine = nwg > c ? (nwg - c + F.G - 1) / F.G : 0, most = (nwg + F.G - 1) / F.G;
        if (mine < most) cvt_fill(F, layer + 1, FILL_E2); }
    GRID_BAR(); }
    }
    if constexpr (layer + 1 < DEPTH) cvt_fill(F, layer + 1, -1);
    for (int rep_ = 0; rep_ < REP_R2; ++rep_) {     r2_phase(F, layer, layer == DEPTH - 1, (layer + 1 < DEPTH && ((layer + 1) & 1) == 0) ? (layer + 1) / 2 : -1, ((MOE_LAYER_MASK >> layer) & 1) ? 4 : 0); GRID_BAR(); }
}

struct Args { const float* in[20]; float* out; unsigned char* ws; };
__global__ void __launch_bounds__(NTHREADS, 2) fwd(Args args) {
    extern __shared__ __attribute__((aligned(16))) unsigned char lds_raw[];
    Frame F;
    F.lds = (LAS unsigned char*)lds_raw; F.X = (LAS unsigned*)(F.lds + LDSX_OFF);
    F.tid = threadIdx.x; F.lane = F.tid & 63; F.wave = __builtin_amdgcn_readfirstlane(F.tid >> 6); F.wave0 = F.wave; F.G = gridDim.x;
    F.ws_ = args.ws;
    for (int u = F.tid; u < XW_WORDS; u += NTHREADS) F.X[u] = 0u;
    __syncthreads();
    if (F.tid == 0) {
#pragma unroll
        for (int i = 0; i < 20; ++i) { const unsigned long long p = (unsigned long long)args.in[i]; F.X[XW_INP + 2 * i] = (unsigned)p; F.X[XW_INP + 2 * i + 1] = (unsigned)(p >> 32); }
        { const unsigned long long p = (unsigned long long)args.out; F.X[XW_INP + 40] = (unsigned)p; F.X[XW_INP + 41] = (unsigned)(p >> 32); } }
    __syncthreads();
    (void)xcd_barrier_post((unsigned*)(F.ctlp() + CW_BAR), (volatile LAS unsigned*)(F.X + XW_BAR));

    for (int rep = 0; rep < REP_P0A; ++rep) { p0a_weights(F); GRID_BAR(); }
    p0b_rows(F); GRID_BAR();
#define GRID_BAR_() GRID_BAR()
    moe_layer<0>(F); moe_layer<1>(F); moe_layer<2>(F); moe_layer<3>(F);
}

extern "C" void kernel_launch(void* const* d_in, const int* in_sizes, int n_in, void* d_out, int out_size, void* d_ws, size_t ws_size, hipStream_t stream) {
    static int grid = 0;
    if (grid == 0) {
        if (n_in != 20 || out_size != T * D || ws_size < WS_END) { fprintf(stderr, "kernel_launch: unexpected shapes (n_in %d out %d ws %zu need %zu)\n", n_in, out_size, ws_size, (size_t)WS_END); grid = -1; return; }
        int dev = 0, cus = 0, per_cu = 0;
        if (hipGetDevice(&dev) != hipSuccess || hipDeviceGetAttribute(&cus, hipDeviceAttributeMultiprocessorCount, dev) != hipSuccess) { grid = -1; return; }
        if (hipFuncSetAttribute((const void*)fwd, hipFuncAttributeMaxDynamicSharedMemorySize, LDS_BYTES) != hipSuccess) { fprintf(stderr, "kernel_launch: hipFuncSetAttribute failed\n"); grid = -1; return; }
        if (hipOccupancyMaxActiveBlocksPerMultiprocessor(&per_cu, (const void*)fwd, NTHREADS, LDS_BYTES) != hipSuccess || per_cu < 1) { fprintf(stderr, "kernel_launch: occupancy query says %d\n", per_cu); }
        (void)hipGetLastError();
        grid = cus;
    }
    if (grid < 0) return;
    if (hipMemsetAsync((char*)d_ws + WS_CTL, 0, CTL_ZERO_BYTES, stream) != hipSuccess) return;
    Args a{};
    for (int i = 0; i < 20; ++i) a.in[i] = (const float*)d_in[i];
    a.out = (float*)d_out; a.ws = (unsigned char*)d_ws;
    hipLaunchKernelGGL(fwd, dim3(grid), dim3(NTHREADS), LDS_BYTES, stream, a);
    const hipError_t le = hipPeekAtLastError();
    if (le != hipSuccess) fprintf(stderr, "kernel_launch: launch failed: %s\n", hipGetErrorName(le));
}
```

```cpp
#include <utility>
#include <type_traits>
#include <hip/hip_runtime.h>
#include <cstdio>
#include <cstdint>

#define LAS __attribute__((address_space(3)))
#define GAS __attribute__((address_space(1)))
typedef unsigned short bf16;
typedef short bf16x8 __attribute__((ext_vector_type(8)));
typedef short s16x4 __attribute__((ext_vector_type(4)));
typedef float f32x4 __attribute__((ext_vector_type(4)));
typedef float f32x2 __attribute__((ext_vector_type(2)));
typedef unsigned u32x4 __attribute__((ext_vector_type(4)));
typedef unsigned u32x2 __attribute__((ext_vector_type(2)));
typedef GAS unsigned gu32;
#define RLX_AGENT __ATOMIC_RELAXED, __HIP_MEMORY_SCOPE_AGENT

constexpr int T = 16384, D = 2048, DEPTH = 4, SEQ = 4096, NBATCH = 4;
constexpr int NE = 32, TOPK = 4, FF = 512;
constexpr int HEADS = 8, DV = 256, DK = 128, QKW = 1024, VW = 2048, MIN_COLS = 6176, MIN_MAIN = 6144;
constexpr int CAP = T;
constexpr int MAXSLOT = T * TOPK + NE * 256;
constexpr float ALPHA = 1.6817928305074290f;
constexpr float LN_EPS = 1e-5f;
constexpr float Y_SCALE = 16.0f;
constexpr int NWAVES = 8, NTHREADS = 512;
#ifndef EXP_NO_MOE
#define EXP_NO_MOE 0
#endif

constexpr size_t MiB = 1u << 20;
constexpr size_t WS_CTL = 0, CTL_ZERO_BYTES = 1 * MiB;
constexpr size_t WS_WGU = 1 * MiB;
constexpr size_t WS_WDN = WS_WGU + 512 * MiB;
constexpr size_t WS_WMI = WS_WDN + 256 * MiB;
constexpr size_t WS_WMO = WS_WMI + 48 * MiB;
constexpr size_t WS_WGI = WS_WMO + 16 * MiB;
constexpr size_t WS_WGO = WS_WGI + 32 * MiB;
constexpr size_t WS_WSM = WS_WGO + 16 * MiB;
constexpr size_t WS_WG_T = WS_WSM, WS_WR_T = WS_WSM + 256 * 1024, WS_WS = WS_WSM + 768 * 1024;
constexpr size_t WS_XB = WS_WSM + 2 * MiB;
constexpr size_t WS_X1 = WS_XB + 64 * MiB;
constexpr size_t WS_PRE = WS_X1 + 64 * MiB;
constexpr size_t WS_MIX = WS_PRE + 64 * MiB;
constexpr size_t WS_HACT = WS_MIX + 384 * MiB;
constexpr size_t WS_Y = WS_HACT + 72 * MiB;
constexpr size_t WS_LIST = WS_Y + 288 * MiB;
constexpr size_t WS_TOK = WS_LIST + 2 * MiB;
constexpr size_t WS_GATES = WS_TOK + 1 * MiB;
constexpr size_t WS_X1F8 = WS_GATES + 2 * MiB;
constexpr size_t WS_END = WS_X1F8 + 32 * MiB;

constexpr size_t WS_GU = WS_MIX, WS_GV = WS_MIX + 64 * MiB, WS_GY = WS_MIX + 128 * MiB, WS_VSTAT = WS_MIX + 192 * MiB;
constexpr size_t WS_MQ = WS_MIX, WS_MK = WS_MIX + 32 * MiB, WS_MV = WS_MIX + 64 * MiB, WS_MO = WS_MIX + 128 * MiB, WS_HF = WS_MIX + 192 * MiB, WS_HB = WS_MIX + 256 * MiB, WS_HG = WS_MIX + 320 * MiB;
constexpr int CW_TMO = 0, CW_CODE = 1, CW_BAR = 4096, CW_CNT = 8192;

constexpr int RING_BYTES = 131072;
constexpr int LDS_BYTES = 163840;
constexpr int LDSX_OFF = LDS_BYTES - 4096;
constexpr int XW_BAR = 8, XW_LCNT = 64, XW_LBASE = 96, XW_CNT = 128, XW_TPRE = 160, XW_PSTART = 200, XW_NTILES = 232, XW_TILE_E = 256, XW_INP = 600, XW_WORDS = 1024;
constexpr int XT_PITCH = 4112;
constexpr int RP_PART = 66048, RP_LOG = 82944, LOGP = 36, RP_GB = 90112, RP_LOGA = 106496;

__device__ __forceinline__ unsigned f2bf(float f) { unsigned u = __builtin_bit_cast(unsigned, f); return (u + 0x7fffu + ((u >> 16) & 1u)) >> 16; }
__device__ __forceinline__ unsigned cvt_pk_bf16_nop(float lo, float hi) { unsigned r; asm volatile("v_cvt_pk_bf16_f32 %0, %1, %2\n\ts_nop 1" : "=v"(r) : "v"(lo), "v"(hi)); return r; }
__device__ __forceinline__ unsigned cvt_pk_bf16(float lo, float hi) { unsigned r; asm volatile("v_cvt_pk_bf16_f32 %0, %1, %2" : "=v"(r) : "v"(lo), "v"(hi)); return r; }
__device__ __forceinline__ float bf_lo(unsigned w) { return __builtin_bit_cast(float, w << 16); }
__device__ __forceinline__ float bf_hi(unsigned w) { return __builtin_bit_cast(float, w & 0xffff0000u); }
__device__ __forceinline__ float wave_sum(float v) {
#pragma unroll
    for (int o = 1; o < 64; o <<= 1) v += __shfl_xor(v, o);
    return v;
}
#define LDS_WAIT() asm volatile("s_waitcnt lgkmcnt(0)" ::: "memory")
#define VM_WAIT() asm volatile("s_waitcnt vmcnt(0)" ::: "memory")

namespace pg8 {
constexpr int BM = 256, BK = 64, HALF = 128, HTB = HALF * BK * 2, STAGE_BYTES = 8 * HTB, NXCD = 8, WGM = 8;
__host__ __device__ __forceinline__ int lds_byte(int r, int c) { const int st = (r >> 4) * 2 + (c >> 5), rr = r & 15, cc = c & 31, ob = rr * 64 + cc * 2; return st * 1024 + (ob ^ (((ob >> 9) & 1) << 5)); }
__host__ __device__ __forceinline__ void stage_rc(int b, int& R, int& C) { const int st = b / 1024, sb = b % 1024, swz = sb ^ (((sb >> 9) & 1) << 5); R = (st >> 1) * 16 + swz / 64; C = (st & 1) * 32 + (swz % 64) / 2; }
__host__ __device__ __forceinline__ int perm32(int rho) { const int n = rho >> 4, i = rho & 15; return 8 * (i >> 2) + 4 * n + (i & 3); }

struct Unit { int pm, pn, e, x; };
typedef int v8i_t __attribute__((ext_vector_type(8)));
typedef int v4i_t __attribute__((ext_vector_type(4)));
__device__ __forceinline__ v8i_t cat_v8(bf16x8 lo, bf16x8 hi) { return __builtin_shufflevector(__builtin_bit_cast(v4i_t, lo), __builtin_bit_cast(v4i_t, hi), 0, 1, 2, 3, 4, 5, 6, 7); }

__device__ __forceinline__ void mfma_f8_tied(f32x4& acc, v8i_t a, v8i_t b, int sa, int sb) {
    asm volatile("v_mfma_scale_f32_16x16x128_f8f6f4 %0, %1, %2, %0, %3, %4 op_sel_hi:[0,0,0]" : "+v"(acc) : "v"(a), "v"(b), "v"(sa), "v"(sb));
}
__device__ __forceinline__ int xcd_remap(int wgid, int nwg) { const int q = nwg / NXCD, r = nwg % NXCD, xcd = wgid % NXCD, off = wgid / NXCD; return (xcd < r ? xcd * (q + 1) : r * (q + 1) + (xcd - r) * q) + off; }

template <class Prob, bool ALIGN_EPI = true>
__device__ __forceinline__ void gemm_phase(LAS unsigned char* lds, const Prob& P, int wave_id) {
    int wid = wave_id; asm volatile("" : "+s"(wid)); unsigned z_ = 0u; asm volatile("" : "+v"(z_)); const int lane = (int)__builtin_amdgcn_mbcnt_hi(~0u, __builtin_amdgcn_mbcnt_lo(~0u, z_));
    const int tid = wid * 64 + lane, wr = wid >> 2, wc = wid & 3, fr = lane & 15, fq = lane >> 4;
    constexpr int K = Prob::K, nt = K / BK;
    unsigned voffB[2];
#pragma unroll
    for (int i = 0; i < 2; ++i) { int R, C; stage_rc(tid * 16 + i * 8192, R, C); const int Rb = Prob::PERM ? ((R & ~31) + perm32(R & 31)) : R;
        voffB[i] = (unsigned)(Rb * K + C) * 2u; }
    const size_t kstep = (size_t)(BK * 2);
    const size_t hstep = (size_t)HALF * K * 2;
    const unsigned ldsw = (unsigned)wid * 1024u;
    const int aoff = lds_byte(wr * 64 + fr, fq * 8), boff = lds_byte(wc * 32 + fr, fq * 8);
#define PG8_SA(b, h) (((b) * 2 + (h)) * HTB)
#define PG8_SB(b, h) ((4 + (b) * 2 + (h)) * HTB)
#define PG8_STAGE(bufoff, gbase, v0, v1) do { \
        __builtin_amdgcn_global_load_lds((const unsigned*)((const char*)(gbase) + (v0)), (LAS unsigned*)(lds + (bufoff) + ldsw), 16, 0, 0); \
        __builtin_amdgcn_global_load_lds((const unsigned*)((const char*)(gbase) + (v1)), (LAS unsigned*)(lds + (bufoff) + ldsw + 8192), 16, 0, 0); } while (0)
#define PG8_STB(bufoff, gbase) PG8_STAGE(bufoff, gbase, voffB[0], voffB[1])
#define PG8_LDA(dst, b, h) do { _Pragma("unroll") for (int m = 0; m < 4; ++m) _Pragma("unroll") for (int k = 0; k < 2; ++k) dst[m][k] = *(const LAS bf16x8*)(lds + PG8_SA(b, h) + aoff + m * 2048 + k * 1024); } while (0)
#define PG8_LDB(dst, b, h) do { _Pragma("unroll") for (int n = 0; n < 2; ++n) _Pragma("unroll") for (int k = 0; k < 2; ++k) dst[n][k] = *(const LAS bf16x8*)(lds + PG8_SB(b, h) + boff + n * 2048 + k * 1024); } while (0)
#define PG8_MMA(ai, bj, At, Bt) do { __builtin_amdgcn_s_setprio(1); \
        if constexpr (Prob::FP8) { asm volatile("s_nop 1" ::: "memory"); _Pragma("unroll") for (int m = 0; m < 4; ++m) _Pragma("unroll") for (int n = 0; n < 2; ++n) \
            mfma_f8_tied(acc[ai][bj][m][n], cat_v8(Bt[n][0], Bt[n][1]), cat_v8(At[m][0], At[m][1]), sc_w, sc_x); } \
        else { _Pragma("unroll") for (int m = 0; m < 4; ++m) _Pragma("unroll") for (int n = 0; n < 2; ++n) _Pragma("unroll") for (int k = 0; k < 2; ++k) \
            acc[ai][bj][m][n] = __builtin_amdgcn_mfma_f32_16x16x32_bf16(Bt[n][k], At[m][k], acc[ai][bj][m][n], 0, 0, 0); } \
        __builtin_amdgcn_s_setprio(0); } while (0)
#define PG8_WAIT_V(n) asm volatile("s_waitcnt vmcnt(" #n ")" ::: "memory")
#define PG8_WAIT_L(n) asm volatile("s_waitcnt lgkmcnt(" #n ")" ::: "memory")
#define PG8_BAR __builtin_amdgcn_s_barrier()
#define PG8_SCHED __builtin_amdgcn_sched_barrier(0)
    Unit cur, nxt; int ui = 0;
    if (!P.next(0, cur)) return;
    int sc_w = Prob::SCALE_B, sc_x = 0x7f7f7f7f; if constexpr (Prob::FP8) { asm volatile("" : "+v"(sc_w), "+v"(sc_x)); }
    float zf_ = 0.f; asm volatile("" : "+v"(zf_)); const f32x4 zero4 = (f32x4){zf_, zf_, zf_, zf_};
    f32x4 acc[2][2][4][2];
#pragma unroll
    for (int a = 0; a < 2; ++a)
#pragma unroll
        for (int b = 0; b < 2; ++b)
#pragma unroll
            for (int m = 0; m < 4; ++m)
#pragma unroll
                for (int n = 0; n < 2; ++n) acc[a][b][m][n] = zero4;
    bf16x8 At[4][2], B0[2][2], B1[2][2];
    const char* cA; const char* cB; unsigned va[2][2], vn[2][2];
    P.bases(cur, cA, cB); P.avoff(cur, tid, va);
    PG8_STB(PG8_SB(0, 0), cB); PG8_STB(PG8_SB(0, 1), cB + hstep); PG8_STAGE(PG8_SA(0, 0), cA, va[0][0], va[0][1]); PG8_STAGE(PG8_SA(0, 1), cA, va[1][0], va[1][1]);
    if (wr == 1) PG8_BAR;
    PG8_WAIT_V(2); PG8_BAR;
    PG8_STB(PG8_SB(1, 0), cB + kstep); PG8_STAGE(PG8_SA(1, 0), cA + kstep, va[0][0], va[0][1]); PG8_STB(PG8_SB(1, 1), cB + hstep + kstep);
    PG8_WAIT_V(6); PG8_BAR;
    for (;;) {
        const bool has_next = P.next(ui + 1, nxt);
        const char* nA = cA; const char* nB = cB;
#pragma unroll
        for (int h = 0; h < 2; ++h)
#pragma unroll
            for (int i = 0; i < 2; ++i) vn[h][i] = va[h][i];
        if (has_next) { P.bases(nxt, nA, nB); P.avoff(nxt, tid, vn); }
        for (int t = 0; t < nt; t += 2) {
            const bool last = (t == nt - 2);
            const char* a1 = cA + (size_t)(t + 1) * kstep;
            const char* a2 = last ? nA : cA + (size_t)(t + 2) * kstep; const char* b2 = last ? nB : cB + (size_t)(t + 2) * kstep;
            const char* a3 = a2 + kstep; const char* b3 = b2 + kstep;
            const unsigned s00 = last ? vn[0][0] : va[0][0], s01 = last ? vn[0][1] : va[0][1], s10 = last ? vn[1][0] : va[1][0], s11 = last ? vn[1][1] : va[1][1];
            PG8_LDB(B0, 0, 0); PG8_LDB(B1, 0, 1); PG8_SCHED; PG8_LDA(At, 0, 0); PG8_STAGE(PG8_SA(1, 1), a1, va[1][0], va[1][1]);
            PG8_WAIT_V(8); PG8_WAIT_L(0); PG8_BAR; PG8_MMA(0, 0, At, B0); PG8_MMA(0, 1, At, B1); PG8_BAR; PG8_SCHED;
            PG8_LDA(At, 0, 1); PG8_STB(PG8_SB(0, 0), b2); PG8_STB(PG8_SB(0, 1), b2 + hstep); PG8_STAGE(PG8_SA(0, 0), a2, s00, s01);
            PG8_WAIT_V(8); PG8_WAIT_L(0); PG8_BAR; PG8_MMA(1, 0, At, B0); PG8_MMA(1, 1, At, B1); PG8_BAR; PG8_SCHED;
            PG8_LDB(B0, 1, 0); PG8_LDB(B1, 1, 1); PG8_SCHED; PG8_LDA(At, 1, 0); PG8_STAGE(PG8_SA(0, 1), a2, s10, s11);
            PG8_WAIT_V(8); PG8_WAIT_L(0); PG8_BAR; PG8_MMA(0, 0, At, B0); PG8_MMA(0, 1, At, B1); PG8_BAR; PG8_SCHED;
            PG8_LDA(At, 1, 1); PG8_STB(PG8_SB(1, 0), b3); PG8_STB(PG8_SB(1, 1), b3 + hstep); PG8_STAGE(PG8_SA(1, 0), a3, s00, s01);
            PG8_WAIT_V(8); PG8_WAIT_L(0); PG8_BAR; PG8_MMA(1, 0, At, B0); PG8_MMA(1, 1, At, B1); PG8_BAR; PG8_SCHED;
        }
        if constexpr (ALIGN_EPI) { if (wr == 0) PG8_BAR; }
        if constexpr (Prob::FP8) asm volatile("s_nop 15\n\ts_nop 15" ::: "memory");
        P.epi(acc, cur, wr, wc, fr, fq);
        if (!has_next) break;
#pragma unroll
        for (int a = 0; a < 2; ++a)
#pragma unroll
            for (int b = 0; b < 2; ++b)
#pragma unroll
                for (int m = 0; m < 4; ++m)
#pragma unroll
                    for (int n = 0; n < 2; ++n) acc[a][b][m][n] = zero4;
        cur = nxt; cA = nA; cB = nB; ++ui;
#pragma unroll
        for (int h = 0; h < 2; ++h)
#pragma unroll
            for (int i = 0; i < 2; ++i) va[h][i] = vn[h][i];
        if constexpr (ALIGN_EPI) { if (wr == 1) PG8_BAR; }
    }
    PG8_WAIT_V(0);
    if constexpr (!ALIGN_EPI) { if (wr == 0) PG8_BAR; }
    PG8_BAR;
#undef PG8_SA
#undef PG8_SB
#undef PG8_STAGE
#undef PG8_STB
#undef PG8_LDA
#undef PG8_LDB
#undef PG8_MMA
#undef PG8_WAIT_V
#undef PG8_WAIT_L
#undef PG8_BAR
#undef PG8_SCHED
}
}

#define XB_TMO      128
#define XB_XCNT(j)  (256  + 64 * (j))
#define XB_XSUB(j)  (1280 + 64 * (j))
#define XB_XGEN(j)  (2304 + 64 * (j))
#define XB_TOP      3328
#define XB_TOPGEN   3392
#define XCD_BAR_WORDS 3456
#define XB_SPIN_CAP (1u << 18)
__device__ __forceinline__ unsigned xb_ld(unsigned* p)              { return __hip_atomic_load(p, __ATOMIC_RELAXED, __HIP_MEMORY_SCOPE_AGENT); }
__device__ __forceinline__ unsigned xb_add(unsigned* p, unsigned v) { return __hip_atomic_fetch_add(p, v, __ATOMIC_RELAXED, __HIP_MEMORY_SCOPE_AGENT); }
__device__ __forceinline__ unsigned xb_xcc_id() { return (unsigned)__builtin_amdgcn_s_getreg((3 << 11) | 20) & 0xFu; }
#define XB_SPIN(cond, bar) do { unsigned _sp = 0; while (cond) { __builtin_amdgcn_s_sleep(1); \
    if ((++_sp & 255u) == 0u) { if (xb_ld(&(bar)[XB_TMO])) break; if (_sp > XB_SPIN_CAP) { atomicAdd(&(bar)[XB_TMO], 1u); break; } } } } while (0)
struct XcdBarrier { unsigned* bar; unsigned x; volatile LAS unsigned* st; };
__device__ __forceinline__ XcdBarrier xcd_barrier_post(unsigned* bar, volatile LAS unsigned* st) {
    XcdBarrier b; b.bar = bar; b.x = xb_xcc_id(); b.st = st;
    if (threadIdx.x == 0) (void)xb_add(&bar[XB_XCNT(b.x)], 1u);
    return b;
}
__device__ __forceinline__ void xcd_barrier_complete(unsigned* bar, unsigned x, unsigned& nloc, unsigned& nx) {
    const unsigned G = gridDim.x * gridDim.y * gridDim.z;
    unsigned sum, cnt, mine, sp = 0u;
    for (;;) {
        sum = 0u; cnt = 0u; mine = 0u;
#pragma unroll
        for (unsigned j = 0; j < 16; ++j) { const unsigned c = xb_ld(&bar[XB_XCNT(j)]); sum += c; cnt += (c > 0u) ? 1u : 0u; mine = (j == x) ? c : mine; }
        if (sum == G) break;
        __builtin_amdgcn_s_sleep(1);
        if ((++sp & 255u) == 0u) { if (xb_ld(&bar[XB_TMO])) break; if (sp > XB_SPIN_CAP) { atomicAdd(&bar[XB_TMO], 1u); break; } }
    }
    nloc = mine > 0u ? mine : 1u; nx = cnt > 0u ? cnt : 1u;
}
__device__ __forceinline__ void xcd_barrier(const XcdBarrier& b, bool is_t0) {
    asm volatile("s_waitcnt vmcnt(0)" ::: "memory");
    __syncthreads();
    if (is_t0) {
        unsigned* bar = b.bar;
        __builtin_amdgcn_s_waitcnt(0);
        unsigned nloc = b.st[0], nx = b.st[1];
        if (nloc == 0u) { xcd_barrier_complete(bar, b.x, nloc, nx); b.st[0] = nloc; b.st[1] = nx; }
        const unsigned old = xb_add(&bar[XB_XSUB(b.x)], 1u);
        const unsigned gen = old / nloc;
        if (old + 1u == (gen + 1u) * nloc) {
            __builtin_amdgcn_fence(__ATOMIC_RELEASE, "agent");
            asm volatile("s_waitcnt vmcnt(0)" ::: "memory");
            const unsigned og = xb_add(&bar[XB_TOP], 1u);
            const unsigned tg = og / nx;
            if (og + 1u == (tg + 1u) * nx) xb_add(&bar[XB_TOPGEN], 1u);
            else XB_SPIN(xb_ld(&bar[XB_TOPGEN]) == tg, bar);
            __builtin_amdgcn_fence(__ATOMIC_ACQUIRE, "agent");
            xb_add(&bar[XB_XGEN(b.x)], 1u);
            asm volatile("s_waitcnt vmcnt(0)" ::: "memory");
        } else {
            XB_SPIN(xb_ld(&bar[XB_XGEN(b.x)]) == gen, bar);
            __builtin_amdgcn_fence(__ATOMIC_ACQUIRE, "agent");
            asm volatile("s_waitcnt vmcnt(0)" ::: "memory");
        }
    }
    __syncthreads();
}

struct Frame {
    LAS unsigned char* lds;
    LAS unsigned* X;
    unsigned char* ws_;
    int tid, lane, wave, G;
    __device__ __forceinline__ unsigned char* wsp() const { unsigned char* p = ws_; asm volatile("" : "+s"(p)); return p; }
    __device__ __forceinline__ gu32* ctlp() const { return (gu32*)(wsp() + WS_CTL); }
    __device__ __forceinline__ float* outp() const { return (float*)inp(20); }
    __device__ __forceinline__ const float* inp(int i) const { const unsigned lo = __builtin_amdgcn_readfirstlane(X[XW_INP + 2 * i]), hi = __builtin_amdgcn_readfirstlane(X[XW_INP + 2 * i + 1]);
        return (const float*)(((unsigned long long)hi << 32) | lo); }
    int wave0;
    __device__ __forceinline__ void rethread() { int w = wave0; asm volatile("" : "+s"(w)); unsigned z = 0u; asm volatile("" : "+v"(z)); const int l = (int)__builtin_amdgcn_mbcnt_hi(~0u, __builtin_amdgcn_mbcnt_lo(~0u, z)); wave = w; lane = l; tid = w * 64 + l; }
};
enum { I_X = 0, I_MWIN, I_MBG, I_MNG, I_MWOUT, I_GWIN, I_GBIN, I_GVG, I_GVB, I_GWS, I_GBS, I_GWOUT, I_RW, I_RB, I_EWGU, I_EBGU, I_EWDN, I_EBDN, I_LNG, I_LNB };

constexpr int TR_P = 65, TR_WAVE_BYTES = 64 * TR_P * 4;
__device__ __forceinline__ void tr_item64(const float* W, int N, int k0, int n0, bf16* dst, int Kd, LAS float* scr, int lane) {
    f32x4 v[16];
#pragma unroll
    for (int i = 0; i < 16; ++i) v[i] = *(const GAS f32x4*)(W + (size_t)(k0 + 4 * i + (lane >> 4)) * N + n0 + (lane & 15) * 4);
#pragma unroll
    for (int i = 0; i < 16; ++i) { LAS float* p = scr + (4 * i + (lane >> 4)) * TR_P + (lane & 15) * 4; p[0] = v[i].x; p[1] = v[i].y; p[2] = v[i].z; p[3] = v[i].w; }
    LDS_WAIT(); asm volatile("" ::: "memory");
    const int c = lane & 7;
#pragma unroll
    for (int j = 0; j < 8; ++j) { const int n = (lane >> 3) + 8 * j; const LAS float* s = scr + (8 * c) * TR_P + n;
        u32x4 o; o.x = cvt_pk_bf16(s[0 * TR_P], s[1 * TR_P]); o.y = cvt_pk_bf16(s[2 * TR_P], s[3 * TR_P]); o.z = cvt_pk_bf16(s[4 * TR_P], s[5 * TR_P]); o.w = cvt_pk_bf16(s[6 * TR_P], s[7 * TR_P]);
        *(GAS u32x4*)(dst + (size_t)n * Kd + k0 + 8 * c) = o; }
    LDS_WAIT(); asm volatile("" ::: "memory");
}
__device__ __forceinline__ void tr_item64_f8(const float* W, int N, int k0, int n0, unsigned char* dst, int Kd, LAS float* scr, int lane, float wscale = 64.f) {
    f32x4 v[16];
#pragma unroll
    for (int i = 0; i < 16; ++i) v[i] = *(const GAS f32x4*)(W + (size_t)(k0 + 4 * i + (lane >> 4)) * N + n0 + (lane & 15) * 4);
#pragma unroll
    for (int i = 0; i < 16; ++i) { LAS float* p = scr + (4 * i + (lane >> 4)) * TR_P + (lane & 15) * 4; p[0] = v[i].x; p[1] = v[i].y; p[2] = v[i].z; p[3] = v[i].w; }
    LDS_WAIT(); asm volatile("" ::: "memory");
    const int c = lane & 3;
#pragma unroll
    for (int j = 0; j < 4; ++j) { const int n = (lane >> 2) + 16 * j; const LAS float* s = scr + (16 * c) * TR_P + n; unsigned w[4];
#pragma unroll
        for (int g = 0; g < 4; ++g) { int a_ = 0; a_ = __builtin_amdgcn_cvt_pk_fp8_f32(s[(4 * g) * TR_P] * wscale, s[(4 * g + 1) * TR_P] * wscale, a_, false); a_ = __builtin_amdgcn_cvt_pk_fp8_f32(s[(4 * g + 2) * TR_P] * wscale, s[(4 * g + 3) * TR_P] * wscale, a_, true); w[g] = (unsigned)a_; }
        *(GAS u32x4*)(dst + (size_t)n * Kd + k0 + 16 * c) = (u32x4){w[0], w[1], w[2], w[3]}; }
    LDS_WAIT(); asm volatile("" ::: "memory");
}
__device__ __forceinline__ void tr_item(const float* W, int N, int k0, int n0, bf16* dst, int Kd, LAS float* scr, int lane) {
#pragma unroll 8
    for (int i = 0; i < 32; ++i) { const int kk = 2 * i + (lane >> 5); scr[kk * 33 + (lane & 31)] = W[(size_t)(k0 + kk) * N + n0 + (lane & 31)]; }
    LDS_WAIT(); asm volatile("" ::: "memory");
    const int c = lane & 7;
#pragma unroll
    for (int j = 0; j < 4; ++j) { const int n = (lane >> 3) + 8 * j; const LAS float* s = scr + (8 * c) * 33 + n;
        u32x4 o; o.x = cvt_pk_bf16(s[0 * 33], s[1 * 33]); o.y = cvt_pk_bf16(s[2 * 33], s[3 * 33]); o.z = cvt_pk_bf16(s[4 * 33], s[5 * 33]); o.w = cvt_pk_bf16(s[6 * 33], s[7 * 33]);
        *(GAS u32x4*)(dst + (size_t)n * Kd + k0 + 8 * c) = o; }
    LDS_WAIT(); asm volatile("" ::: "memory");
}

constexpr int CVT_ITEMS = 32 * 32 * 16 + 32 * 8 * 32, CW_CVT = 24576, XW_CVT = 660;
__device__ __forceinline__ void cvt_moe_item(Frame& F, int L, int idx, LAS float* scr) {
    if (idx < 32 * 512) { const int le = L * 32 + idx / 512, q = idx % 512, kb = q % 32, nb = q / 32;
        const int n0 = nb * 64, half = n0 >> 9, nn = n0 & 511, row = (nn >> 7) * 256 + half * 128 + (nn & 127);
        tr_item64_f8(F.inp(I_EWGU) + (size_t)le * D * 1024, 1024, kb * 64, n0, (unsigned char*)(F.wsp() + WS_WGU) + ((size_t)le * 1024 + row) * D, D, scr, F.lane); }
    else { const int r = idx - 32 * 512; const int le = L * 32 + r / 256, q = r % 256, kb = q % 8, nb = q / 8;
        tr_item64_f8(F.inp(I_EWDN) + (size_t)le * FF * D, D, kb * 64, nb * 64, (unsigned char*)(F.wsp() + WS_WDN) + ((size_t)le * D + nb * 64) * FF, FF, scr, F.lane); }
}
__device__ __forceinline__ void cvt_fill(Frame& F, int L, int max_batches) {
    F.rethread();
    LAS float* scr = (LAS float*)(F.lds + F.wave * TR_WAVE_BYTES);
    gu32* ctr = F.ctlp() + CW_CVT + L * 64;
#pragma unroll 1
    for (int bt = 0; max_batches < 0 || bt < max_batches; ++bt) {
        if (F.tid == 0) F.X[XW_CVT] = __hip_atomic_fetch_add(ctr, 8u, RLX_AGENT);
        __syncthreads();
        const int base = (int)F.X[XW_CVT];
        __syncthreads();
        if (base >= CVT_ITEMS) break;
        const int idx = base + F.wave; if (idx < CVT_ITEMS) cvt_moe_item(F, L, idx, scr);
    }
    __syncthreads();
}
constexpr int P0_S0 = 2 * 32 * 96, P0_S1 = 2 * 32 * 32, P0_S2 = 2 * 32 * 64, P0_S3 = 2 * 32 * 32, P0_NI64 = P0_S0 + P0_S1 + P0_S2 + P0_S3 + CVT_ITEMS;
__device__ __forceinline__ void p0a_decode(Frame& F, int it, const float*& src, int& N, unsigned char*& dst, int& Kd, int& f8, float& scale) {
    int r = it;
    if (r < P0_S0) { const int j = r / (32 * 96), q = r % (32 * 96), kb = q % 32, nb = q / 32;
        src = F.inp(I_MWIN) + (size_t)j * D * MIN_COLS + (size_t)(kb * 64) * MIN_COLS + nb * 64; N = MIN_COLS; dst = (unsigned char*)((bf16*)(F.wsp() + WS_WMI) + ((size_t)j * MIN_MAIN + nb * 64) * D + kb * 64); Kd = D; f8 = 0; scale = 1.f; return; } r -= P0_S0;
    if (r < P0_S1) { const int j = r / 1024, q = r % 1024, kb = q % 32, nb = q / 32;
        src = F.inp(I_MWOUT) + (size_t)j * D * D + (size_t)(kb * 64) * D + nb * 64; N = D; dst = (unsigned char*)(F.wsp() + WS_WMO) + ((size_t)j * D + nb * 64) * D + kb * 64; Kd = D; f8 = 1; scale = 128.f; return; } r -= P0_S1;
    if (r < P0_S2) { const int j = r / 2048, q = r % 2048, kb = q % 32, nb = q / 32;
        src = F.inp(I_GWIN) + (size_t)j * D * 4096 + (size_t)(kb * 64) * 4096 + nb * 64; N = 4096; dst = (unsigned char*)((bf16*)(F.wsp() + WS_WGI) + ((size_t)j * 4096 + nb * 64) * D + kb * 64); Kd = D; f8 = 0; scale = 1.f; return; } r -= P0_S2;
    if (r < P0_S3) { const int j = r / 1024, q = r % 1024, kb = q % 32, nb = q / 32;
        src = F.inp(I_GWOUT) + (size_t)j * D * D + (size_t)(kb * 64) * D + nb * 64; N = D; dst = (unsigned char*)(F.wsp() + WS_WGO) + ((size_t)j * D + nb * 64) * D + kb * 64; Kd = D; f8 = 1; scale = 128.f; return; } r -= P0_S3;
    f8 = 1; scale = 64.f;
    if (r < 32 * 512) { const int le = r / 512, q = r % 512, kb = q % 32, nb = q / 32; const int n0 = nb * 64, half = n0 >> 9, nn = n0 & 511, row = (nn >> 7) * 256 + half * 128 + (nn & 127);
        src = F.inp(I_EWGU) + (size_t)le * D * 1024 + (size_t)(kb * 64) * 1024 + n0; N = 1024; dst = (unsigned char*)(F.wsp() + WS_WGU) + ((size_t)le * 1024 + row) * D + kb * 64; Kd = D; }
    else { r -= 32 * 512; const int le = r / 256, q = r % 256, kb = q % 8, nb = q / 8;
        src = F.inp(I_EWDN) + (size_t)le * FF * D + (size_t)(kb * 64) * D + nb * 64; N = D; dst = (unsigned char*)(F.wsp() + WS_WDN) + ((size_t)le * D + nb * 64) * FF + kb * 64; Kd = FF; }
}
__device__ __forceinline__ void tr_load64(const float* src, int N, int lane, f32x4 (&v)[16]) {
#pragma unroll
    for (int i = 0; i < 16; ++i) v[i] = *(const GAS f32x4*)(src + (size_t)(4 * i + (lane >> 4)) * N + (lane & 15) * 4);
}
__device__ __forceinline__ void tr_finish64(const f32x4 (&v)[16], unsigned char* dst, int Kd, int f8, float wscale, LAS float* scr, int lane) {
#pragma unroll
    for (int i = 0; i < 16; ++i) { LAS float* p = scr + (4 * i + (lane >> 4)) * TR_P + (lane & 15) * 4; p[0] = v[i].x; p[1] = v[i].y; p[2] = v[i].z; p[3] = v[i].w; }
    LDS_WAIT(); asm volatile("" ::: "memory");
    if (f8) { const int c = lane & 3;
#pragma unroll
        for (int j = 0; j < 4; ++j) { const int n = (lane >> 2) + 16 * j; const LAS float* s = scr + (16 * c) * TR_P + n; unsigned w[4];
#pragma unroll
            for (int g = 0; g < 4; ++g) { int a_ = 0; a_ = __builtin_amdgcn_cvt_pk_fp8_f32(s[(4 * g) * TR_P] * wscale, s[(4 * g + 1) * TR_P] * wscale, a_, false); a_ = __builtin_amdgcn_cvt_pk_fp8_f32(s[(4 * g + 2) * TR_P] * wscale, s[(4 * g + 3) * TR_P] * wscale, a_, true); w[g] = (unsigned)a_; }
            *(GAS u32x4*)(dst + (size_t)n * Kd + 16 * c) = (u32x4){w[0], w[1], w[2], w[3]}; } }
    else { const int c = lane & 7;
#pragma unroll
        for (int j = 0; j < 8; ++j) { const int n = (lane >> 3) + 8 * j; const LAS float* s = scr + (8 * c) * TR_P + n;
            u32x4 o; o.x = cvt_pk_bf16(s[0 * TR_P], s[1 * TR_P]); o.y = cvt_pk_bf16(s[2 * TR_P], s[3 * TR_P]); o.z = cvt_pk_bf16(s[4 * TR_P], s[5 * TR_P]); o.w = cvt_pk_bf16(s[6 * TR_P], s[7 * TR_P]);
            *(GAS u32x4*)((bf16*)dst + (size_t)n * Kd + 8 * c) = o; } }
    LDS_WAIT(); asm volatile("" ::: "memory");
}
__device__ __forceinline__ void p0a_weights(Frame& F) {
    F.rethread();
    LAS float* scr = (LAS float*)(F.lds + F.wave * TR_WAVE_BYTES);
    const int gw = blockIdx.x * NWAVES + F.wave, NGW = F.G * NWAVES;
    { f32x4 va[16], vb[16]; const float* sA; const float* sB; unsigned char* dA; unsigned char* dB; int nA, nB, kA, kB, fA, fB; float cA, cB;
      int it = gw;
      if (it < P0_NI64) { p0a_decode(F, it, sA, nA, dA, kA, fA, cA); tr_load64(sA, nA, F.lane, va);
#pragma unroll 1
        for (;;) {
            const bool haveB = it + NGW < P0_NI64; p0a_decode(F, haveB ? it + NGW : it, sB, nB, dB, kB, fB, cB); tr_load64(sB, nB, F.lane, vb);
            tr_finish64(va, dA, kA, fA, cA, scr, F.lane);
            if (!haveB) break;
            const bool haveA = it + 2 * NGW < P0_NI64; p0a_decode(F, haveA ? it + 2 * NGW : it + NGW, sA, nA, dA, kA, fA, cA); tr_load64(sA, nA, F.lane, va);
            tr_finish64(vb, dB, kB, fB, cB, scr, F.lane);
            if (!haveA) break;
            it += 2 * NGW; } } }
    { constexpr int SG = 2 * 32, S4 = 4 * 32;
      for (int it = gw; it < SG + S4; it += NGW) { int r = it;
        if (r < SG) { const int j = r / 32, kb = r % 32;
            tr_item(F.inp(I_MWIN) + (size_t)j * D * MIN_COLS, MIN_COLS, kb * 64, MIN_MAIN, (bf16*)(F.wsp() + WS_WG_T) + (size_t)j * 32 * D, D, scr, F.lane); continue; } r -= SG;
        { const int l = r / 32, kb = r % 32;
            tr_item(F.inp(I_RW) + (size_t)l * D * NE, NE, kb * 64, 0, (bf16*)(F.wsp() + WS_WR_T) + (size_t)l * 32 * D, D, scr, F.lane); } } }
    { const float* src = F.inp(I_GWS); bf16* dst = (bf16*)(F.wsp() + WS_WS); const int n4 = 2 * 8 * 128 * 128 / 4;
      for (int i = blockIdx.x * NTHREADS + F.tid; i < n4; i += F.G * NTHREADS) { const f32x4 v = ((const GAS f32x4*)src)[i]; u32x2 o; o.x = cvt_pk_bf16(v.x, v.y); o.y = cvt_pk_bf16(v.z, v.w); ((GAS u32x2*)dst)[i] = o; } }
}

__device__ __forceinline__ void skinny16(Frame& F, const bf16* WT, const float* bias) {
    LAS unsigned char* XT = F.lds; LAS float* PART = (LAS float*)(F.lds + RP_PART); LAS float* LOG = (LAS float*)(F.lds + RP_LOG);
    const int r = F.lane & 15, q = F.lane >> 4;
    float zf_ = 0.f; asm volatile("" : "+v"(zf_)); f32x4 acc0 = (f32x4){zf_, zf_, zf_, zf_}, acc1 = acc0;
#pragma unroll
    for (int ks = 0; ks < 8; ++ks) {
        const int k0 = F.wave * 256 + ks * 32 + 8 * q;
        const bf16x8 a = *(const LAS bf16x8*)(XT + r * XT_PITCH + k0 * 2);
        const bf16x8 b0 = *(const GAS bf16x8*)(WT + (size_t)r * D + k0);
        const bf16x8 b1 = *(const GAS bf16x8*)(WT + (size_t)(16 + r) * D + k0);
        acc0 = __builtin_amdgcn_mfma_f32_16x16x32_bf16(a, b0, acc0, 0, 0, 0);
        acc1 = __builtin_amdgcn_mfma_f32_16x16x32_bf16(a, b1, acc1, 0, 0, 0);
    }
#pragma unroll
    for (int i = 0; i < 4; ++i) { PART[(F.wave * 16 + 4 * q + i) * 33 + r] = acc0[i]; PART[(F.wave * 16 + 4 * q + i) * 33 + 16 + r] = acc1[i]; }
    __syncthreads();
    { const int row = F.tid >> 5, e = F.tid & 31; float s = bias[e];
#pragma unroll
      for (int w = 0; w < 8; ++w) s += PART[(w * 16 + row) * 33 + e];
      LOG[row * LOGP + e] = s; }
    __syncthreads();
}
__device__ __forceinline__ void load_lane_vec32(const float* p, int lane, float (&v)[32]) {
#pragma unroll
    for (int j = 0; j < 4; ++j) { const f32x4 a = *(const GAS f32x4*)(p + 8 * lane + 512 * j), b = *(const GAS f32x4*)(p + 8 * lane + 512 * j + 4);
        v[8 * j + 0] = a.x; v[8 * j + 1] = a.y; v[8 * j + 2] = a.z; v[8 * j + 3] = a.w; v[8 * j + 4] = b.x; v[8 * j + 5] = b.y; v[8 * j + 6] = b.z; v[8 * j + 7] = b.w; }
}
__device__ __forceinline__ void load_row_bf16(const bf16* row, int lane, float (&v)[32]) {
#pragma unroll
    for (int j = 0; j < 4; ++j) { const u32x4 w = *(const GAS u32x4*)(row + 8 * lane + 512 * j);
        v[8 * j + 0] = bf_lo(w.x); v[8 * j + 1] = bf_hi(w.x); v[8 * j + 2] = bf_lo(w.y); v[8 * j + 3] = bf_hi(w.y); v[8 * j + 4] = bf_lo(w.z); v[8 * j + 5] = bf_hi(w.z); v[8 * j + 6] = bf_lo(w.w); v[8 * j + 7] = bf_hi(w.w); }
}
__device__ __forceinline__ void layer_norm32(float (&v)[32], const float (&g)[32], const float (&b)[32]) {
    float s = 0.f;
#pragma unroll
    for (int i = 0; i < 32; ++i) s += v[i];
    const float mean = wave_sum(s) * (1.f / D); float s2 = 0.f;
#pragma unroll
    for (int i = 0; i < 32; ++i) { v[i] -= mean; s2 += v[i] * v[i]; }
    const float rstd = 1.f / sqrtf(wave_sum(s2) * (1.f / D) + LN_EPS);
#pragma unroll
    for (int i = 0; i < 32; ++i) v[i] = v[i] * rstd * g[i] + b[i];
}
__device__ __forceinline__ void layer_norm32_lds(float (&v)[32], const LAS float* GL, const LAS float* BL, int lane) {
    float s = 0.f;
#pragma unroll
    for (int i = 0; i < 32; ++i) s += v[i];
    const float mean = wave_sum(s) * (1.f / D); float s2 = 0.f;
#pragma unroll
    for (int i = 0; i < 32; ++i) { v[i] -= mean; s2 += v[i] * v[i]; }
    const float rstd = 1.f / sqrtf(wave_sum(s2) * (1.f / D) + LN_EPS);
#pragma unroll
    for (int j = 0; j < 4; ++j) { const f32x4 g0 = *(const LAS f32x4*)(GL + 8 * lane + 512 * j), g1 = *(const LAS f32x4*)(GL + 8 * lane + 512 * j + 4), b0 = *(const LAS f32x4*)(BL + 8 * lane + 512 * j), b1 = *(const LAS f32x4*)(BL + 8 * lane + 512 * j + 4);
        v[8 * j + 0] = v[8 * j + 0] * rstd * g0.x + b0.x; v[8 * j + 1] = v[8 * j + 1] * rstd * g0.y + b0.y; v[8 * j + 2] = v[8 * j + 2] * rstd * g0.z + b0.z; v[8 * j + 3] = v[8 * j + 3] * rstd * g0.w + b0.w;
        v[8 * j + 4] = v[8 * j + 4] * rstd * g1.x + b1.x; v[8 * j + 5] = v[8 * j + 5] * rstd * g1.y + b1.y; v[8 * j + 6] = v[8 * j + 6] * rstd * g1.z + b1.z; v[8 * j + 7] = v[8 * j + 7] * rstd * g1.w + b1.w; }
}
__device__ __forceinline__ void store_row_bf16(const float (&v)[32], bf16* grow, LAS unsigned char* xt_row, bool to_lds, int lane) {
#pragma unroll
    for (int j = 0; j < 4; ++j) { u32x4 w; w.x = cvt_pk_bf16(v[8 * j], v[8 * j + 1]); w.y = cvt_pk_bf16(v[8 * j + 2], v[8 * j + 3]); w.z = cvt_pk_bf16(v[8 * j + 4], v[8 * j + 5]); w.w = cvt_pk_bf16(v[8 * j + 6], v[8 * j + 7]);
        *(GAS u32x4*)(grow + 8 * lane + 512 * j) = w;
        if (to_lds) *(LAS u32x4*)(xt_row + (8 * lane + 512 * j) * 2) = w; }
}
__device__ __forceinline__ void p0b_rows(Frame& F) {
    F.rethread();
    const float* x = F.inp(I_X); bf16* XB = (bf16*)(F.wsp() + WS_XB); float* GT = (float*)(F.wsp() + WS_GATES);
    LAS float* LOG = (LAS float*)(F.lds + RP_LOG);
    for (int it = blockIdx.x; it < T / 16; it += F.G) {
#pragma unroll 1
        for (int rr = 0; rr < 2; ++rr) { const int r = F.wave * 2 + rr, t = it * 16 + r; float v[32];
            load_lane_vec32(x + (size_t)t * D, F.lane, v);
            store_row_bf16(v, XB + (size_t)t * D, F.lds + r * XT_PITCH, true, F.lane); }
        __syncthreads();
        skinny16(F, (const bf16*)(F.wsp() + WS_WG_T), F.inp(I_MBG));
        { const int row = F.tid >> 5, e = F.tid & 31; GT[(size_t)(it * 16 + row) * 32 + e] = LOG[row * LOGP + e]; }
    }
    __syncthreads();
}
__device__ __forceinline__ void r1_phase(Frame& F, int layer) {
    F.rethread();
    const bf16* PRE = (const bf16*)(F.wsp() + WS_PRE); bf16* X1 = (bf16*)(F.wsp() + WS_X1);
    int* LIST = (int*)(F.wsp() + WS_LIST); int* EIDX = (int*)(F.wsp() + WS_TOK); int* POS = (int*)(F.wsp() + WS_TOK + 256 * 1024); float* GATE = (float*)(F.wsp() + WS_TOK + 512 * 1024);
    LAS unsigned char* XT = F.lds; LAS float* PART = (LAS float*)(F.lds + RP_PART); LAS float* LOGA = (LAS float*)(F.lds + RP_LOGA);
    gu32* gcnt = F.ctlp() + CW_CNT + layer * 32 * 64;
    const int r16 = F.lane & 15, q = F.lane >> 4;
    float g[32], b[32];
    load_lane_vec32(F.inp(I_LNG) + (size_t)(layer * 2 + 0) * D, F.lane, g); load_lane_vec32(F.inp(I_LNB) + (size_t)(layer * 2 + 0) * D, F.lane, b);
    bf16x8 bw0[8], bw1[8];
    { const bf16* WT = (const bf16*)(F.wsp() + WS_WR_T) + (size_t)layer * 32 * D;
#pragma unroll
      for (int ks = 0; ks < 8; ++ks) { const int k0 = F.wave * 256 + ks * 32 + 8 * q; bw0[ks] = *(const GAS bf16x8*)(WT + (size_t)r16 * D + k0); bw1[ks] = *(const GAS bf16x8*)(WT + (size_t)(16 + r16) * D + k0); } }
    const float* rbias = F.inp(I_RB) + layer * NE;
    if (F.tid < 32) F.X[XW_LCNT + F.tid] = 0u;
    int nit = 0;
    u32x4 praw[4];
    if ((int)blockIdx.x < T / 16) {
#pragma unroll
        for (int j = 0; j < 4; ++j) praw[j] = *(const GAS u32x4*)(PRE + (size_t)((int)blockIdx.x * 16 + F.wave * 2) * D + 8 * F.lane + 512 * j); }
    for (int it = blockIdx.x; it < T / 16; it += F.G, ++nit) {
#pragma unroll 1
        for (int rr = 0; rr < 2; ++rr) { const int r = F.wave * 2 + rr, t = it * 16 + r; float v[32];
#pragma unroll
            for (int j = 0; j < 4; ++j) { const u32x4 w = praw[j];
                v[8 * j + 0] = bf_lo(w.x); v[8 * j + 1] = bf_hi(w.x); v[8 * j + 2] = bf_lo(w.y); v[8 * j + 3] = bf_hi(w.y); v[8 * j + 4] = bf_lo(w.z); v[8 * j + 5] = bf_hi(w.z); v[8 * j + 6] = bf_lo(w.w); v[8 * j + 7] = bf_hi(w.w); }
            { const int tn = rr == 0 ? t + 1 : (it + F.G) * 16 + F.wave * 2;
              if (rr == 0 || it + F.G < T / 16) {
#pragma unroll
                  for (int j = 0; j < 4; ++j) praw[j] = *(const GAS u32x4*)(PRE + (size_t)tn * D + 8 * F.lane + 512 * j); } }
            layer_norm32(v, g, b);
            store_row_bf16(v, X1 + (size_t)t * D, XT + r * XT_PITCH, true, F.lane);
            { unsigned char* x8 = (unsigned char*)(F.wsp() + WS_X1F8) + (size_t)t * D;
#pragma unroll
              for (int j = 0; j < 4; ++j) { int a_ = 0, b_ = 0; a_ = __builtin_amdgcn_cvt_pk_fp8_f32(v[8 * j], v[8 * j + 1], a_, false); a_ = __builtin_amdgcn_cvt_pk_fp8_f32(v[8 * j + 2], v[8 * j + 3], a_, true);
                  b_ = __builtin_amdgcn_cvt_pk_fp8_f32(v[8 * j + 4], v[8 * j + 5], b_, false); b_ = __builtin_amdgcn_cvt_pk_fp8_f32(v[8 * j + 6], v[8 * j + 7], b_, true);
                  *(GAS u32x2*)(x8 + 8 * F.lane + 512 * j) = (u32x2){(unsigned)a_, (unsigned)b_}; } } }
        __syncthreads();
        { float zf_ = 0.f; asm volatile("" : "+v"(zf_)); f32x4 acc0 = (f32x4){zf_, zf_, zf_, zf_}, acc1 = acc0;
#pragma unroll
          for (int ks = 0; ks < 8; ++ks) { const bf16x8 a = *(const LAS bf16x8*)(XT + r16 * XT_PITCH + (F.wave * 256 + ks * 32 + 8 * q) * 2);
              acc0 = __builtin_amdgcn_mfma_f32_16x16x32_bf16(a, bw0[ks], acc0, 0, 0, 0); acc1 = __builtin_amdgcn_mfma_f32_16x16x32_bf16(a, bw1[ks], acc1, 0, 0, 0); }
#pragma unroll
          for (int i = 0; i < 4; ++i) { PART[(F.wave * 16 + 4 * q + i) * 33 + r16] = acc0[i]; PART[(F.wave * 16 + 4 * q + i) * 33 + 16 + r16] = acc1[i]; } }
        __syncthreads();
        { const int row = F.tid >> 5, e = F.tid & 31; float s = rbias[e];
#pragma unroll
          for (int w = 0; w < 8; ++w) s += PART[(w * 16 + row) * 33 + e];
          LOGA[(nit * 16 + row) * LOGP + e] = s; }
    }
    __syncthreads();
    const int nrows = nit * 16; const int row = F.wave * 8 + (F.lane & 7); const bool act = (F.lane < 8) && (row < nrows);
    int e4[4] = {0, 0, 0, 0}; float v4[4] = {0.f, 0.f, 0.f, 0.f}; unsigned rk[4] = {0u, 0u, 0u, 0u};
    if (act) { unsigned mask = 0u; float lv[32];
#pragma unroll
        for (int e4i = 0; e4i < 8; ++e4i) { const f32x4 t = *(const LAS f32x4*)(LOGA + row * LOGP + 4 * e4i); lv[4 * e4i] = t.x; lv[4 * e4i + 1] = t.y; lv[4 * e4i + 2] = t.z; lv[4 * e4i + 3] = t.w; }
#pragma unroll
        for (int k = 0; k < 4; ++k) { float best = -__builtin_inff(); int bi = 0;
#pragma unroll
            for (int e = 0; e < 32; ++e) { const bool ok = (((mask >> e) & 1u) == 0u) && (lv[e] > best); best = ok ? lv[e] : best; bi = ok ? e : bi; }
            mask |= 1u << bi; e4[k] = bi; v4[k] = best; }
        const float e1 = __expf(v4[1] - v4[0]), e2 = __expf(v4[2] - v4[0]), e3 = __expf(v4[3] - v4[0]); const float inv = 1.f / (1.f + e1 + e2 + e3);
        v4[0] = inv; v4[1] = e1 * inv; v4[2] = e2 * inv; v4[3] = e3 * inv;
#pragma unroll
        for (int k = 0; k < 4; ++k) rk[k] = __hip_atomic_fetch_add((LAS unsigned*)(F.X + XW_LCNT + e4[k]), 1u, __ATOMIC_RELAXED, __HIP_MEMORY_SCOPE_WORKGROUP); }
    __syncthreads();
    if (F.tid < 32) { const unsigned c = F.X[XW_LCNT + F.tid]; unsigned base = 0u; if (c) base = __hip_atomic_fetch_add(gcnt + F.tid * 64, c, RLX_AGENT); F.X[XW_LBASE + F.tid] = base; }
    __syncthreads();
    if (act) { const int t = ((int)blockIdx.x + (row >> 4) * F.G) * 16 + (row & 15);
#pragma unroll
        for (int k = 0; k < 4; ++k) { const unsigned pos = F.X[XW_LBASE + e4[k]] + rk[k]; __hip_atomic_store((GAS int*)LIST + ((size_t)e4[k] * CAP + pos), t, RLX_AGENT); EIDX[t * 4 + k] = e4[k]; POS[t * 4 + k] = (int)pos; GATE[t * 4 + k] = v4[k]; } }
    __syncthreads();
}
__device__ __forceinline__ void moe_tables(Frame& F, int layer) {
    F.rethread();
    gu32* gcnt = F.ctlp() + CW_CNT + layer * 32 * 64;
    if (F.tid < 32) F.X[XW_CNT + F.tid] = __hip_atomic_load(gcnt + F.tid * 64, RLX_AGENT);
    __syncthreads();
    if (F.tid < 32) {
        unsigned run = 0u;
        for (int e = 0; e < F.tid; ++e) run += (F.X[XW_CNT + e] + 255u) >> 8;
        const unsigned n = (F.X[XW_CNT + F.tid] + 255u) >> 8; F.X[XW_TPRE + F.tid] = run; F.X[XW_PSTART + F.tid] = run * 256u;
        for (unsigned i = 0; i < n; ++i) F.X[XW_TILE_E + run + i] = (unsigned)F.tid;
        if (F.tid == 31) { F.X[XW_TPRE + 32] = run + n; F.X[XW_NTILES] = run + n; } }
    __syncthreads();
}
__device__ __forceinline__ void r2_phase(Frame& F, int layer, bool last, int gates_j, int kmax) {
    F.rethread();
    const bf16* X1 = (const bf16*)(F.wsp() + WS_X1); const unsigned char* Y = (const unsigned char*)(F.wsp() + WS_Y); bf16* XB = (bf16*)(F.wsp() + WS_XB); float* GT = (float*)(F.wsp() + WS_GATES);
    const int* EIDX = (const int*)(F.wsp() + WS_TOK); const int* POS = (const int*)(F.wsp() + WS_TOK + 256 * 1024); const float* GATE = (const float*)(F.wsp() + WS_TOK + 512 * 1024);
    LAS float* LOG = (LAS float*)(F.lds + RP_LOG);
    LAS float* GL = (LAS float*)(F.lds + RP_GB); LAS float* BL = GL + D;
    { const float* gp = F.inp(I_LNG) + (size_t)(layer * 2 + 1) * D; const float* bp = F.inp(I_LNB) + (size_t)(layer * 2 + 1) * D;
      *(LAS f32x4*)(GL + 4 * F.tid) = *(const GAS f32x4*)(gp + 4 * F.tid); *(LAS f32x4*)(BL + 4 * F.tid) = *(const GAS f32x4*)(bp + 4 * F.tid); }
    __syncthreads();
    const int pl = F.lane < 12 ? F.lane : 0; const int* tokl = EIDX + (pl >> 2) * 65536 + (pl & 3);
    int pk = 0;
    if ((int)blockIdx.x < T / 16) pk = *(const GAS int*)(tokl + ((int)blockIdx.x * 16 + F.wave * 2) * 4);
    for (int it = blockIdx.x; it < T / 16; it += F.G) {
#pragma unroll
        for (int rr = 0; rr < 2; ++rr) { const int r = F.wave * 2 + rr, t = it * 16 + r; float v[32];
            load_row_bf16(X1 + (size_t)t * D, F.lane, v);
            const int ck = pk;
            { const int tn = rr == 0 ? t + 1 : (it + F.G) * 16 + F.wave * 2; if (rr == 0 || it + F.G < T / 16) pk = *(const GAS int*)(tokl + tn * 4); }
#pragma unroll
            for (int i = 0; i < 32; ++i) v[i] *= ALPHA;
#pragma unroll
            for (int k = 0; k < 4; ++k) if (k < kmax) { const int e = __builtin_amdgcn_readlane(ck, k), pos = __builtin_amdgcn_readlane(ck, 4 + k); const float gt = __builtin_bit_cast(float, __builtin_amdgcn_readlane(ck, 8 + k));
                const unsigned slot = F.X[XW_PSTART + e] + (unsigned)pos; float yv[32];
                { const unsigned char* yr = Y + (size_t)slot * D;
#pragma unroll
                  for (int j = 0; j < 4; ++j) { const u32x2 w = *(const GAS u32x2*)(yr + 8 * F.lane + 512 * j);
                      yv[8 * j + 0] = __builtin_amdgcn_cvt_f32_fp8((int)w.x, 0); yv[8 * j + 1] = __builtin_amdgcn_cvt_f32_fp8((int)w.x, 1); yv[8 * j + 2] = __builtin_amdgcn_cvt_f32_fp8((int)w.x, 2); yv[8 * j + 3] = __builtin_amdgcn_cvt_f32_fp8((int)w.x, 3);
                      yv[8 * j + 4] = __builtin_amdgcn_cvt_f32_fp8((int)w.y, 0); yv[8 * j + 5] = __builtin_amdgcn_cvt_f32_fp8((int)w.y, 1); yv[8 * j + 6] = __builtin_amdgcn_cvt_f32_fp8((int)w.y, 2); yv[8 * j + 7] = __builtin_amdgcn_cvt_f32_fp8((int)w.y, 3); } }
                const float gts = gt * (1.0f / Y_SCALE);
#pragma unroll
                for (int i = 0; i < 32; ++i) v[i] += gts * yv[i]; }
            layer_norm32_lds(v, GL, BL, F.lane);
            if (last) { float* o = F.outp() + (size_t)t * D;
#pragma unroll
                for (int j = 0; j < 4; ++j) { *(GAS f32x4*)(o + 8 * F.lane + 512 * j) = (f32x4){v[8 * j], v[8 * j + 1], v[8 * j + 2], v[8 * j + 3]}; *(GAS f32x4*)(o + 8 * F.lane + 512 * j + 4) = (f32x4){v[8 * j + 4], v[8 * j + 5], v[8 * j + 6], v[8 * j + 7]}; } }
            else store_row_bf16(v, XB + (size_t)t * D, F.lds + r * XT_PITCH, gates_j >= 0, F.lane); }
        if (gates_j >= 0) {
            __syncthreads();
            skinny16(F, (const bf16*)(F.wsp() + WS_WG_T) + (size_t)gates_j * 32 * D, F.inp(I_MBG) + gates_j * 32);
            { const int row = F.tid >> 5, e = F.tid & 31; GT[(size_t)(it * 16 + row) * 32 + e] = LOG[row * LOGP + e]; }
        }
    }
    __syncthreads();
}
__device__ __forceinline__ void stub_mixer(Frame& F) {
    F.rethread();
    const bf16* XB = (const bf16*)(F.wsp() + WS_XB); bf16* PRE = (bf16*)(F.wsp() + WS_PRE);
    for (size_t i = (size_t)blockIdx.x * NTHREADS + F.tid; i < (size_t)T * D / 8; i += (size_t)F.G * NTHREADS) { const u32x4 w = ((const GAS u32x4*)XB)[i]; u32x4 o;
        o.x = cvt_pk_bf16(bf_lo(w.x) * ALPHA, bf_hi(w.x) * ALPHA); o.y = cvt_pk_bf16(bf_lo(w.y) * ALPHA, bf_hi(w.y) * ALPHA); o.z = cvt_pk_bf16(bf_lo(w.z) * ALPHA, bf_hi(w.z) * ALPHA); o.w = cvt_pk_bf16(bf_lo(w.w) * ALPHA, bf_hi(w.w) * ALPHA);
        ((GAS u32x4*)PRE)[i] = o; }
}


typedef float f32x2_t __attribute__((ext_vector_type(2)));
__device__ __forceinline__ f32x2_t gelu_pk(f32x2_t v) {
    const f32x2_t av = __builtin_elementwise_abs(v), d = av * 0.2316418882f + 1.0f;
    f32x2_t t; t.x = __builtin_amdgcn_rcpf(d.x); t.y = __builtin_amdgcn_rcpf(d.y);
    f32x2_t q = t * 0.5307027145f + (-0.7265760135f); q = q * t + 0.7107068705f; q = q * t + (-0.142248368f); q = q * t + 0.127414796f; q = q * t;
    const f32x2_t s = (v * v) * (-0.72134752044f);
    f32x2_t e; e.x = __builtin_amdgcn_exp2f(s.x); e.y = __builtin_amdgcn_exp2f(s.y);
    const f32x2_t m = v * (q * e), r = v - m;
    f32x2_t o; o.x = v.x < 0.f ? m.x : r.x; o.y = v.y < 0.f ? m.y : r.y; return o;
}
template <int KK, int NN> struct RectBase {
    static constexpr int K = KK; static constexpr bool PERM = true, FP8 = false; static constexpr int SCALE_B = 0x7f7f7f7f;
    const bf16* A; const bf16* Bt; int G, c;
    __device__ __forceinline__ bool next(int i, pg8::Unit& u) const {
        constexpr int nM = T / 256, nN = NN / 256, nwg = nM * nN; const long L = (long)i * G + c; if (L >= nwg) return false;
        const int wgid = pg8::xcd_remap((int)L, nwg); constexpr int nig = pg8::WGM * nN; const int gid = wgid / nig, fm = gid * pg8::WGM, gsz = (nM - fm) < pg8::WGM ? (nM - fm) : pg8::WGM;
        u.pm = fm + ((wgid % nig) % gsz); u.pn = (wgid % nig) / gsz; u.e = 0; u.x = 0; return true;
    }
    __device__ __forceinline__ void bases(const pg8::Unit& u, const char*& cA, const char*& cB) const { cA = (const char*)(A + (size_t)u.pm * 256 * KK); cB = (const char*)(Bt + (size_t)u.pn * 256 * KK); }
    __device__ __forceinline__ void avoff(const pg8::Unit&, int tid, unsigned (&v)[2][2]) const {
#pragma unroll
        for (int i = 0; i < 2; ++i) { int R, C; pg8::stage_rc(tid * 16 + i * 8192, R, C);
#pragma unroll
            for (int h = 0; h < 2; ++h) v[h][i] = (unsigned)((h * 128 + R) * KK + C) * 2u; }
    }
};
struct OutProjProb : RectBase<D / 2, D> {
    static constexpr bool FP8 = true; static constexpr int SCALE_B = 0x78787878;
    const bf16* XB; bf16* PRE;
    __device__ __forceinline__ void epi(const f32x4 (&acc)[2][2][4][2], const pg8::Unit& u, int wr, int wc, int fr, int fq) const {
        const int row0 = u.pm * 256 + wr * 64 + fr, c0 = u.pn * 256 + wc * 32 + 8 * fq;
#pragma unroll
        for (int ai = 0; ai < 2; ++ai)
#pragma unroll
            for (int m = 0; m < 4; ++m) { const size_t off = (size_t)(row0 + ai * 128 + m * 16) * D + c0;
#pragma unroll
                for (int bj = 0; bj < 2; ++bj) { const u32x4 xr = *(const GAS u32x4*)(XB + off + bj * 128); const f32x4 a0 = acc[ai][bj][m][0], a1 = acc[ai][bj][m][1]; u32x4 w;
                    w.x = cvt_pk_bf16(ALPHA * bf_lo(xr.x) + a0[0], ALPHA * bf_hi(xr.x) + a0[1]); w.y = cvt_pk_bf16(ALPHA * bf_lo(xr.y) + a0[2], ALPHA * bf_hi(xr.y) + a0[3]);
                    w.z = cvt_pk_bf16(ALPHA * bf_lo(xr.z) + a1[0], ALPHA * bf_hi(xr.z) + a1[1]); w.w = cvt_pk_bf16(ALPHA * bf_lo(xr.w) + a1[2], ALPHA * bf_hi(xr.w) + a1[3]);
                    *(GAS u32x4*)(PRE + off + bj * 128) = w; }
                asm volatile("" ::: "memory"); }
    }
};
struct GmlpInProb : RectBase<D, 4096> {
    const float* bias; bf16* U; bf16* V; float* VSTAT;
    __device__ __forceinline__ void epi(const f32x4 (&acc)[2][2][4][2], const pg8::Unit& u, int wr, int wc, int fr, int fq) const {
        const int row0 = u.pm * 256 + wr * 64 + fr, ct = u.pn * 256 + wc * 32 + 8 * fq; const bool isv = u.pn >= 8;
        bf16* O = isv ? V : U; const int c0 = isv ? ct - 2048 : ct;
#pragma unroll
        for (int ai = 0; ai < 2; ++ai)
#pragma unroll
            for (int m = 0; m < 4; ++m) { const int row = row0 + ai * 128 + m * 16; float s1 = 0.f, s2 = 0.f;
#pragma unroll
                for (int bj = 0; bj < 2; ++bj) { const f32x4 b0 = *(const GAS f32x4*)(bias + ct + bj * 128), b1 = *(const GAS f32x4*)(bias + ct + bj * 128 + 4);
                    const f32x4 v0 = acc[ai][bj][m][0] + b0, v1 = acc[ai][bj][m][1] + b1;
                    const f32x2_t g0 = gelu_pk((f32x2_t){v0[0], v0[1]}), g1 = gelu_pk((f32x2_t){v0[2], v0[3]}), g2 = gelu_pk((f32x2_t){v1[0], v1[1]}), g3 = gelu_pk((f32x2_t){v1[2], v1[3]});
                    u32x4 w; w.x = cvt_pk_bf16(g0.x, g0.y); w.y = cvt_pk_bf16(g1.x, g1.y); w.z = cvt_pk_bf16(g2.x, g2.y); w.w = cvt_pk_bf16(g3.x, g3.y);
                    *(GAS u32x4*)(O + (isv ? (size_t)((((unsigned)(row >> 7) * 8u + (unsigned)(u.pn - 8)) * 32u + (unsigned)(wc * 4 + fq + bj * 16)) * 128u + (unsigned)(row & 127)) * 8u : (size_t)row * D + c0 + bj * 128)) = w;
                    if (isv) { const float r0 = bf_lo(w.x), r1 = bf_hi(w.x), r2 = bf_lo(w.y), r3 = bf_hi(w.y), r4 = bf_lo(w.z), r5 = bf_hi(w.z), r6 = bf_lo(w.w), r7 = bf_hi(w.w);
                        s1 += ((r0 + r1) + (r2 + r3)) + ((r4 + r5) + (r6 + r7)); s2 += ((r0 * r0 + r1 * r1) + (r2 * r2 + r3 * r3)) + ((r4 * r4 + r5 * r5) + (r6 * r6 + r7 * r7)); } }
                if (isv) { s1 += __shfl_xor(s1, 16); s1 += __shfl_xor(s1, 32); s2 += __shfl_xor(s2, 16); s2 += __shfl_xor(s2, 32);
                    if (fq == 0) *(GAS f32x2_t*)(VSTAT + ((size_t)((u.pn - 8) * 4 + wc) * T + row) * 2) = (f32x2_t){s1, s2}; }
                asm volatile("" ::: "memory"); }
    }
};


constexpr int VT_PITCH = 272, G3_ST = 69632, G3_WS = 70656;
constexpr int G3_GB = 105472, G3_ST2 = 107520;
__device__ __forceinline__ void g3_stats(const float* VSTAT, int row0, int tid, LAS float* STb) {
    f32x2 p[32];
#pragma unroll
    for (int cg = 0; cg < 32; ++cg) p[cg] = *(const GAS f32x2*)(VSTAT + ((size_t)cg * T + row0 + tid) * 2);
    float s1 = 0.f, s2 = 0.f;
#pragma unroll
    for (int cg = 0; cg < 32; ++cg) { s1 += p[cg].x; s2 += p[cg].y; }
    const float mean = s1 * (1.f / D), var = s2 * (1.f / D) - mean * mean; STb[tid * 2] = mean; STb[tid * 2 + 1] = 1.f / sqrtf(var + LN_EPS);
}
__device__ __forceinline__ void g3_phase(Frame& F, int j) {
    F.rethread();
    LAS unsigned char* VT = F.lds; LAS float* GB = (LAS float*)(F.lds + G3_GB);
    const bf16* U = (const bf16*)(F.wsp() + WS_GU); const bf16* V = (const bf16*)(F.wsp() + WS_GV); bf16* YG = (bf16*)(F.wsp() + WS_GY); const float* VSTAT = (const float*)(F.wsp() + WS_VSTAT);
    const float* vg = F.inp(I_GVG) + (size_t)j * D; const float* vb = F.inp(I_GVB) + (size_t)j * D; const float* bs = F.inp(I_GBS) + (size_t)j * 8 * 128;
    const bf16* WS = (const bf16*)(F.wsp() + WS_WS) + (size_t)j * 8 * 128 * 128;
    const int r = F.lane & 15, q = F.lane >> 4;
    const unsigned psel = (F.lane & 1) ? 0x03020706u : 0x05040100u; const int podd = F.lane & 1;
    const int unit0 = blockIdx.x, g = unit0 & 7;
    if (unit0 < 1024) {
        if (F.tid < 128) { g3_stats(VSTAT, (unit0 >> 3) * 128, F.tid, (LAS float*)(F.lds + G3_ST));
            const float* gsrc = (F.tid < 64 ? vg : vb) + g * 256 + 4 * (F.tid & 63); *(LAS f32x4*)(GB + (F.tid < 64 ? 0 : 256) + 4 * (F.tid & 63)) = *(const GAS f32x4*)gsrc; }
        { const bf16* wsg0 = WS + (size_t)g * 128 * 128;
#pragma unroll
          for (int i = 0; i < 4; ++i) { const int p = F.tid + 512 * i; *(LAS u32x4*)(F.lds + G3_WS + (p >> 4) * VT_PITCH + (p & 15) * 16) = *(const GAS u32x4*)(wsg0 + (size_t)(p >> 4) * 128 + (p & 15) * 8); } }
    }
    u32x4 vreg[8];
    if (unit0 < 1024) {
#pragma unroll
        for (int i = 0; i < 8; ++i) { const int qq = F.tid + 512 * i, s = qq & 127, d8 = qq >> 7;
            vreg[i] = *(const GAS u32x4*)(V + (size_t)((((unsigned)(unit0 >> 3) * 8u + (unsigned)g) * 32u + (unsigned)d8) * 128u + (unsigned)s) * 8u); } }
    __syncthreads();
    int par = 0;
    for (int unit = unit0; unit < 1024; unit += F.G, par ^= 1) {
        const int row0 = (unit >> 3) * 128; const LAS float* ST = (const LAS float*)(F.lds + (par ? G3_ST2 : G3_ST));
        u32x2 ureg[8][2]; float bsv[8];
#pragma unroll
        for (int tt = 0; tt < 8; ++tt) { const int t = 16 * tt + r; const size_t off = (size_t)(row0 + t) * D + g * 256 + 32 * F.wave + 4 * q;
            ureg[tt][0] = *(const GAS u32x2*)(U + off); ureg[tt][1] = *(const GAS u32x2*)(U + off + 16); bsv[tt] = *(const GAS float*)(bs + g * 128 + t); }
#pragma unroll
        for (int i = 0; i < 8; ++i) { const int qq = F.tid + 512 * i, s = qq & 127, d0 = (qq >> 7) * 8;
            const u32x4 w = vreg[i]; const float mean = ST[s * 2], rstd = ST[s * 2 + 1];
            const f32x4 g0 = *(const LAS f32x4*)(GB + d0), g1 = *(const LAS f32x4*)(GB + d0 + 4), b0 = *(const LAS f32x4*)(GB + 256 + d0), b1 = *(const LAS f32x4*)(GB + 256 + d0 + 4);
            const float x[8] = {bf_lo(w.x), bf_hi(w.x), bf_lo(w.y), bf_hi(w.y), bf_lo(w.z), bf_hi(w.z), bf_lo(w.w), bf_hi(w.w)};
            const float gg[8] = {g0.x, g0.y, g0.z, g0.w, g1.x, g1.y, g1.z, g1.w}, bb[8] = {b0.x, b0.y, b0.z, b0.w, b1.x, b1.y, b1.z, b1.w};
            LAS unsigned char* vt = VT + (d0 + podd) * VT_PITCH + (s & ~1) * 2;
#pragma unroll
            for (int k = 0; k < 4; ++k) { const unsigned pk = cvt_pk_bf16_nop((x[2 * k] - mean) * rstd * gg[2 * k] + bb[2 * k], (x[2 * k + 1] - mean) * rstd * gg[2 * k + 1] + bb[2 * k + 1]);
                const unsigned y = (unsigned)__builtin_amdgcn_update_dpp(0, (int)pk, 0xB1, 0xf, 0xf, true); *(LAS unsigned*)(vt + (2 * k) * VT_PITCH) = __builtin_amdgcn_perm(y, pk, psel); } }
        __syncthreads();
        bf16x8 af[2][4];
#pragma unroll
        for (int dd = 0; dd < 2; ++dd)
#pragma unroll
            for (int ks = 0; ks < 4; ++ks) af[dd][ks] = *(const LAS bf16x8*)(VT + (16 * (2 * F.wave + dd) + r) * VT_PITCH + (32 * ks + 8 * q) * 2);
        if (unit + F.G < 1024) { const int un = unit + F.G;
#pragma unroll
            for (int i = 0; i < 8; ++i) { const int qq = F.tid + 512 * i, s = qq & 127, d8 = qq >> 7;
                vreg[i] = *(const GAS u32x4*)(V + (size_t)((((unsigned)(un >> 3) * 8u + (unsigned)g) * 32u + (unsigned)d8) * 128u + (unsigned)s) * 8u); }
            if (F.tid < 128) g3_stats(VSTAT, (un >> 3) * 128, F.tid, (LAS float*)(F.lds + (par ? G3_ST : G3_ST2))); }
#pragma unroll
        for (int tt = 0; tt < 8; ++tt) { bf16x8 bfr[4];
#pragma unroll
            for (int ks = 0; ks < 4; ++ks) bfr[ks] = *(const LAS bf16x8*)(F.lds + G3_WS + (16 * tt + r) * VT_PITCH + (32 * ks + 8 * q) * 2);
            f32x4 a0 = (f32x4){0.f, 0.f, 0.f, 0.f}, a1 = a0;
#pragma unroll
            for (int ks = 0; ks < 4; ++ks) { a0 = __builtin_amdgcn_mfma_f32_16x16x32_bf16(af[0][ks], bfr[ks], a0, 0, 0, 0); a1 = __builtin_amdgcn_mfma_f32_16x16x32_bf16(af[1][ks], bfr[ks], a1, 0, 0, 0); }
            const int t = 16 * tt + r; const float bias = bsv[tt]; const size_t off = (size_t)(row0 + t) * D + g * 256 + 32 * F.wave + 4 * q;
            { const u32x2 uu = ureg[tt][0]; int o_ = 0; o_ = __builtin_amdgcn_cvt_pk_fp8_f32(bf_lo(uu.x) * (a0[0] + bias), bf_hi(uu.x) * (a0[1] + bias), o_, false); o_ = __builtin_amdgcn_cvt_pk_fp8_f32(bf_lo(uu.y) * (a0[2] + bias), bf_hi(uu.y) * (a0[3] + bias), o_, true); *(GAS unsigned*)((unsigned char*)YG + off) = (unsigned)o_; }
            { const u32x2 uu = ureg[tt][1]; int o_ = 0; o_ = __builtin_amdgcn_cvt_pk_fp8_f32(bf_lo(uu.x) * (a1[0] + bias), bf_hi(uu.x) * (a1[1] + bias), o_, false); o_ = __builtin_amdgcn_cvt_pk_fp8_f32(bf_lo(uu.y) * (a1[2] + bias), bf_hi(uu.y) * (a1[3] + bias), o_, true); *(GAS unsigned*)((unsigned char*)YG + off + 16) = (unsigned)o_; }
            __builtin_amdgcn_sched_barrier(0); }
        __syncthreads();
    }
}


struct MlstmInProb : RectBase<D, MIN_MAIN> {
    bf16* Q; bf16* Kb; bf16* V; bf16* O;
    __device__ __forceinline__ void epi(const f32x4 (&acc)[2][2][4][2], const pg8::Unit& u, int wr, int wc, int fr, int fq) const {
        bf16* base; float sc = 1.f; unsigned off0, SA, SM, SB;
        const unsigned row0 = (unsigned)(u.pm * 256 + wr * 64 + fr), bb = row0 >> 12, chunk0 = (row0 >> 7) & 31u, s0 = row0 & 127u;
        if (u.pn < 4) { base = Q; sc = 0.08838834764831845f; off0 = row0 * QKW + u.pn * 256 + wc * 32 + 8 * fq; SA = 128u * QKW; SM = 16u * QKW; SB = 128u; }
        else if (u.pn < 8) { base = Kb; const unsigned hb = (unsigned)(u.pn - 4) * 2u, seg = (unsigned)(wc * 4 + fq);
            off0 = ((((bb * 8u + hb) * 32u + chunk0) * 16u + seg) * 128u + s0) * 8u; SA = 16384u; SM = 128u; SB = 524288u; }
        else if (u.pn < 16) { base = V; const unsigned h = (unsigned)(u.pn - 8), v8 = (unsigned)((wc & 1) * 4 + fq);
            off0 = (((((bb * 8u + h) * 4u + (unsigned)(wc >> 1)) * 32u + chunk0) * 8u + v8) * 128u + s0) * 8u; SA = 8192u; SM = 128u; SB = 524288u; }
        else { base = O; off0 = row0 * VW + (u.pn - 16) * 256 + wc * 32 + 8 * fq; SA = 128u * VW; SM = 16u * VW; SB = 128u; }
#pragma unroll
        for (int ai = 0; ai < 2; ++ai)
#pragma unroll
            for (int m = 0; m < 4; ++m) { bf16* rowp = base + (size_t)(off0 + ai * SA + m * SM);
#pragma unroll
                for (int bj = 0; bj < 2; ++bj) { const f32x4 v0 = acc[ai][bj][m][0] * sc, v1 = acc[ai][bj][m][1] * sc;
                    u32x4 w; w.x = cvt_pk_bf16(v0[0], v0[1]); w.y = cvt_pk_bf16(v0[2], v0[3]); w.z = cvt_pk_bf16(v1[0], v1[1]); w.w = cvt_pk_bf16(v1[2], v1[3]);
                    *(GAS u32x4*)(rowp + (size_t)(bj * SB)) = w; } }
    }
};
template <class Fn, int... I> __device__ __forceinline__ void sfor_impl(Fn&& f, std::integer_sequence<int, I...>) { (f(std::integral_constant<int, I>{}), ...); }
template <int N, class Fn> __device__ __forceinline__ void sfor(Fn&& f) { sfor_impl(static_cast<Fn&&>(f), std::make_integer_sequence<int, N>{}); }
template <int OFF> __device__ __forceinline__ bf16x8 lds_ld128(const LAS unsigned char* a) { return *(const LAS bf16x8*)(a + OFF); }
template <int OFF> __device__ __forceinline__ u32x2 lds_ld64(const LAS unsigned char* a) { return *(const LAS u32x2*)(a + OFF); }
#define LDS_LANDED10(a, b) __builtin_amdgcn_sched_barrier(0)
#define MFMA_DRAIN(vec) do { __builtin_amdgcn_sched_barrier(0); const int d_ = __builtin_amdgcn_readfirstlane(__builtin_bit_cast(int, (vec)[0])); asm volatile("" :: "s"(d_)); __builtin_amdgcn_sched_barrier(0); } while (0)
#define SFOR(n, var) sfor<n>([&](auto var##_) __attribute__((always_inline)) { constexpr int var = decltype(var##_)::value;
#define SFOR_END });
constexpr int SP = 272;
constexpr int SC_KI = 0, SC_KT = 34816, SC_VT = 69632, SC_VW = 91392, SC_CT = 113152, SC_TB = 134912, SC_TBF = 672;
__device__ __forceinline__ size_t ktile(int b, int h, int dir, int c, int j, int g) { const int cc = dir ? 31 - c : c, s = dir ? 127 - j : j; return ((size_t)((((b * 8 + h) * 32 + cc) * 16 + g) * 128 + s)) * 8; }
__device__ __forceinline__ size_t vtile(int b, int h, int dvs, int dir, int c, int j, int g) { const int cc = dir ? 31 - c : c, s = dir ? 127 - j : j; return ((size_t)(((((b * 8 + h) * 4 + dvs) * 32 + cc) * 8 + g) * 128 + s)) * 8; }
__device__ __forceinline__ int scan_row(int b, int dir, int c, int j) { return b * SEQ + (dir ? (31 - c) * 128 + (127 - j) : c * 128 + j); }
__device__ __forceinline__ float log_sigmoid(float x) {
    const float e = __expf(-fabsf(x)), u = 1.f + e;
    const float l = (u == 1.f) ? e : __logf(u) * (e * __builtin_amdgcn_rcpf(u - 1.f));
    return fminf(x, 0.f) - l;
}
template <int CTRL, int ROWM> __device__ __forceinline__ float dpp_take(float ident, float v) {
    return __builtin_bit_cast(float, __builtin_amdgcn_update_dpp(__builtin_bit_cast(int, ident), __builtin_bit_cast(int, v), CTRL, ROWM, 0xf, false)); }
__device__ __forceinline__ float wave_scan_add(float x) {
    x += dpp_take<0x111, 0xf>(0.f, x); x += dpp_take<0x112, 0xf>(0.f, x); x += dpp_take<0x114, 0xf>(0.f, x); x += dpp_take<0x118, 0xf>(0.f, x);
    x += dpp_take<0x142, 0xa>(0.f, x); x += dpp_take<0x143, 0xc>(0.f, x); return x; }
__device__ __forceinline__ float wave_scan_max(float x) {
    const float ni = -__builtin_inff();
    x = fmaxf(x, dpp_take<0x111, 0xf>(ni, x)); x = fmaxf(x, dpp_take<0x112, 0xf>(ni, x)); x = fmaxf(x, dpp_take<0x114, 0xf>(ni, x)); x = fmaxf(x, dpp_take<0x118, 0xf>(ni, x));
    x = fmaxf(x, dpp_take<0x142, 0xa>(ni, x)); x = fmaxf(x, dpp_take<0x143, 0xc>(ni, x)); return x; }
__device__ __forceinline__ void scan_gate_load(const float* GT, int b, int dir, int c, int gi, int lane, float (&gv)[4]) {
    const int t0 = scan_row(b, dir, c, 2 * lane), t1 = scan_row(b, dir, c, 2 * lane + 1);
    const GAS float* G = (const GAS float*)GT; gv[0] = G[(size_t)t0 * 32 + gi]; gv[1] = G[(size_t)t1 * 32 + gi]; gv[2] = G[(size_t)t0 * 32 + gi + 8]; gv[3] = G[(size_t)t1 * 32 + gi + 8];
}
__device__ __forceinline__ void scan_tables(LAS float* TB, const float (&gv)[4], int lane, float& m) {
    const float i0 = gv[0], i1 = gv[1], f0 = log_sigmoid(gv[2]), f1 = log_sigmoid(gv[3]);
    const float x = wave_scan_add(f0 + f1);
    const float b1 = x, b0 = x - f1, u0 = i0 - b0, u1 = i1 - b1;
    const float z = wave_scan_max(fmaxf(u0, u1));
    float ex = __shfl_up(z, 1); if (lane == 0) ex = -__builtin_inff();
    const float M0 = fmaxf(m, fmaxf(ex, u0)), M1 = fmaxf(m, z);
    const float Ml = __builtin_bit_cast(float, __builtin_amdgcn_readlane(__builtin_bit_cast(int, M1), 63)), bl = __builtin_bit_cast(float, __builtin_amdgcn_readlane(__builtin_bit_cast(int, b1), 63));
    TB[2 * lane] = u0; TB[2 * lane + 1] = u1; TB[128 + 2 * lane] = M0; TB[128 + 2 * lane + 1] = M1;
    TB[256 + 2 * lane] = __expf(-(b0 + M0)); TB[256 + 2 * lane + 1] = __expf(-(b1 + M1));
    TB[384 + 2 * lane] = __expf(u0 - Ml); TB[384 + 2 * lane + 1] = __expf(u1 - Ml);
    TB[512 + 2 * lane] = __expf(m - M0); TB[512 + 2 * lane + 1] = __expf(m - M1);
    if (lane == 0) TB[640] = __expf(m - Ml);
    m = bl + Ml;
}
__device__ __forceinline__ void m2_scan(Frame& F) {
    F.rethread();
    LAS unsigned char* L = F.lds;
    const bf16* Qg = (const bf16*)(F.wsp() + WS_MQ); const bf16* Kg = (const bf16*)(F.wsp() + WS_MK); const bf16* Vg = (const bf16*)(F.wsp() + WS_MV); const float* GT = (const float*)(F.wsp() + WS_GATES);
    const int w = F.wave, lane = F.lane, c16 = lane & 15, q = lane >> 4, tid = F.tid;
    for (int cblk = blockIdx.x; cblk < 256; cblk += F.G) {
        const int chain = (cblk & 7) * 32 + (cblk >> 3);
        const int dvs = chain & 3, dir = (chain >> 2) & 1, h = (chain >> 3) & 7, b = chain >> 6;
        bf16* Hout = (bf16*)(F.wsp() + (dir ? WS_HB : WS_HF));
        const int qcol0 = h * 128, vcol0 = h * 256 + dvs * 64, gi = 2 * dir * 8 + h;
        const LAS unsigned char* lbase = L + c16 * SP;
        const LAS unsigned char* bKI = lbase + SC_KI + 16 * q; const LAS unsigned char* bCT = lbase + SC_CT + 16 * q; const LAS unsigned char* bVT = lbase + SC_VT + 8 * q;
        const LAS unsigned char* bVW = lbase + SC_VW + 16 * q; const LAS unsigned char* bKT = lbase + SC_KT + 16 * w * SP + 16 * q;
        for (int i = tid; i < 80 * SP / 4; i += NTHREADS) ((LAS unsigned*)(L + SC_CT))[i] = 0u;
        for (int i = tid; i < 16 * SP / 4; i += NTHREADS) { ((LAS unsigned*)(L + SC_VT + 64 * SP))[i] = (i < SP / 4) ? 0x3F803F80u : 0u; ((LAS unsigned*)(L + SC_VW + 64 * SP))[i] = 0u; }
        f32x4 cacc[5];
#pragma unroll
        for (int vt = 0; vt < 5; ++vt) cacc[vt] = (f32x4){0.f, 0.f, 0.f, 0.f};
        const int nK = w < 4 ? 6 : (w < 6 ? 4 : 0), nV = nK >> 1, kbase = w < 4 ? 6 * w : (w == 4 ? 24 : 28), vbase = w < 4 ? 3 * w : (w == 4 ? 12 : 14);
        u32x4 kn[6], vn[3]; bf16x8 qn[4];
#pragma unroll
        for (int i = 0; i < 6; ++i) { kn[i] = (u32x4){0u, 0u, 0u, 0u}; if (i < nK) kn[i] = *(const GAS u32x4*)(Kg + ktile(b, h, dir, 0, 64 * (i & 1) + lane, (kbase + i) >> 1)); }
#pragma unroll
        for (int i = 0; i < 3; ++i) { vn[i] = (u32x4){0u, 0u, 0u, 0u}; if (i < nV) vn[i] = *(const GAS u32x4*)(Vg + vtile(b, h, dvs, dir, 0, 64 * ((vbase + i) & 1) + lane, (vbase + i) >> 1)); }
#pragma unroll
        for (int ks = 0; ks < 4; ++ks) qn[ks] = *(const GAS bf16x8*)(Qg + (size_t)scan_row(b, dir, 0, 16 * w + c16) * QKW + qcol0 + 32 * ks + 8 * q);
        float m_run = 0.f;
        float gv[4] = {0.f, 0.f, 0.f, 0.f};
        if (w == 0) { scan_gate_load(GT, b, dir, 0, gi, lane, gv); scan_tables((LAS float*)(L + SC_TB), gv, lane, m_run); scan_gate_load(GT, b, dir, 1, gi, lane, gv); }
        __syncthreads();
#pragma unroll 1
        for (int c = 0; c < 32; ++c) {
            const LAS float* TB = (const LAS float*)(L + SC_TB) + (c & 1) * SC_TBF;
            bf16x8 qf[4];
#pragma unroll
            for (int ks = 0; ks < 4; ++ks) qf[ks] = qn[ks];
            const unsigned psel = (lane & 1) ? 0x03020706u : 0x05040100u; const int podd = lane & 1;
#pragma unroll
            for (int i = 0; i < 6; ++i) if (i < nK) { const int s = 64 * (i & 1) + lane, d8 = (kbase + i) >> 1; *(LAS u32x4*)(L + SC_KI + s * SP + d8 * 16) = kn[i]; }
#pragma unroll
            for (int i = 0; i < 3; ++i) if (i < nV) { const int s = 64 * ((vbase + i) & 1) + lane, v8 = (vbase + i) >> 1; const u32x4 vv = vn[i];
                LAS unsigned char* vt = L + SC_VT + (8 * v8 + podd) * SP + (s & ~1) * 2; const unsigned ww[4] = {vv.x, vv.y, vv.z, vv.w};
#pragma unroll
                for (int e = 0; e < 4; ++e) { const unsigned y = (unsigned)__builtin_amdgcn_update_dpp(0, (int)ww[e], 0xB1, 0xf, 0xf, true); *(LAS unsigned*)(vt + (2 * e) * SP) = __builtin_amdgcn_perm(y, ww[e], psel); } }
            __syncthreads();
#pragma unroll
            for (int i = 0; i < 6; ++i) if (i < nK) { const int s = 64 * (i & 1) + lane, d8 = (kbase + i) >> 1; const u32x4 kv = kn[i];
                LAS unsigned char* kt = L + SC_KT + (8 * d8 + podd) * SP + (s & ~1) * 2; const unsigned kw[4] = {kv.x, kv.y, kv.z, kv.w};
#pragma unroll
                for (int e = 0; e < 4; ++e) { const unsigned y = (unsigned)__builtin_amdgcn_update_dpp(0, (int)kw[e], 0xB1, 0xf, 0xf, true); *(LAS unsigned*)(kt + (2 * e) * SP) = __builtin_amdgcn_perm(y, kw[e], psel); } }
#pragma unroll
            for (int i = 0; i < 3; ++i) if (i < nV) { const int s = 64 * ((vbase + i) & 1) + lane, v8 = (vbase + i) >> 1; const u32x4 vv = vn[i]; const float wk = TB[384 + s];
                LAS unsigned char* vw = L + SC_VW + (8 * v8 + podd) * SP + (s & ~1) * 2; const unsigned ww[4] = {vv.x, vv.y, vv.z, vv.w};
#pragma unroll
                for (int e = 0; e < 4; ++e) { const unsigned sc = cvt_pk_bf16_nop(bf_lo(ww[e]) * wk, bf_hi(ww[e]) * wk); const unsigned ys = (unsigned)__builtin_amdgcn_update_dpp(0, (int)sc, 0xB1, 0xf, 0xf, true);
                    *(LAS unsigned*)(vw + (2 * e) * SP) = __builtin_amdgcn_perm(ys, sc, psel); } }
            if (tid < 128) *(LAS unsigned short*)(L + SC_VW + 64 * SP + tid * 2) = (unsigned short)f2bf(TB[384 + tid]);
            if (c + 1 < 32) {
                const int cc1 = dir ? 30 - c : c + 1;
                const char* KB = (const char*)Kg + (size_t)(((b * 8 + h) * 32 + cc1)) * 32768;
                const char* VB = (const char*)Vg + (size_t)((((b * 8 + h) * 4 + dvs) * 32 + cc1)) * 16384;
                const char* QB = (const char*)Qg + ((size_t)(b * SEQ + cc1 * 128) * QKW + qcol0) * 2;
                const unsigned lp = 16u * (unsigned)(dir ? 63 - lane : lane);
#pragma unroll
                for (int i = 0; i < 6; ++i) if (i < nK) { const int n = kbase + i, hf = n & 1; kn[i] = *(const GAS u32x4*)(KB + ((unsigned)((n >> 1) * 2048 + (dir ? 1 - hf : hf) * 1024) + lp)); }
#pragma unroll
                for (int i = 0; i < 3; ++i) if (i < nV) { const int n = vbase + i, hf = n & 1; vn[i] = *(const GAS u32x4*)(VB + ((unsigned)((n >> 1) * 2048 + (dir ? 1 - hf : hf) * 1024) + lp)); }
                const unsigned qo = (unsigned)((dir ? 127 - (16 * w + c16) : 16 * w + c16) * (QKW * 2) + 16 * q);
#pragma unroll
                for (int ks = 0; ks < 4; ++ks) qn[ks] = *(const GAS bf16x8*)(QB + (qo + 64u * ks));
            }
            if (w == 0 && c + 1 < 32) { scan_tables((LAS float*)(L + SC_TB) + ((c + 1) & 1) * SC_TBF, gv, lane, m_run); if (c + 2 < 32) scan_gate_load(GT, b, dir, c + 2, gi, lane, gv); }
            const float Mj = TB[128 + 16 * w + c16], iscj = TB[512 + 16 * w + c16], emtj = TB[256 + 16 * w + c16];
            const LAS unsigned char* bTB = (const LAS unsigned char*)TB + 16 * q;
            f32x4 ad[5], ac[5];
#pragma unroll
            for (int vt = 0; vt < 5; ++vt) { ad[vt] = (f32x4){0.f, 0.f, 0.f, 0.f}; ac[vt] = ad[vt]; }
            SFOR(2, kh) bf16x8 r0[5], r1[5];
                SFOR(5, vt) r0[vt] = lds_ld128<16 * vt * SP + 128 * kh>(bCT); r1[vt] = lds_ld128<16 * vt * SP + 128 * kh + 64>(bCT); SFOR_END
                LDS_LANDED10(r0, r1);
#pragma unroll
                for (int vt = 0; vt < 5; ++vt) ad[vt] = __builtin_amdgcn_mfma_f32_16x16x32_bf16(r0[vt], qf[2 * kh], ad[vt], 0, 0, 0);
#pragma unroll
                for (int vt = 0; vt < 5; ++vt) ad[vt] = __builtin_amdgcn_mfma_f32_16x16x32_bf16(r1[vt], qf[2 * kh + 1], ad[vt], 0, 0, 0);
                MFMA_DRAIN(ad[4]);
            SFOR_END
            bf16x8 pf[4];
            SFOR(4, kp) u32x4 t4 = (u32x4){0u, 0u, 0u, 0u};
                if (2 * kp <= w) {
                    bf16x8 a0[5], a1[5];
                    SFOR(4, ks) a0[ks] = lds_ld128<32 * kp * SP + 64 * ks>(bKI); a1[ks] = lds_ld128<(32 * kp + 16) * SP + 64 * ks>(bKI); SFOR_END
                    a0[4] = lds_ld128<32 * kp * 4>(bTB); a1[4] = lds_ld128<(32 * kp + 16) * 4>(bTB);
                    LDS_LANDED10(a0, a1);
                    const f32x4 ua = __builtin_bit_cast(f32x4, a0[4]), ub = __builtin_bit_cast(f32x4, a1[4]);
                    f32x4 s0 = (f32x4){0.f, 0.f, 0.f, 0.f}, s1 = s0;
#pragma unroll
                    for (int ks = 0; ks < 4; ++ks) { s0 = __builtin_amdgcn_mfma_f32_16x16x32_bf16(a0[ks], qf[ks], s0, 0, 0, 0); s1 = __builtin_amdgcn_mfma_f32_16x16x32_bf16(a1[ks], qf[ks], s1, 0, 0, 0); }
                    float p0[4], p1[4]; const int j = 16 * w + c16;
#pragma unroll
                    for (int i = 0; i < 4; ++i) { const int s = 32 * kp + 4 * q + i; p0[i] = (s <= j) ? s0[i] * __expf(ua[i] - Mj) : 0.f; p1[i] = (s + 16 <= j) ? s1[i] * __expf(ub[i] - Mj) : 0.f; }
                    t4.x = cvt_pk_bf16(p0[0], p0[1]); t4.y = cvt_pk_bf16(p0[2], p0[3]); t4.z = cvt_pk_bf16(p1[0], p1[1]); t4.w = cvt_pk_bf16(p1[2], p1[3]); }
                pf[kp] = __builtin_bit_cast(bf16x8, t4);
            SFOR_END
            SFOR(4, kp) if (2 * kp <= w) {
                u32x2 lo[5], hi[5];
                SFOR(5, vt) lo[vt] = lds_ld64<16 * vt * SP + 64 * kp>(bVT); hi[vt] = lds_ld64<16 * vt * SP + 64 * kp + 32>(bVT); SFOR_END
                LDS_LANDED10(lo, hi);
#pragma unroll
                for (int vt = 0; vt < 5; ++vt) { u32x4 t4; t4.x = lo[vt].x; t4.y = lo[vt].y; t4.z = hi[vt].x; t4.w = hi[vt].y; ac[vt] = __builtin_amdgcn_mfma_f32_16x16x32_bf16(__builtin_bit_cast(bf16x8, t4), pf[kp], ac[vt], 0, 0, 0); }
                MFMA_DRAIN(ac[4]); }
            SFOR_END
            f32x4 num[5];
#pragma unroll
            for (int vt = 0; vt < 5; ++vt) num[vt] = ac[vt] + ad[vt] * iscj;
            { const float den = __shfl(num[4][0], c16); const float inv = 1.f / fmaxf(fabsf(den), emtj);
              bf16* hrow = Hout + (size_t)scan_row(b, dir, c, 16 * w + c16) * VW + vcol0 + 4 * q;
#pragma unroll
              for (int vt = 0; vt < 4; ++vt) { u32x2 o; o.x = cvt_pk_bf16(num[vt][0] * inv, num[vt][1] * inv); o.y = cvt_pk_bf16(num[vt][2] * inv, num[vt][3] * inv); *(GAS u32x2*)(hrow + 16 * vt) = o; } }
            __syncthreads();
            { const float decay = TB[640];
#pragma unroll
              for (int vt = 0; vt < 5; ++vt) cacc[vt] = cacc[vt] * decay;
              SFOR(2, kh) bf16x8 b0[5], b1[5], ka0, ka1;
                  ka0 = lds_ld128<128 * kh>(bKT); ka1 = lds_ld128<128 * kh + 64>(bKT);
                  SFOR(5, vt) b0[vt] = lds_ld128<16 * vt * SP + 128 * kh>(bVW); b1[vt] = lds_ld128<16 * vt * SP + 128 * kh + 64>(bVW); SFOR_END
                  LDS_LANDED10(b0, b1);
#pragma unroll
                  for (int vt = 0; vt < 5; ++vt) cacc[vt] = __builtin_amdgcn_mfma_f32_16x16x32_bf16(ka0, b0[vt], cacc[vt], 0, 0, 0);
#pragma unroll
                  for (int vt = 0; vt < 5; ++vt) cacc[vt] = __builtin_amdgcn_mfma_f32_16x16x32_bf16(ka1, b1[vt], cacc[vt], 0, 0, 0);
                  MFMA_DRAIN(cacc[4]);
              SFOR_END
#pragma unroll
              for (int vt = 0; vt < 5; ++vt) { u32x2 o; o.x = cvt_pk_bf16(cacc[vt][0], cacc[vt][1]); o.y = cvt_pk_bf16(cacc[vt][2], cacc[vt][3]); *(LAS u32x2*)(L + SC_CT + (16 * vt + c16) * SP + (16 * w + 4 * q) * 2) = o; } }
            __syncthreads();
        }
    }
}
__device__ __forceinline__ float half_wave_sum(float x) {
    x += __builtin_bit_cast(float, __builtin_amdgcn_update_dpp(0, __builtin_bit_cast(int, x), 0xB1, 0xf, 0xf, true));
    x += __builtin_bit_cast(float, __builtin_amdgcn_update_dpp(0, __builtin_bit_cast(int, x), 0x4E, 0xf, 0xf, true));
    x += __builtin_bit_cast(float, __builtin_amdgcn_update_dpp(0, __builtin_bit_cast(int, x), 0x141, 0xf, 0xf, true));
    x += __builtin_bit_cast(float, __builtin_amdgcn_update_dpp(0, __builtin_bit_cast(int, x), 0x140, 0xf, 0xf, true));
    return x + __shfl_xor(x, 16);
}
__device__ __forceinline__ void m3_combine(Frame& F, int j) {
    F.rethread();
    const bf16* HF = (const bf16*)(F.wsp() + WS_HF); const bf16* HB = (const bf16*)(F.wsp() + WS_HB); const bf16* O = (const bf16*)(F.wsp() + WS_MO); bf16* HG = (bf16*)(F.wsp() + WS_HG);
    float g[32]; load_lane_vec32(F.inp(I_MNG) + (size_t)j * VW, F.lane, g);
    const int t0 = blockIdx.x * NWAVES + F.wave, tstep = F.G * NWAVES;
    u32x4 ra[4], rb[4], ro[4];
#pragma unroll
    for (int jj = 0; jj < 4; ++jj) { ra[jj] = *(const GAS u32x4*)(HF + (size_t)t0 * VW + 8 * F.lane + 512 * jj); rb[jj] = *(const GAS u32x4*)(HB + (size_t)t0 * VW + 8 * F.lane + 512 * jj); ro[jj] = *(const GAS u32x4*)(O + (size_t)t0 * VW + 8 * F.lane + 512 * jj); }
    for (int t = t0; t < T; t += tstep) {
        float a[32], o[32];
#pragma unroll
        for (int jj = 0; jj < 4; ++jj) { const unsigned wa[4] = {ra[jj].x, ra[jj].y, ra[jj].z, ra[jj].w}, wb[4] = {rb[jj].x, rb[jj].y, rb[jj].z, rb[jj].w}, wo[4] = {ro[jj].x, ro[jj].y, ro[jj].z, ro[jj].w};
#pragma unroll
            for (int e = 0; e < 4; ++e) { a[8 * jj + 2 * e] = bf_lo(wa[e]) + bf_lo(wb[e]); a[8 * jj + 2 * e + 1] = bf_hi(wa[e]) + bf_hi(wb[e]); o[8 * jj + 2 * e] = bf_lo(wo[e]); o[8 * jj + 2 * e + 1] = bf_hi(wo[e]); } }
        if (t + tstep < T) { const size_t rn = (size_t)(t + tstep) * VW + 8 * F.lane;
#pragma unroll
            for (int jj = 0; jj < 4; ++jj) { ra[jj] = *(const GAS u32x4*)(HF + rn + 512 * jj); rb[jj] = *(const GAS u32x4*)(HB + rn + 512 * jj); ro[jj] = *(const GAS u32x4*)(O + rn + 512 * jj); } }
#pragma unroll
        for (int jj = 0; jj < 4; ++jj) { float s = 0.f;
#pragma unroll
            for (int e = 0; e < 8; ++e) s += a[8 * jj + e];
            const float mean = half_wave_sum(s) * (1.f / 256.f); float s2 = 0.f;
#pragma unroll
            for (int e = 0; e < 8; ++e) { a[8 * jj + e] -= mean; s2 += a[8 * jj + e] * a[8 * jj + e]; }
            const float rstd = 1.f / sqrtf(half_wave_sum(s2) * (1.f / 256.f) + LN_EPS);
#pragma unroll
            for (int e = 0; e < 8; ++e) a[8 * jj + e] = a[8 * jj + e] * rstd * g[8 * jj + e] * __builtin_amdgcn_rcpf(1.f + __expf(-o[8 * jj + e])); }
        { unsigned char* h8 = (unsigned char*)HG + (size_t)t * VW;
#pragma unroll
          for (int jj = 0; jj < 4; ++jj) { int a_ = 0, b_ = 0; a_ = __builtin_amdgcn_cvt_pk_fp8_f32(a[8 * jj], a[8 * jj + 1], a_, false); a_ = __builtin_amdgcn_cvt_pk_fp8_f32(a[8 * jj + 2], a[8 * jj + 3], a_, true);
              b_ = __builtin_amdgcn_cvt_pk_fp8_f32(a[8 * jj + 4], a[8 * jj + 5], b_, false); b_ = __builtin_amdgcn_cvt_pk_fp8_f32(a[8 * jj + 6], a[8 * jj + 7], b_, true);
              *(GAS u32x2*)(h8 + 8 * F.lane + 512 * jj) = (u32x2){(unsigned)a_, (unsigned)b_}; } }
    }
}

struct MoeOrderBase {
    LAS unsigned* X; int G, c, NT;
    __device__ __forceinline__ bool next_(int i, pg8::Unit& u) const {
        const int ntiles = (int)X[XW_NTILES], nwg = ntiles * NT; const long L = (long)i * G + c; if (L >= nwg) return false;
        const int wgid = pg8::xcd_remap((int)L, nwg); const int ti = wgid / NT; u.pn = wgid % NT;
        u.e = __builtin_amdgcn_readfirstlane((int)X[XW_TILE_E + ti]); u.pm = ti - __builtin_amdgcn_readfirstlane((int)X[XW_TPRE + u.e]); u.x = 0; return true;
    }
};
struct E1Prob : MoeOrderBase {
    static constexpr int K = D / 2; static constexpr bool PERM = true, FP8 = true; static constexpr int SCALE_B = 0x79797979;
    const unsigned char* X1; const unsigned char* Wt; const float* bgu; unsigned char* hact; const int* list;
    __device__ __forceinline__ bool next(int i, pg8::Unit& u) const { return next_(i, u); }
    __device__ __forceinline__ void bases(const pg8::Unit& u, const char*& cA, const char*& cB) const { cA = (const char*)X1; cB = (const char*)(Wt + ((size_t)u.e * 1024 + (size_t)u.pn * 256) * D); }
    __device__ __forceinline__ void avoff(const pg8::Unit& u, int tid, unsigned (&v)[2][2]) const {
        const int cnt = (int)X[XW_CNT + u.e];
#pragma unroll
        for (int i = 0; i < 2; ++i) { int R, C; pg8::stage_rc(tid * 16 + i * 8192, R, C);
#pragma unroll
            for (int h = 0; h < 2; ++h) { int idx = u.pm * 256 + h * 128 + R; idx = idx < cnt ? idx : cnt - 1;
                const int tok = __hip_atomic_load((const GAS int*)list + ((size_t)u.e * CAP + idx), RLX_AGENT); v[h][i] = (unsigned)tok * (unsigned)D + (unsigned)C * 2u; } }
    }
    __device__ __forceinline__ void epi(const f32x4 (&acc)[2][2][4][2], const pg8::Unit& u, int wr, int wc, int fr, int fq) const {
        const unsigned slot0 = X[XW_PSTART + u.e] + (unsigned)u.pm * 256u + (unsigned)(wr * 64 + fr);
        const int hc = u.pn * 128 + wc * 32 + 8 * fq;
        const float* bg = bgu + (size_t)u.e * 1024 + hc;
#pragma unroll
        for (int ai = 0; ai < 2; ++ai)
#pragma unroll
            for (int m = 0; m < 4; ++m) { unsigned char* rowp = hact + (size_t)(slot0 + ai * 128 + m * 16) * FF + hc; float o[8];
#pragma unroll
                for (int n = 0; n < 2; ++n) { const f32x4 bgv = *(const GAS f32x4*)(bg + 4 * n), buv = *(const GAS f32x4*)(bg + 512 + 4 * n);
#pragma unroll
                    for (int j = 0; j < 4; ++j) { float gv = acc[ai][0][m][n][j] + bgv[j], uv = acc[ai][1][m][n][j] + buv[j];
                        gv = fminf(gv, 7.0f); uv = fminf(fmaxf(uv, -7.0f), 7.0f);
                        o[4 * n + j] = (uv + 1.0f) * gv * __builtin_amdgcn_rcpf(1.0f + __expf(-1.702f * gv)); } }
                asm volatile("" ::: "memory");
                u32x2 w; { int a_ = 0, b_ = 0; a_ = __builtin_amdgcn_cvt_pk_fp8_f32(o[0], o[1], a_, false); a_ = __builtin_amdgcn_cvt_pk_fp8_f32(o[2], o[3], a_, true);
                    b_ = __builtin_amdgcn_cvt_pk_fp8_f32(o[4], o[5], b_, false); b_ = __builtin_amdgcn_cvt_pk_fp8_f32(o[6], o[7], b_, true); w.x = (unsigned)a_; w.y = (unsigned)b_; }
                *(GAS u32x2*)rowp = w; }
    }
};
struct E2Prob : MoeOrderBase {
    static constexpr int K = FF / 2; static constexpr bool PERM = true, FP8 = true; static constexpr int SCALE_B = 0x79797979;
    const unsigned char* hact; const unsigned char* Wt; const float* bdn; unsigned char* Y;
    __device__ __forceinline__ bool next(int i, pg8::Unit& u) const { return next_(i, u); }
    __device__ __forceinline__ void bases(const pg8::Unit& u, const char*& cA, const char*& cB) const {
        cA = (const char*)(hact + (size_t)(X[XW_PSTART + u.e] + (unsigned)u.pm * 256u) * FF); cB = (const char*)(Wt + ((size_t)u.e * D + (size_t)u.pn * 256) * FF); }
    __device__ __forceinline__ void avoff(const pg8::Unit&, int tid, unsigned (&v)[2][2]) const {
#pragma unroll
        for (int i = 0; i < 2; ++i) { int R, C; pg8::stage_rc(tid * 16 + i * 8192, R, C);
#pragma unroll
            for (int h = 0; h < 2; ++h) v[h][i] = (unsigned)((h * 128 + R) * (FF / 2) + C) * 2u; }
    }
    __device__ __forceinline__ void epi(const f32x4 (&acc)[2][2][4][2], const pg8::Unit& u, int wr, int wc, int fr, int fq) const {
        const unsigned slot0 = X[XW_PSTART + u.e] + (unsigned)u.pm * 256u + (unsigned)(wr * 64 + fr);
        const int c0 = u.pn * 256 + wc * 32 + 8 * fq;
        const float* bp = bdn + (size_t)u.e * D + c0;
        f32x4 bv[2][2];
#pragma unroll
        for (int bj = 0; bj < 2; ++bj)
#pragma unroll
            for (int n = 0; n < 2; ++n) bv[bj][n] = *(const GAS f32x4*)(bp + bj * 128 + 4 * n);
#pragma unroll
        for (int ai = 0; ai < 2; ++ai)
#pragma unroll
            for (int m = 0; m < 4; ++m) { unsigned char* rowp = Y + (size_t)(slot0 + ai * 128 + m * 16) * D + c0;
#pragma unroll
                for (int bj = 0; bj < 2; ++bj) { const f32x4 v0 = (acc[ai][bj][m][0] + bv[bj][0]) * Y_SCALE, v1 = (acc[ai][bj][m][1] + bv[bj][1]) * Y_SCALE;
                    int a_ = 0, b_ = 0; a_ = __builtin_amdgcn_cvt_pk_fp8_f32(v0[0], v0[1], a_, false); a_ = __builtin_amdgcn_cvt_pk_fp8_f32(v0[2], v0[3], a_, true);
                    b_ = __builtin_amdgcn_cvt_pk_fp8_f32(v1[0], v1[1], b_, false); b_ = __builtin_amdgcn_cvt_pk_fp8_f32(v1[2], v1[3], b_, true);
                    *(GAS u32x2*)(rowp + bj * 128) = (u32x2){(unsigned)a_, (unsigned)b_}; } }
    }
};


#define GRID_BAR() do { XcdBarrier bar_; bar_.bar = (unsigned*)(F.ctlp() + CW_BAR); bar_.x = xb_xcc_id(); bar_.st = (volatile LAS unsigned*)(F.X + XW_BAR); F.rethread(); xcd_barrier(bar_, F.tid == 0); } while (0)
#ifndef REP_M1
#define REP_M1 1
#endif
#ifndef REP_OUT
#define REP_OUT 1
#endif
#ifndef REP_G1
#define REP_G1 1
#endif
#ifndef REP_M3
#define REP_M3 1
#endif
#ifndef REP_P0A
#define REP_P0A 1
#endif
#ifndef REP_SCAN
#define REP_SCAN 1
#endif
#ifndef REP_E1
#define REP_E1 1
#endif
#ifndef REP_E2
#define REP_E2 1
#endif
#ifndef REP_G3
#define REP_G3 1
#endif
#ifndef REP_R2
#define REP_R2 1
#endif
#ifndef FILL_E1
#define FILL_E1 20
#endif
#ifndef FILL_E2
#define FILL_E2 3
#endif
#ifndef MOE_LAYER_MASK
#define MOE_LAYER_MASK 15
#endif
template <int layer> __device__ __forceinline__ void moe_layer(Frame& F) {
    if constexpr ((layer & 1) == 1) {
        constexpr int j = layer / 2;
        for (int rep_ = 0; rep_ < REP_G1; ++rep_) {
        { GmlpInProb P; P.A = (const bf16*)(F.wsp() + WS_XB); P.Bt = (const bf16*)(F.wsp() + WS_WGI) + (size_t)j * 4096 * D; P.G = F.G; P.c = (int)blockIdx.x;
          P.bias = F.inp(I_GBIN) + (size_t)j * 4096; P.U = (bf16*)(F.wsp() + WS_GU); P.V = (bf16*)(F.wsp() + WS_GV); P.VSTAT = (float*)(F.wsp() + WS_VSTAT);
          pg8::gemm_phase<GmlpInProb, true>(F.lds, P, F.wave0); }
        GRID_BAR(); }
        for (int rep = 0; rep < REP_G3; ++rep) { g3_phase(F, j); GRID_BAR(); }
        for (int rep_ = 0; rep_ < REP_OUT; ++rep_) {
        { OutProjProb P; P.A = (const bf16*)(F.wsp() + WS_GY); P.Bt = (const bf16*)(F.wsp() + WS_WGO + (size_t)j * D * D); P.G = F.G; P.c = (int)blockIdx.x;
          P.XB = (const bf16*)(F.wsp() + WS_XB); P.PRE = (bf16*)(F.wsp() + WS_PRE);
          pg8::gemm_phase<OutProjProb, true>(F.lds, P, F.wave0); }
        GRID_BAR(); }
    } else {
        constexpr int j = layer / 2;
        for (int rep_ = 0; rep_ < REP_M1; ++rep_) {
        { MlstmInProb P; P.A = (const bf16*)(F.wsp() + WS_XB); P.Bt = (const bf16*)(F.wsp() + WS_WMI) + (size_t)j * MIN_MAIN * D; P.G = F.G; P.c = (int)blockIdx.x;
          P.Q = (bf16*)(F.wsp() + WS_MQ); P.Kb = (bf16*)(F.wsp() + WS_MK); P.V = (bf16*)(F.wsp() + WS_MV); P.O = (bf16*)(F.wsp() + WS_MO);
          pg8::gemm_phase<MlstmInProb, true>(F.lds, P, F.wave0); }
        GRID_BAR(); }
        for (int rep = 0; rep < REP_SCAN; ++rep) { m2_scan(F); GRID_BAR(); }
        for (int rep_ = 0; rep_ < REP_M3; ++rep_) { m3_combine(F, j); GRID_BAR(); }
        for (int rep_ = 0; rep_ < REP_OUT; ++rep_) {
        { OutProjProb P; P.A = (const bf16*)(F.wsp() + WS_HG); P.Bt = (const bf16*)(F.wsp() + WS_WMO + (size_t)j * D * D); P.G = F.G; P.c = (int)blockIdx.x;
          P.XB = (const bf16*)(F.wsp() + WS_XB); P.PRE = (bf16*)(F.wsp() + WS_PRE);
          pg8::gemm_phase<OutProjProb, true>(F.lds, P, F.wave0); }
        GRID_BAR(); }
    }
    r1_phase(F, layer); GRID_BAR();
    moe_tables(F, layer);
    if constexpr ((MOE_LAYER_MASK >> layer) & 1) {
    for (int rep = 0; rep < REP_E1; ++rep) {
    { E1Prob P; P.X = F.X; P.G = F.G; P.c = (int)blockIdx.x; P.NT = 4; P.X1 = (const unsigned char*)(F.wsp() + WS_X1F8); P.Wt = (const unsigned char*)(F.wsp() + WS_WGU) + (size_t)layer * 32 * 1024 * D;
      P.bgu = F.inp(I_EBGU) + (size_t)layer * 32 * 1024; P.hact = (unsigned char*)(F.wsp() + WS_HACT); P.list = (const int*)(F.wsp() + WS_LIST);
      pg8::gemm_phase<E1Prob, true>(F.lds, P, F.wave0); }
    if constexpr (layer + 1 < DEPTH) { const int nwg = (int)F.X[XW_NTILES] * 4, c = (int)blockIdx.x; const int mine = nwg > c ? (nwg - c + F.G - 1) / F.G : 0, most = (nwg + F.G - 1) / F.G;
        if (mine < most) cvt_fill(F, layer + 1, FILL_E1); }
    GRID_BAR(); }
    for (int rep = 0; rep < REP_E2; ++rep) {
    { E2Prob P; P.X = F.X; P.G = F.G; P.c = (int)blockIdx.x; P.NT = 8; P.hact = (const unsigned char*)(F.wsp() + WS_HACT); P.Wt = (const unsigned char*)(F.wsp() + WS_WDN) + (size_t)layer * 32 * D * FF;
      P.bdn = F.inp(I_EBDN) + (size_t)layer * 32 * D; P.Y = (unsigned char*)(F.wsp() + WS_Y);
      pg8::gemm_phase<E2Prob, true>(F.lds, P, F.wave0); }
    if constexpr (layer + 1 < DEPTH) { const int nwg = (int)F.X[XW_NTILES] * 8, c = (int)blockIdx.x; const int mine = nwg > c ? (nwg - c + F.G - 1) / F.G : 0, most = (nwg + F.G - 1) / F.G;
        if (mine < most) cvt_fill(F, layer + 1, FILL_E2); }
    GRID_BAR(); }
    }
    if constexpr (layer + 1 < DEPTH) cvt_fill(F, layer + 1, -1);
    for (int rep_ = 0; rep_ < REP_R2; ++rep_) {     r2_phase(F, layer, layer == DEPTH - 1, (layer + 1 < DEPTH && ((layer + 1) & 1) == 0) ? (layer + 1) / 2 : -1, ((MOE_LAYER_MASK >> layer) & 1) ? 4 : 0); GRID_BAR(); }
}

struct Args { const float* in[20]; float* out; unsigned char* ws; };
__global__ void __launch_bounds__(NTHREADS, 2) fwd(Args args) {
    extern __shared__ __attribute__((aligned(16))) unsigned char lds_raw[];
    Frame F;
    F.lds = (LAS unsigned char*)lds_raw; F.X = (LAS unsigned*)(F.lds + LDSX_OFF);
    F.tid = threadIdx.x; F.lane = F.tid & 63; F.wave = __builtin_amdgcn_readfirstlane(F.tid >> 6); F.wave0 = F.wave; F.G = gridDim.x;
    F.ws_ = args.ws;
    for (int u = F.tid; u < XW_WORDS; u += NTHREADS) F.X[u] = 0u;
    __syncthreads();
    if (F.tid == 0) {
#pragma unroll
        for (int i = 0; i < 20; ++i) { const unsigned long long p = (unsigned long long)args.in[i]; F.X[XW_INP + 2 * i] = (unsigned)p; F.X[XW_INP + 2 * i + 1] = (unsigned)(p >> 32); }
        { const unsigned long long p = (unsigned long long)args.out; F.X[XW_INP + 40] = (unsigned)p; F.X[XW_INP + 41] = (unsigned)(p >> 32); } }
    __syncthreads();
    (void)xcd_barrier_post((unsigned*)(F.ctlp() + CW_BAR), (volatile LAS unsigned*)(F.X + XW_BAR));

    for (int rep = 0; rep < REP_P0A; ++rep) { p0a_weights(F); GRID_BAR(); }
    p0b_rows(F); GRID_BAR();
#define GRID_BAR_() GRID_BAR()
    moe_layer<0>(F); moe_layer<1>(F); moe_layer<2>(F); moe_layer<3>(F);
}

extern "C" void kernel_launch(void* const* d_in, const int* in_sizes, int n_in, void* d_out, int out_size, void* d_ws, size_t ws_size, hipStream_t stream) {
    static int grid = 0;
    if (grid == 0) {
        if (n_in != 20 || out_size != T * D || ws_size < WS_END) { fprintf(stderr, "kernel_launch: unexpected shapes (n_in %d out %d ws %zu need %zu)\n", n_in, out_size, ws_size, (size_t)WS_END); grid = -1; return; }
        int dev = 0, cus = 0, per_cu = 0;
        if (hipGetDevice(&dev) != hipSuccess || hipDeviceGetAttribute(&cus, hipDeviceAttributeMultiprocessorCount, dev) != hipSuccess) { grid = -1; return; }
        if (hipFuncSetAttribute((const void*)fwd, hipFuncAttributeMaxDynamicSharedMemorySize, LDS_BYTES) != hipSuccess) { fprintf(stderr, "kernel_launch: hipFuncSetAttribute failed\n"); grid = -1; return; }
        if (hipOccupancyMaxActiveBlocksPerMultiprocessor(&per_cu, (const void*)fwd, NTHREADS, LDS_BYTES) != hipSuccess || per_cu < 1) { fprintf(stderr, "kernel_launch: occupancy query says %d\n", per_cu); }
        (void)hipGetLastError();
        grid = cus;
    }
    if (grid < 0) return;
    if (hipMemsetAsync((char*)d_ws + WS_CTL, 0, CTL_ZERO_BYTES, stream) != hipSuccess) return;
    Args a{};
    for (int i = 0; i < 20; ++i) a.in[i] = (const float*)d_in[i];
    a.out = (float*)d_out; a.ws = (unsigned char*)d_ws;
    hipLaunchKernelGGL(fwd, dim3(grid), dim3(NTHREADS), LDS_BYTES, stream, a);
    const hipError_t le = hipPeekAtLastError();
    if (le != hipSuccess) fprintf(stderr, "kernel_launch: launch failed: %s\n", hipGetErrorName(le));
}
```
